# Optimizing an MI355X kernel written in HIP

```python
import math
import jax, jax.numpy as jnp
from jax import lax
import numpy as np

D_MODEL = 1024
BATCH = 32
SEQ = 2048
DEPTH = 2

GRID_W = 64
CTX_LEN = 256
EPS = 1e-6
ROPE_THETA = 10000.0

A_HEADS = 4
A_DH = 64
A_W = A_HEADS * 2 * A_DH
Q_BLOCK = 128
B_GROUPS = 4
B_GW = 128
B_W = B_GROUPS * B_GW
POOL_WINDOWS = (2, 4, 8, 16)
C_HEADS = 8
C_DH = 64
C_W = C_HEADS * C_DH
NA_ROWS = 8
NA_COLS = 16
D_GROUPS = 4
D_GW = 128
D_W = D_GROUPS * D_GW
CHUNK = 128
N_BRANCH = 4
FFN_HIDDEN = ((8 * D_MODEL // 3 + 255) // 256) * 256

OFF_AQ = 0
OFF_AK = OFF_AQ + A_W
OFF_AV = OFF_AK + A_W
OFF_B = OFF_AV + A_W
OFF_CQ = OFF_B + B_W
OFF_CK = OFF_CQ + C_W
OFF_CV = OFF_CK + C_W
OFF_DU = OFF_CV + C_W
OFF_DV = OFF_DU + D_W
OFF_G = OFF_DV + D_W
IN_COLS = OFF_G + N_BRANCH * D_MODEL
BRANCH_WIDTHS = (A_W, B_W, C_W, D_W)
MIX_W = A_W + B_W + C_W + D_W

kernel_name = 'hybrid_gated_branch_diffusion_block'


def _rmsnorm(t, g):
    tf = t.astype(jnp.float32)
    n = tf * lax.rsqrt(jnp.mean(tf * tf, axis=-1, keepdims=True) + EPS)
    return n.astype(t.dtype) * g


def _modulate(h, shift, scale):
    return h * (1 + scale) + shift


def _axial_rope(n_tok, dim, dtype):
    nf = dim // 4
    t = jnp.arange(n_tok)
    row = (t // GRID_W).astype(jnp.float32)
    col = (t % GRID_W).astype(jnp.float32)
    inv = ROPE_THETA ** (-jnp.arange(nf, dtype=jnp.float32) / nf)
    ar = row[:, None] * inv
    ac = col[:, None] * inv
    ang = jnp.concatenate([ar, ar, ac, ac], axis=-1)
    return jnp.cos(ang).astype(dtype), jnp.sin(ang).astype(dtype)


def _rope(t, cos, sin):
    a, b, cc, d = jnp.split(t, 4, axis=-1)
    rot = jnp.concatenate([-b, a, -d, cc], axis=-1)
    return t * cos + rot * sin


def _col_tables():
    ncb = GRID_W // NA_COLS
    qcol = np.arange(GRID_W).reshape(ncb, NA_COLS)
    band0 = np.clip(np.arange(ncb) * NA_COLS - NA_COLS // 2, 0, GRID_W - 2 * NA_COLS)
    band = band0[:, None] + np.arange(2 * NA_COLS)
    win0 = np.clip(qcol - NA_COLS // 2, 0, GRID_W - NA_COLS)
    kcol = band[:, None, :]
    valid = (kcol >= win0[..., None]) & (kcol < win0[..., None] + NA_COLS)
    dc_idx = np.clip(kcol - qcol[..., None] + NA_COLS - 1, 0, 2 * NA_COLS - 2)
    return band, valid, dc_idx


def _heads(t, h, d):
    return t.reshape(t.shape[0], t.shape[1], h, d).transpose(0, 2, 1, 3)


def _merge_heads(t):
    return t.transpose(0, 2, 1, 3).reshape(t.shape[0], t.shape[2], -1)


def _diff_heads(t, g):
    t = t.reshape(t.shape[0], t.shape[1], A_HEADS, 2, A_DH)
    return _rmsnorm(t, g).transpose(0, 2, 3, 1, 4)


def _diff_attend(q, k, v, lam):
    s = jnp.einsum('bhcqd,bhckd->bhcqk', q, k).astype(jnp.float32) * (A_DH ** -0.5)
    p = jax.nn.softmax(s, axis=-1)
    a = p[:, :, 0] - lam * p[:, :, 1]
    return jnp.einsum('bhqk,bhkv->bhqv', a.astype(v.dtype), v)


def _diff_attention_blocks(q, k, v, lam):
    b_, h, _, s, dh = q.shape
    nb = s // Q_BLOCK
    qb = q.reshape(b_, h, 2, nb, Q_BLOCK, dh).transpose(3, 0, 1, 2, 4, 5)
    out = lax.map(lambda qi: _diff_attend(qi, k, v, lam), qb)
    return out.transpose(1, 2, 0, 3, 4).reshape(b_, h, s, 2 * A_DH)


def _dense_attention(q, k, v):
    s = jnp.einsum('bqhd,bkhd->bhqk', q, k).astype(jnp.float32) * (q.shape[-1] ** -0.5)
    p = jax.nn.softmax(s, axis=-1).astype(v.dtype)
    o = jnp.einsum('bhqk,bkhd->bqhd', p, v)
    return o.reshape(o.shape[0], o.shape[1], -1)


def _neighbourhood_attention(q, k, v, k_ctx, v_ctx, rpb, col_tabs):
    band, valid, dc_idx = col_tabs
    b_, s, h, dh = q.shape
    rows = s // GRID_W
    wr = min(NA_ROWS, rows)
    ncb = GRID_W // NA_COLS
    nk = 2 * NA_COLS
    scale = dh ** -0.5
    qr = q.reshape(b_, rows, ncb, NA_COLS, h, dh).transpose(1, 0, 4, 2, 3, 5)

    def grid_band(t):
        t = t.reshape(b_, rows, GRID_W, h, dh).transpose(0, 3, 1, 2, 4)
        return t[:, :, :, band]

    kb_all = grid_band(k)
    vb_all = grid_band(v)
    kc = k_ctx.transpose(0, 2, 1, 3)
    vc = v_ctx.transpose(0, 2, 1, 3)
    col_bias = rpb[:, :, dc_idx]
    n_loc = wr * nk

    def row_step(args):
        r, qrow = args
        rs = jnp.clip(r - wr // 2, 0, rows - wr)
        kb = lax.dynamic_slice_in_dim(kb_all, rs, wr, axis=2)
        vb = lax.dynamic_slice_in_dim(vb_all, rs, wr, axis=2)
        ridx = rs + jnp.arange(wr) - r + NA_ROWS - 1
        bias = jnp.take(col_bias, ridx, axis=1).transpose(0, 2, 3, 1, 4)
        s_loc = jnp.einsum('bhjqd,bhrjkd->bhjqrk', qrow, kb).astype(jnp.float32) * scale
        s_loc = jnp.where(valid[:, :, None, :], s_loc + bias.astype(jnp.float32), -jnp.inf)
        s_ctx = jnp.einsum('bhjqd,bhkd->bhjqk', qrow, kc).astype(jnp.float32) * scale
        sc = jnp.concatenate([s_loc.reshape(b_, h, ncb, NA_COLS, n_loc), s_ctx], axis=-1)
        p = jax.nn.softmax(sc, axis=-1).astype(v.dtype)
        p_loc = p[..., :n_loc].reshape(b_, h, ncb, NA_COLS, wr, nk)
        return (jnp.einsum('bhjqrk,bhrjkd->bhjqd', p_loc, vb)
                + jnp.einsum('bhjqk,bhkd->bhjqd', p[..., n_loc:], vc))

    out = lax.map(row_step, (jnp.arange(rows), qr))
    return out.transpose(1, 0, 3, 4, 2, 5).reshape(b_, s, h * dh)


def _pool_mixer(p, w_pool, s_pool):
    b_, l_, _ = p.shape
    pg = p.reshape(b_, l_, B_GROUPS, B_GW)
    cs = jnp.cumsum(pg.astype(jnp.float32), axis=1)
    cs = jnp.concatenate([jnp.zeros_like(cs[:, :1]), cs], axis=1)
    t = jnp.arange(l_)
    means = []
    for g, w in enumerate(POOL_WINDOWS):
        lo = jnp.clip(t - w // 2, 0, l_)
        hi = jnp.clip(t + w // 2, 0, l_)
        cnt = (hi - lo).astype(jnp.float32)[None, :, None]
        means.append((cs[:, hi, g] - cs[:, lo, g]) / cnt)
    pooled = jnp.stack(means, axis=2).astype(p.dtype) - pg
    y = jnp.einsum('blgc,gcd->blgd', pooled, w_pool)
    return y.reshape(b_, l_, B_W) * s_pool


def _spatial_gating(u, v, vn_g, w_s, b_s):
    b_, l_, _ = u.shape
    v = _rmsnorm(v, vn_g).reshape(b_, l_ // CHUNK, CHUNK, D_GROUPS, D_GW)
    sv = jnp.einsum('gpq,bnqgc->bnpgc', w_s, v) + b_s.T[:, :, None]
    return u * sv.reshape(b_, l_, D_W)


def _merge_branches(ys, gate_pre, w_branch, w_out):
    d = w_out.shape[0]
    acc = None
    off = 0
    for i, (y, w) in enumerate(zip(ys, BRANCH_WIDTHS)):
        term = jax.nn.sigmoid(gate_pre[..., i * d:(i + 1) * d]) * (y @ w_branch[off:off + w])
        acc = term if acc is None else acc + term
        off += w
    return acc @ w_out


def _swiglu(h, w_gu, w_down):
    a, b = jnp.split(h @ w_gu, 2, axis=-1)
    return (jax.nn.silu(a) * b) @ w_down


def setup_inputs(seed: int = 0) -> dict:
    key = jax.random.key(seed)
    ks = jax.random.split(key, 24)
    f32 = jnp.float32
    D = D_MODEL
    L = DEPTH

    def nrm(k, shape, scale):
        return jax.random.normal(k, shape, f32) * scale

    return {
        'x': nrm(ks[0], (BATCH, SEQ, D), 1.0),
        'c': nrm(ks[1], (BATCH, D), 1.0),
        'ctx': nrm(ks[2], (BATCH, CTX_LEN, D), 1.0),
        'c_ctx': nrm(ks[3], (D,), 1.0),
        'w_mod': nrm(ks[4], (L, D, 6 * D), 0.5 * D ** -0.5),
        'b_mod': nrm(ks[5], (L, 6 * D), 0.02),
        'norm1_g': 1.0 + nrm(ks[6], (L, D), 0.02),
        'w_in': nrm(ks[7], (L, D, IN_COLS), D ** -0.5),
        'a_qk_g': 1.0 + nrm(ks[8], (L, 2, A_DH), 0.02),
        'a_lambda': nrm(ks[9], (L, 4, A_DH), 0.1),
        'a_subln_g': 1.0 + nrm(ks[10], (L, 2 * A_DH), 0.02),
        'b_pool_w': nrm(ks[11], (L, B_GROUPS, B_GW, B_GW), B_GW ** -0.5),
        'b_pool_s': 1.0 + nrm(ks[12], (L, B_W), 0.1),
        'c_qk_g': 1.0 + nrm(ks[13], (L, 2, C_DH), 0.02),
        'c_rpb': nrm(ks[14], (L, C_HEADS, 2 * NA_ROWS - 1, 2 * NA_COLS - 1), 0.5),
        'd_vn_g': 1.0 + nrm(ks[15], (L, D_W), 0.02),
        'd_ws': nrm(ks[16], (L, D_GROUPS, CHUNK, CHUNK), CHUNK ** -0.5),
        'd_bs': 1.0 + nrm(ks[17], (L, D_GROUPS, CHUNK), 0.02),
        'w_branch': nrm(ks[18], (L, MIX_W, D), A_W ** -0.5),
        'w_out': nrm(ks[19], (L, D, D), D ** -0.5),
        'norm2_g': 1.0 + nrm(ks[20], (L, D), 0.02),
        'w_gu': nrm(ks[21], (L, D, 2 * FFN_HIDDEN), D ** -0.5),
        'w_down': nrm(ks[22], (L, FFN_HIDDEN, D), FFN_HIDDEN ** -0.5),
    }


def reference(x, c, ctx, c_ctx, w_mod, b_mod, norm1_g, w_in, a_qk_g, a_lambda, a_subln_g,
              b_pool_w, b_pool_s, c_qk_g, c_rpb, d_vn_g, d_ws, d_bs, w_branch, w_out,
              norm2_g, w_gu, w_down):
    s = x.shape[1]
    cos_a, sin_a = _axial_rope(s, A_DH, x.dtype)
    col_tabs = _col_tables()
    for l in range(DEPTH):
        last = l == DEPTH - 1
        lam_init = 0.8 - 0.6 * math.exp(-0.3 * l)
        lam = (jnp.exp(jnp.sum(a_lambda[l, 0] * a_lambda[l, 1]))
               - jnp.exp(jnp.sum(a_lambda[l, 2] * a_lambda[l, 3])) + lam_init)

        mod_x = jax.nn.silu(c) @ w_mod[l] + b_mod[l]
        mod_c = jax.nn.silu(c_ctx) @ w_mod[l] + b_mod[l]
        sh1, sc1, g1, sh2, sc2, g2 = jnp.split(mod_x[:, None, :], 6, axis=-1)
        sh1c, sc1c, g1c, sh2c, sc2c, g2c = jnp.split(mod_c, 6)

        hx = _modulate(_rmsnorm(x, norm1_g[l]), sh1, sc1)
        hc = _modulate(_rmsnorm(ctx, norm1_g[l]), sh1c, sc1c)
        px = hx @ w_in[l]
        if last:
            ccol = lambda off, w: hc @ w_in[l][:, off:off + w]
        else:
            pc = hc @ w_in[l]
            ccol = lambda off, w: pc[..., off:off + w]
        xcol = lambda off, w: px[..., off:off + w]

        ga_q, ga_k = a_qk_g[l, 0], a_qk_g[l, 1]
        aq = _rope(_diff_heads(xcol(OFF_AQ, A_W), ga_q), cos_a, sin_a)
        ak = _rope(_diff_heads(xcol(OFF_AK, A_W), ga_k), cos_a, sin_a)
        av = _heads(xcol(OFF_AV, A_W), A_HEADS, 2 * A_DH)
        ak_c = _diff_heads(ccol(OFF_AK, A_W), ga_k)
        av_c = _heads(ccol(OFF_AV, A_W), A_HEADS, 2 * A_DH)
        k_all = jnp.concatenate([ak, ak_c], axis=3)
        v_all = jnp.concatenate([av, av_c], axis=2)
        ya = _diff_attention_blocks(aq, k_all, v_all, lam)
        ya = _merge_heads(_rmsnorm(ya, a_subln_g[l]) * (1 - lam_init))

        yb = _pool_mixer(xcol(OFF_B, B_W), b_pool_w[l], b_pool_s[l])

        gc_q, gc_k = c_qk_g[l, 0], c_qk_g[l, 1]
        split_c = lambda t: t.reshape(t.shape[0], t.shape[1], C_HEADS, C_DH)
        cq = _rmsnorm(split_c(xcol(OFF_CQ, C_W)), gc_q)
        ck = _rmsnorm(split_c(xcol(OFF_CK, C_W)), gc_k)
        cv = split_c(xcol(OFF_CV, C_W))
        ck_c = _rmsnorm(split_c(ccol(OFF_CK, C_W)), gc_k)
        cv_c = split_c(ccol(OFF_CV, C_W))
        yc = _neighbourhood_attention(cq, ck, cv, ck_c, cv_c, c_rpb[l], col_tabs)

        yd = _spatial_gating(xcol(OFF_DU, D_W), xcol(OFF_DV, D_W), d_vn_g[l], d_ws[l], d_bs[l])

        mix_x = _merge_branches((ya, yb, yc, yd), xcol(OFF_G, N_BRANCH * D_MODEL),
                                w_branch[l], w_out[l])
        x = x + g1 * mix_x
        x = x + g2 * _swiglu(_modulate(_rmsnorm(x, norm2_g[l]), sh2, sc2), w_gu[l], w_down[l])

        if not last:
            aq_c = _diff_heads(ccol(OFF_AQ, A_W), ga_q)
            ya_c = _merge_heads(_rmsnorm(_diff_attend(aq_c, ak_c, av_c, lam), a_subln_g[l]) * (1 - lam_init))
            yb_c = _pool_mixer(ccol(OFF_B, B_W), b_pool_w[l], b_pool_s[l])
            cq_c = _rmsnorm(split_c(ccol(OFF_CQ, C_W)), gc_q)
            yc_c = _dense_attention(cq_c, ck_c, cv_c)
            yd_c = _spatial_gating(ccol(OFF_DU, D_W), ccol(OFF_DV, D_W), d_vn_g[l], d_ws[l], d_bs[l])
            mix_c = _merge_branches((ya_c, yb_c, yc_c, yd_c), ccol(OFF_G, N_BRANCH * D_MODEL),
                                    w_branch[l], w_out[l])
            ctx = ctx + g1c * mix_c
            ctx = ctx + g2c * _swiglu(_modulate(_rmsnorm(ctx, norm2_g[l]), sh2c, sc2c), w_gu[l], w_down[l])
    return x
```

```cpp
#include <hip/hip_runtime.h>
#include <hip/hip_cooperative_groups.h>
#include <cstdio>
#include <cstdint>
namespace cg = cooperative_groups;

#ifndef P13
#define P13 255
#endif
#ifndef MXMASK
#define MXMASK 63
#endif
#ifndef MULTI_LAUNCH
#define MULTI_LAUNCH 0
#endif

typedef unsigned short u16;
typedef short bf16x8 __attribute__((ext_vector_type(8)));
typedef float f32x4 __attribute__((ext_vector_type(4)));
typedef __bf16 bf2_t __attribute__((ext_vector_type(2)));
typedef float f2_t __attribute__((ext_vector_type(2)));
typedef unsigned u32x4 __attribute__((ext_vector_type(4)));
typedef unsigned u32x2 __attribute__((ext_vector_type(2)));

#define DEV __device__ __forceinline__

constexpr int NLAYER = 2;
constexpr int INC = 8704, PXW = 7680, FH = 2816;
constexpr int HB = 16;
constexpr int LR = HB * 2048;
constexpr int HR = LR + HB * 256;
constexpr int KV = 2304;
constexpr int PX_AQ = 0, PX_AK = 512, PX_B = 1024, PX_CQ = 1536, PX_CK = 2048, PX_DU = 2560, PX_DV = 3072, PX_G = 3584;
constexpr int YS_A = 0, YS_B = 512, YS_C = 1024, YS_D = 1536;
constexpr int LDS_BYTES = 2 * 73728 + 16;
constexpr float EPS_ = 1e-6f;
constexpr float LOG2E = 1.4426950408889634f;
constexpr int NPHASE = 1 + NLAYER * 11;

struct Params {
  const float *x, *c, *ctx, *c_ctx, *w_mod, *b_mod, *norm1_g, *w_in, *a_qk_g, *a_lambda, *a_subln_g, *b_pool_w, *b_pool_s,
      *c_qk_g, *c_rpb, *d_vn_g, *d_ws, *d_bs, *w_branch, *w_out, *norm2_g, *w_gu, *w_down;
  float* out;
  u16 *WIN, *WBR, *WOUT, *WGU, *WDN, *WPOOL, *WSB;
  float *MOD, *CTXC;
  u16 *HX, *PX, *VTA, *VTC, *YS, *ACC0;
  unsigned* BAR;
  int ph0, ph1;
};

DEV int tid() { int t = threadIdx.x & 255; asm volatile("" : "+v"(t)); return t; }
DEV int vhalf() { return __builtin_amdgcn_readfirstlane((int)(threadIdx.x >> 8)); }
DEV int bid() { int b = (((int)blockIdx.x >> 3) * 2 + vhalf()) * 8 + ((int)blockIdx.x & 7); asm volatile("" : "+s"(b)); return b; }
DEV int vgrid() { return (int)gridDim.x * 2; }
DEV unsigned cvt_pk(float lo, float hi) {
  f2_t v = {lo, hi};
  bf2_t b = __builtin_convertvector(v, bf2_t);
  return __builtin_bit_cast(unsigned, b);
}
DEV float bflo(unsigned u) { return __uint_as_float(u << 16); }
DEV float bfhi(unsigned u) { return __uint_as_float(u & 0xffff0000u); }
DEV int perm32(int r) { return (r & ~31) | (((r >> 2) & 1) << 4) | (((r >> 3) & 3) << 2) | (r & 3); }
DEV f32x4 mfma16(bf16x8 a, bf16x8 b, f32x4 c) { return __builtin_amdgcn_mfma_f32_16x16x32_bf16(a, b, c, 0, 0, 0); }
DEV u32x4 pack8(const f32x4& a, const f32x4& b) {
  u32x4 o;
  o.x = cvt_pk(a[0], a[1]); o.y = cvt_pk(a[2], a[3]); o.z = cvt_pk(b[0], b[1]); o.w = cvt_pk(b[2], b[3]);
  return o;
}
DEV bf16x8 pack8f(const f32x4& a, const f32x4& b) { return __builtin_bit_cast(bf16x8, pack8(a, b)); }
DEV float fexp2(float x) { return __builtin_amdgcn_exp2f(x); }
DEV float frcp(float x) { return __builtin_amdgcn_rcpf(x); }
DEV float sigmoidf_(float x) { return frcp(1.f + fexp2(-x * LOG2E)); }

DEV int xidx(int wx, int u, int quad) { return wx * 64 + u * 32 + quad * 8; }
DEV int yidx(int wy, int yt, int l15) { return wy * 64 + (yt >> 1) * 32 + (l15 >> 2) * 8 + (yt & 1) * 4 + (l15 & 3); }

DEV void zero_acc(f32x4 (&acc)[4][4]) {
#pragma unroll
  for (int i = 0; i < 4; ++i)
#pragma unroll
    for (int j = 0; j < 4; ++j) acc[i][j] = (f32x4){0.f, 0.f, 0.f, 0.f};
}

template <int KS, int STRIDE>
DEV void wave_mma(const u16* Xs, const u16* Ys, f32x4 (&acc)[4][4], int wx, int wy, int l15, int quad) {
#pragma unroll
  for (int ks = 0; ks < KS; ++ks) {
    bf16x8 xf[4], yf[4];
#pragma unroll
    for (int i = 0; i < 4; ++i) xf[i] = *(const bf16x8*)(Xs + (wx * 64 + i * 16 + l15) * STRIDE + ks * 32 + quad * 8);
#pragma unroll
    for (int i = 0; i < 4; ++i) yf[i] = *(const bf16x8*)(Ys + (wy * 64 + i * 16 + l15) * STRIDE + ks * 32 + quad * 8);
#pragma unroll
    for (int a = 0; a < 4; ++a)
#pragma unroll
      for (int b = 0; b < 4; ++b) acc[a][b] = mfma16(xf[a], yf[b], acc[a][b]);
  }
}

DEV void gemm_kloop(const u16* __restrict__ Xg, int ldx, const u16* __restrict__ Yg, int ldy, int nkt, f32x4 (&acc)[4][4], u16* lds) {
  const int t = tid(), lane = t & 63, w = t >> 6, l15 = lane & 15, quad = lane >> 4;
  const int wx = w & 1, wy = w >> 1;
  const int lr = t >> 3, kc = t & 7;
  const unsigned xo = (unsigned)(lr * ldx + kc * 8), yo = (unsigned)(lr * ldy + kc * 8);
  const int pr = perm32(lr);
  const int sofs = pr * 64 + ((kc ^ ((pr >> 1) & 7)) << 3);
  const int m7 = (l15 >> 1) & 7;
  const int xrow = (wx * 64 + l15) * 64, yrow = 8192 + (wy * 64 + l15) * 64;
  const int ko0 = ((0 + quad) ^ m7) << 3, ko1 = ((4 + quad) ^ m7) << 3;
  u32x4 rx[4], ry[4];
#define GK_LOAD(KT)                                                                \
  _Pragma("unroll") for (int i = 0; i < 4; ++i) {                                  \
    rx[i] = *(const u32x4*)((Xg + (size_t)(32 * i) * ldx + (size_t)(KT) * 64) + xo); \
    ry[i] = *(const u32x4*)((Yg + (size_t)(32 * i) * ldy + (size_t)(KT) * 64) + yo); \
  }
#define GK_STORE(B)                                                                \
  _Pragma("unroll") for (int i = 0; i < 4; ++i) {                                  \
    *(u32x4*)(lds + (B) * 16384 + sofs + i * 32 * 64) = rx[i];                     \
    *(u32x4*)(lds + (B) * 16384 + 8192 + sofs + i * 32 * 64) = ry[i];              \
  }
  GK_LOAD(0)
  __syncthreads();
  GK_STORE(0)
  if (nkt > 1) { GK_LOAD(1) }
  __syncthreads();
  for (int kt = 0; kt < nkt; ++kt) {
    const int cur = kt & 1;
    if (kt + 1 < nkt) {
      GK_STORE(cur ^ 1)
      if (kt + 2 < nkt) { GK_LOAD(kt + 2) }
    }
    const u16* B = lds + cur * 16384;
#pragma unroll
    for (int ks = 0; ks < 2; ++ks) {
      const int ko = ks ? ko1 : ko0;
      bf16x8 xf[4], yf[4];
#pragma unroll
      for (int i = 0; i < 4; ++i) xf[i] = *(const bf16x8*)(B + xrow + i * 16 * 64 + ko);
#pragma unroll
      for (int i = 0; i < 4; ++i) yf[i] = *(const bf16x8*)(B + yrow + i * 16 * 64 + ko);
#pragma unroll
      for (int a = 0; a < 4; ++a)
#pragma unroll
        for (int b = 0; b < 4; ++b) acc[a][b] = mfma16(xf[a], yf[b], acc[a][b]);
    }
    __syncthreads();
  }
#undef GK_LOAD
#undef GK_STORE
}

DEV int ptid() { int t = threadIdx.x; asm volatile("" : "+v"(t)); return t; }
DEV int pbid() { int b = blockIdx.x; asm volatile("" : "+s"(b)); return b; }
DEV void zero_acc8(f32x4 (&acc)[8][4]) {
#pragma unroll
  for (int i = 0; i < 8; ++i)
#pragma unroll
    for (int j = 0; j < 4; ++j) acc[i][j] = (f32x4){0.f, 0.f, 0.f, 0.f};
}
DEV int xidx8(int wx, int u, int quad) { return wx * 128 + u * 32 + quad * 8; }
DEV void gemm_kloop256(const u16* __restrict__ Xg, int ldx, const u16* __restrict__ Yg, int ldy, int nkt, f32x4 (&acc)[8][4], u16* lds) {
  const int t = ptid(), lane = t & 63, w = t >> 6, l15 = lane & 15, quad = lane >> 4;
  const int wx = w & 1, wy = w >> 1;
  const int lr = t >> 3, kc = t & 7;
  const unsigned xo = (unsigned)(lr * ldx + kc * 8), yo = (unsigned)(lr * ldy + kc * 8);
  const int pr = perm32(lr);
  const int sofs = pr * 64 + ((kc ^ ((pr >> 1) & 7)) << 3);
  const int m7 = (l15 >> 1) & 7;
  const int xrow = (wx * 128 + l15) * 64, yrow = 16384 + (wy * 64 + l15) * 64;
  const int ko0 = ((0 + quad) ^ m7) << 3, ko1 = ((4 + quad) ^ m7) << 3;
  u32x4 rx[4], ry[4];
#define GK_LOAD(KT)                                                                \
  _Pragma("unroll") for (int i = 0; i < 4; ++i) {                                  \
    rx[i] = *(const u32x4*)((Xg + (size_t)(64 * i) * ldx + (size_t)(KT) * 64) + xo); \
    ry[i] = *(const u32x4*)((Yg + (size_t)(64 * i) * ldy + (size_t)(KT) * 64) + yo); \
  }
#define GK_STORE(B)                                                                \
  _Pragma("unroll") for (int i = 0; i < 4; ++i) {                                  \
    *(u32x4*)(lds + (B) * 32768 + sofs + i * 64 * 64) = rx[i];                     \
    *(u32x4*)(lds + (B) * 32768 + 16384 + sofs + i * 64 * 64) = ry[i];             \
  }
  GK_LOAD(0)
  __syncthreads();
  GK_STORE(0)
  if (nkt > 1) { GK_LOAD(1) }
  __syncthreads();
  for (int kt = 0; kt < nkt; ++kt) {
    const int cur = kt & 1;
    if (kt + 1 < nkt) {
      GK_STORE(cur ^ 1)
      if (kt + 2 < nkt) { GK_LOAD(kt + 2) }
    }
    const u16* B = lds + cur * 32768;
#pragma unroll
    for (int ks = 0; ks < 2; ++ks) {
      const int ko = ks ? ko1 : ko0;
      bf16x8 yf[4];
#pragma unroll
      for (int i = 0; i < 4; ++i) yf[i] = *(const bf16x8*)(B + yrow + i * 16 * 64 + ko);
#pragma unroll
      for (int a = 0; a < 8; ++a) {
        const bf16x8 xf = *(const bf16x8*)(B + xrow + a * 16 * 64 + ko);
#pragma unroll
        for (int b = 0; b < 4; ++b) acc[a][b] = mfma16(xf, yf[b], acc[a][b]);
      }
    }
    __syncthreads();
  }
#undef GK_LOAD
#undef GK_STORE
}
DEV bool next_tile_p(int it, int RT, int CT, int PR, int PC, int& rt, int& ct) {
  const int G = (int)gridDim.x;
  const int b = pbid();
  if ((G & 7) == 0 && (G >> 3) == PR * PC) {
    const int x = b & 7, lb = b >> 3;
    const int gp = it * 8 + x;
    const int npc = CT / PC, npr = RT / PR;
    if (gp >= npc * npr) return false;
    const int prow = gp / npc, pcol = gp - prow * npc;
    rt = prow * PR + lb / PC;
    ct = pcol * PC + lb % PC;
    return true;
  } else {
    const int v = it * G + b;
    if (v >= RT * CT) return false;
    rt = v / CT; ct = v - rt * CT;
    return true;
  }
}

DEV bool next_tile(int it, int RT, int CT, int PR, int PC, int& rt, int& ct) {
  const int G = vgrid();
  if ((G & 7) == 0) {
    const int x = bid() & 7, nbx = G >> 3, lb = bid() >> 3;
    const int s = it * nbx + lb;
    const int ps = s >> 6, j = s & 63;
    const int gp = ps * 8 + x;
    const int npc = CT / PC, npr = RT / PR;
    if (gp >= npc * npr) return false;
    const int prow = gp / npc, pcol = gp - prow * npc;
    rt = prow * PR + j / PC;
    ct = pcol * PC + j % PC;
    return true;
  } else {
    const int v = it * G + bid();
    if (v >= RT * CT) return false;
    rt = v / CT; ct = v - rt * CT;
    return true;
  }
}

DEV void rowmap(int hf, int R, int& b, int& idx, bool& isc) {
  if (R < LR) { b = hf * HB + (R >> 11); idx = R & 2047; isc = false; }
  else { const int q = R - LR; b = hf * HB + (q >> 8); idx = q & 255; isc = true; }
}

DEV void tconv(const float* __restrict__ src, int K, int N, u16* __restrict__ dst, int mode, float* lds) {
  const int t = tid();
  const int ntn = N >> 6, ntk = K >> 6, ntiles = ntn * ntk;
  for (int base = 0; base < ntiles; base += vgrid()) {
    const int tile = base + bid();
    const bool active = tile < ntiles;
    const int kt = active ? tile / ntn : 0, nt = active ? tile - kt * ntn : 0;
    const int k0 = kt * 64, n0 = nt * 64;
    __syncthreads();
    if (active) {
      const int c = t & 63, r0 = t >> 6;
#pragma unroll
      for (int i = 0; i < 16; ++i) {
        const int k = r0 + 4 * i;
        lds[k * 65 + c] = src[(size_t)(k0 + k) * N + n0 + c];
      }
    }
    __syncthreads();
    if (active) {
      const int kk = t & 63, r0 = t >> 6;
#pragma unroll
      for (int i = 0; i < 16; ++i) {
        const int n = n0 + r0 + 4 * i;
        int dr = n;
        if (mode == 1) { if (n < FH) dr = ((n >> 2) << 3) + (n & 3); else { const int hh = n - FH; dr = ((hh >> 2) << 3) + 4 + (hh & 3); } }
        const float v = lds[kk * 65 + (r0 + 4 * i)];
        dst[(size_t)dr * K + k0 + kk] = (u16)(cvt_pk(v, 0.f) & 0xffffu);
      }
    }
  }
}

DEV void phase_prep(const Params& p, char* ldsc) {
  float* lds = (float*)ldsc;
  const int t = tid();
  for (int l = 0; l < NLAYER; ++l) {
    tconv(p.w_in + (size_t)l * 1024 * INC, 1024, INC, p.WIN + (size_t)l * INC * 1024, 0, lds);
    tconv(p.w_branch + (size_t)l * 2048 * 1024, 2048, 1024, p.WBR + (size_t)l * 1024 * 2048, 0, lds);
    tconv(p.w_out + (size_t)l * 1024 * 1024, 1024, 1024, p.WOUT + (size_t)l * 1024 * 1024, 0, lds);
    tconv(p.w_gu + (size_t)l * 1024 * 2 * FH, 1024, 2 * FH, p.WGU + (size_t)l * 2 * FH * 1024, 1, lds);
    tconv(p.w_down + (size_t)l * FH * 1024, FH, 1024, p.WDN + (size_t)l * 1024 * FH, 0, lds);
    for (int g = 0; g < 4; ++g)
      tconv(p.b_pool_w + (size_t)(l * 4 + g) * 16384, 128, 128, p.WPOOL + (size_t)(l * 4 + g) * 16384, 0, lds);
  }
  for (int i = bid() * 256 + t; i < NLAYER * 4 * 16384; i += vgrid() * 256) p.WSB[i] = (u16)(cvt_pk(p.d_ws[i], 0.f) & 0xffffu);
  for (int base = 0; base < NLAYER * 96; base += vgrid()) {
    const int item0 = base + vgrid() - 1 - bid();
    const bool active = item0 < NLAYER * 96;
    const int item = active ? item0 : 0;
    const int l = item / 96, n0 = (item % 96) * 64;
    const int c = t & 63, w = t >> 6;
    float acc[9];
#pragma unroll
    for (int i = 0; i < 9; ++i) acc[i] = 0.f;
    const float* wm = p.w_mod + (size_t)l * 1024 * 6144 + n0 + c;
    for (int kc = 0; kc < 4; ++kc) {
      __syncthreads();
      for (int i = 0; i < 36; ++i) {
        const int idx = t + 256 * i, r = idx >> 8, k = idx & 255;
        float v = 0.f;
        if (r < 32) v = p.c[r * 1024 + kc * 256 + k]; else if (r == 32) v = p.c_ctx[kc * 256 + k];
        lds[idx] = v / (1.f + __expf(-v));
      }
      __syncthreads();
      for (int k4 = 0; k4 < 64; ++k4) {
        const size_t kb = (size_t)(kc * 256 + k4 * 4) * 6144;
        const float w0 = wm[kb], w1 = wm[kb + 6144], w2 = wm[kb + 2 * 6144], w3 = wm[kb + 3 * 6144];
#pragma unroll
        for (int i = 0; i < 9; ++i) {
          const float4 s = *(const float4*)(lds + (w + 4 * i) * 256 + k4 * 4);
          acc[i] += s.x * w0 + s.y * w1 + s.z * w2 + s.w * w3;
        }
      }
    }
    const float bm = p.b_mod[l * 6144 + n0 + c];
#pragma unroll
    for (int i = 0; i < 9; ++i) {
      const int r = w + 4 * i;
      if (active && r < 33) p.MOD[((size_t)l * 33 + r) * 6144 + n0 + c] = acc[i] + bm;
    }
  }
}

DEV void phase_norm(const Params& p, int l, int hf0, int which) {
  const bool last = (l == NLAYER - 1);
  const int lane = tid() & 63;
  const int gw = (bid() * 256 + tid()) >> 6, nw = vgrid() * 4;
  const float* g = (which ? p.norm2_g : p.norm1_g) + l * 1024;
  const bool first = (which == 0 && l == 0);
  const float* xs = first ? p.x : p.out;
  const float* cs = first ? p.ctx : p.CTXC;
  const int nrows = which ? 2 * HR : HR;
  u16* dstb = which ? p.YS : p.HX;
  for (int GR = gw; GR < nrows; GR += nw) {
    const int hf = which ? (GR >= HR ? 1 : 0) : hf0;
    const int R = which ? GR - hf * HR : GR;
    if (which && last && R >= LR) continue;
    int b, idx; bool isc;
    rowmap(hf, R, b, idx, isc);
    const float* src = isc ? cs + ((size_t)b * 256 + idx) * 1024 : xs + ((size_t)b * 2048 + idx) * 1024;
    const float* md = p.MOD + ((size_t)l * 33 + (isc ? 32 : b)) * 6144 + (which ? 3 : 0) * 1024;
    float4 v[4];
    float ss = 0.f;
#pragma unroll
    for (int i = 0; i < 4; ++i) {
      { const f32x4 q_ = __builtin_nontemporal_load((const f32x4*)(src + i * 256 + lane * 4)); v[i] = make_float4(q_[0], q_[1], q_[2], q_[3]); }
      ss += v[i].x * v[i].x + v[i].y * v[i].y + v[i].z * v[i].z + v[i].w * v[i].w;
    }
#pragma unroll
    for (int o = 32; o >= 1; o >>= 1) ss += __shfl_xor(ss, o);
    const float r = rsqrtf(ss * (1.f / 1024.f) + EPS_);
#pragma unroll
    for (int i = 0; i < 4; ++i) {
      const int col = i * 256 + lane * 4;
      const float4 g4 = *(const float4*)(g + col), sh = *(const float4*)(md + col), sc = *(const float4*)(md + 1024 + col);
      const float o0 = v[i].x * r * g4.x * (1.f + sc.x) + sh.x;
      const float o1 = v[i].y * r * g4.y * (1.f + sc.y) + sh.y;
      const float o2 = v[i].z * r * g4.z * (1.f + sc.z) + sh.z;
      const float o3 = v[i].w * r * g4.w * (1.f + sc.w) + sh.w;
      u32x2 o; o.x = cvt_pk(o0, o1); o.y = cvt_pk(o2, o3);
      *(u32x2*)(dstb + (size_t)GR * 1024 + col) = o;
    }
  }
}

DEV void phase_inproj(const Params& p, int l, int hf, u16* lds) {
  const bool last = (l == NLAYER - 1);
  const int t = ptid(), lane = t & 63, w = t >> 6, l15 = lane & 15, quad = lane >> 4, wx = w & 1, wy = w >> 1;
  int rt, ct;
  for (int it = 0; next_tile_p(it, 144, 34, 16, 2, rt, ct); ++it) {
    const bool ctxrow = rt >= 128;
    if (last && ctxrow && !((ct >= 2 && ct < 6) || (ct >= 10 && ct < 14))) continue;
    const u16* W = p.WIN + ((size_t)l * INC + ct * 256) * 1024;
    const u16* A = p.HX + (size_t)rt * 256 * 1024;
    f32x4 acc[8][4];
    zero_acc8(acc);
    const bool isva = (ct == 4 || ct == 5), isvc = (ct == 12 || ct == 13);
    if (!(isva || isvc)) {
      gemm_kloop256(W, 1024, A, 1024, 16, acc, lds);
      if (ct < 4 || (ct >= 8 && ct < 12)) {
        const int seg = ct < 4 ? (ct >> 1) : 2 + ((ct - 8) >> 1);
        const float* gq = (seg < 2 ? p.a_qk_g : p.c_qk_g) + l * 128 + (seg & 1) * 64;
        const float qs = (seg == 0 || seg == 2) ? 0.125f * LOG2E : 1.f;
        const bool dorope = (seg < 2) && !ctxrow;
        float gl[4][4], inv[8];
        int q2 = quad;
        asm volatile("" : "+v"(q2) : "v"(acc[0][0][0]));
#pragma unroll
        for (int xt = 0; xt < 4; ++xt)
#pragma unroll
          for (int j = 0; j < 4; ++j) gl[xt][j] = gq[(xt >> 1) * 32 + q2 * 8 + (xt & 1) * 4 + j] * qs;
#pragma unroll
        for (int k = 0; k < 8; ++k) inv[k] = fexp2(-(float)((q2 & 1) * 8 + k) * (13.287712379549449f / 16.f));
#pragma unroll
        for (int gi = 0; gi < 2; ++gi)
#pragma unroll
          for (int yt = 0; yt < 4; ++yt) {
            __builtin_amdgcn_sched_barrier(0);
            float ss = 0.f;
#pragma unroll
            for (int xt = 0; xt < 4; ++xt)
#pragma unroll
              for (int j = 0; j < 4; ++j) ss += acc[gi * 4 + xt][yt][j] * acc[gi * 4 + xt][yt][j];
            ss += __shfl_xor(ss, 16);
            ss += __shfl_xor(ss, 32);
            const float r = rsqrtf(ss * (1.f / 64.f) + EPS_);
#pragma unroll
            for (int xt = 0; xt < 4; ++xt)
#pragma unroll
              for (int j = 0; j < 4; ++j) acc[gi * 4 + xt][yt][j] *= r * gl[xt][j];
            if (dorope) {
              int sq = (rt * 256 + yidx(wy, yt, l15)) & 2047;
              asm volatile("" : "+v"(sq) : "v"(acc[gi * 4][yt][0]));
              const float frow = (float)(sq >> 6), fcol = (float)(sq & 63);
#pragma unroll
              for (int xt = 0; xt < 4; ++xt)
#pragma unroll
                for (int j = 0; j < 4; ++j) {
                  const float ang = ((xt >> 1) ? fcol : frow) * inv[(xt & 1) * 4 + j];
                  const float cs = __cosf(ang), sn = __sinf(ang);
                  const float v = acc[gi * 4 + xt][yt][j];
                  const float pv = __shfl_xor(v, 32);
                  acc[gi * 4 + xt][yt][j] = (quad < 2) ? v * cs - pv * sn : v * cs + pv * sn;
                }
            }
          }
      }
      const int c0 = ct * 256;
      const int pxc = c0 < 1024 ? c0 : (c0 < 3072 ? c0 - 512 : c0 - 1024);
#pragma unroll
      for (int yt = 0; yt < 4; ++yt) {
        const size_t row = (size_t)rt * 256 + yidx(wy, yt, l15);
#pragma unroll
        for (int u = 0; u < 4; ++u)
          *(u32x4*)(p.PX + row * PXW + pxc + xidx8(wx, u, quad)) = pack8(acc[2 * u][yt], acc[2 * u + 1][yt]);
      }
    } else {
      gemm_kloop256(A, 1024, W, 1024, 16, acc, lds);
      int bl, key0;
      if (!ctxrow) { bl = rt >> 3; key0 = (rt & 7) * 256; } else { bl = rt - 128; key0 = 2048; }
#pragma unroll
      for (int yt = 0; yt < 4; ++yt) {
        const int n = yidx(wy, yt, l15);
        u16* dst;
        if (isva) dst = p.VTA + ((size_t)((bl * 4 + (ct - 4) * 2 + (n >> 7)) * 128 + (n & 127))) * KV + key0;
        else dst = p.VTC + ((size_t)((bl * 8 + (ct - 12) * 4 + (n >> 6)) * 64 + (n & 63))) * KV + key0;
#pragma unroll
        for (int u = 0; u < 4; ++u) *(u32x4*)(dst + xidx8(wx, u, quad)) = pack8(acc[2 * u][yt], acc[2 * u + 1][yt]);
      }
    }
  }
}

DEV void phase_qk(const Params& p, int l, int hf) {
  const bool last = (l == NLAYER - 1);
  const int total = HR * 32;
  for (int id = bid() * 256 + tid(); id < total; id += vgrid() * 256) {
    const int R = id >> 5, gi = id & 31, seg = gi >> 3, grp = gi & 7;
    const bool isc = R >= LR;
    if (last && isc && !(seg == 1 || seg == 3)) continue;
    const int colbase = seg == 0 ? PX_AQ : (seg == 1 ? PX_AK : (seg == 2 ? PX_CQ : PX_CK));
    u16* ptr = p.PX + (size_t)R * PXW + colbase + grp * 64;
    const float* g = (seg < 2 ? p.a_qk_g : p.c_qk_g) + l * 128 + (seg & 1) * 64;
    float v[64];
    float ss = 0.f;
#pragma unroll
    for (int i = 0; i < 8; ++i) {
      const u32x4 q = *(const u32x4*)(ptr + i * 8);
      v[i * 8 + 0] = bflo(q.x); v[i * 8 + 1] = bfhi(q.x); v[i * 8 + 2] = bflo(q.y); v[i * 8 + 3] = bfhi(q.y);
      v[i * 8 + 4] = bflo(q.z); v[i * 8 + 5] = bfhi(q.z); v[i * 8 + 6] = bflo(q.w); v[i * 8 + 7] = bfhi(q.w);
    }
#pragma unroll
    for (int i = 0; i < 64; ++i) ss += v[i] * v[i];
    float r = rsqrtf(ss * (1.f / 64.f) + EPS_);
#pragma unroll
    for (int i = 0; i < 64; ++i) v[i] = v[i] * r * g[i];
    if (seg < 2 && !isc) {
      const int s = R & 2047;
      const float frow = (float)(s >> 6), fcol = (float)(s & 63);
#pragma unroll
      for (int d = 0; d < 16; ++d) {
        const float inv = exp2f(-(float)d * (13.287712379549449f / 16.f));
        const float ar = frow * inv, ac = fcol * inv;
        const float cr = __cosf(ar), sr = __sinf(ar), cc = __cosf(ac), sc = __sinf(ac);
        const float a = v[d], b = v[16 + d], c2 = v[32 + d], d2 = v[48 + d];
        v[d] = a * cr - b * sr; v[16 + d] = b * cr + a * sr;
        v[32 + d] = c2 * cc - d2 * sc; v[48 + d] = d2 * cc + c2 * sc;
      }
    }
    const float qs = (seg == 0 || seg == 2) ? 0.125f * LOG2E : 1.f;
#pragma unroll
    for (int i = 0; i < 8; ++i) {
      u32x4 q;
      q.x = cvt_pk(v[i * 8 + 0] * qs, v[i * 8 + 1] * qs); q.y = cvt_pk(v[i * 8 + 2] * qs, v[i * 8 + 3] * qs);
      q.z = cvt_pk(v[i * 8 + 4] * qs, v[i * 8 + 5] * qs); q.w = cvt_pk(v[i * 8 + 6] * qs, v[i * 8 + 7] * qs);
      *(u32x4*)(ptr + i * 8) = q;
    }
  }
}

#define LASP __attribute__((address_space(3)))
DEV int invperm32(int s_) { return (s_ & ~31) | (((s_ >> 4) & 1) << 2) | (((s_ >> 2) & 3) << 3) | (s_ & 3); }
template <bool CTXQ>
DEV void attnA_unit(const Params& p, int l, int bl, int h, int qb, u16* ldsg) {
  const int t = ptid(), lane = t & 63, w = __builtin_amdgcn_readfirstlane(t >> 6), l15 = lane & 15, quad = lane >> 4;
  const int comp = w & 1, qp = w >> 1;
  LASP unsigned char* lds = (LASP unsigned char*)ldsg;
  float lam, lam_init, gmax;
  {
    const float* al = p.a_lambda + l * 256;
    float p1 = al[lane] * al[64 + lane], p2 = al[128 + lane] * al[192 + lane];
    float gm = fabsf(p.a_qk_g[l * 128 + 64 + lane]);
#pragma unroll
    for (int o = 32; o >= 1; o >>= 1) { p1 += __shfl_xor(p1, o); p2 += __shfl_xor(p2, o); gm = fmaxf(gm, __shfl_xor(gm, o)); }
    lam_init = 0.8f - 0.6f * __expf(-0.3f * (float)l);
    lam = __expf(p1) - __expf(p2) + lam_init;
    gmax = gm;
  }
  const size_t qrow0 = CTXQ ? (size_t)LR + bl * 256 + qb * 128 + qp * 32 : (size_t)bl * 2048 + qb * 128 + qp * 32;
  bf16x8 qf[2][2];
#pragma unroll
  for (int qt = 0; qt < 2; ++qt)
#pragma unroll
    for (int ks = 0; ks < 2; ++ks)
      qf[qt][ks] = *(const bf16x8*)(p.PX + (qrow0 + qt * 16 + l15) * PXW + PX_AQ + h * 128 + comp * 64 + ks * 32 + quad * 8);
  float mq[2];
#pragma unroll
  for (int qt = 0; qt < 2; ++qt) {
    float ss = 0.f;
#pragma unroll
    for (int ks = 0; ks < 2; ++ks)
#pragma unroll
      for (int e = 0; e < 8; ++e) { const float v = bflo((unsigned)(unsigned short)qf[qt][ks][e]); ss += v * v; }
    ss += __shfl_xor(ss, 16);
    ss += __shfl_xor(ss, 32);
    mq[qt] = sqrtf(ss) * (8.f * 1.01f) * gmax;
  }
  unsigned koff[2], voff[2];
#pragma unroll
  for (int i = 0; i < 2; ++i) {
    const int rho = (w * 2 + i) * 8 + (lane >> 3), c = (lane & 7) ^ ((rho >> 1) & 7);
    koff[i] = (unsigned)(invperm32(rho & 63) * PXW + (rho >> 6) * 64 + c * 8);
    voff[i] = (unsigned)(invperm32(rho) * KV + c * 8);
  }
  const int nkt = CTXQ ? 4 : 36, kt0 = CTXQ ? 32 : 0;
  const u16* vbase = p.VTA + ((size_t)((bl * 4 + h) * 128)) * KV;
#define A_DMA(KT, SLOT) do {                                                                                                          \
    const int kt_ = (KT);                                                                                                              \
    const size_t rowbase_ = kt_ < 32 ? (size_t)bl * 2048 + kt_ * 64 : (size_t)LR + bl * 256 + (kt_ - 32) * 64;                          \
    const u16* kb_ = p.PX + rowbase_ * PXW + PX_AK + h * 128;                                                                          \
    const u16* vb_ = vbase + kt_ * 64;                                                                                                 \
    _Pragma("unroll") for (int i_ = 0; i_ < 2; ++i_) {                                                                                 \
      __builtin_amdgcn_global_load_lds((const unsigned*)(kb_ + koff[i_]), (LASP unsigned*)(lds + (SLOT) * 16384 + (w * 2 + i_) * 1024), 16, 0, 0);          \
      __builtin_amdgcn_global_load_lds((const unsigned*)(vb_ + voff[i_]), (LASP unsigned*)(lds + 65536 + (SLOT) * 16384 + (w * 2 + i_) * 1024), 16, 0, 0);  \
    } } while (0)
  __syncthreads();
  A_DMA(kt0, 0);
  if (nkt > 1) A_DMA(kt0 + 1, 1);
  if (nkt > 2) A_DMA(kt0 + 2, 2);
  f32x4 O[8][2];
#pragma unroll
  for (int i = 0; i < 8; ++i) { O[i][0] = (f32x4){0.f, 0.f, 0.f, 0.f}; O[i][1] = (f32x4){0.f, 0.f, 0.f, 0.f}; }
  float lsum[2] = {0.f, 0.f};
  const int m7 = (l15 >> 1) & 7;
  const int ko0 = (((0 + quad) ^ m7) << 4), ko1 = (((4 + quad) ^ m7) << 4);
  int slot = 0;
  if (w >= 4) __builtin_amdgcn_s_setprio(1);
  for (int it = 0; it < nkt; ++it) {
    if (it + 2 < nkt) asm volatile("s_waitcnt vmcnt(8)" ::: "memory");
    else if (it + 1 < nkt) asm volatile("s_waitcnt vmcnt(4)" ::: "memory");
    else asm volatile("s_waitcnt vmcnt(0)" ::: "memory");
    __builtin_amdgcn_s_barrier();
    if (it + 3 < nkt) { const int s3 = (slot + 3) & 3; A_DMA(kt0 + it + 3, s3); }
    const LASP unsigned char* Kb = lds + slot * 16384;
    const LASP unsigned char* Vb = lds + 65536 + slot * 16384;
    f32x4 s[4][2];
#pragma unroll
    for (int mt = 0; mt < 4; ++mt) {
      s[mt][0] = (f32x4){-mq[0], -mq[0], -mq[0], -mq[0]};
      s[mt][1] = (f32x4){-mq[1], -mq[1], -mq[1], -mq[1]};
    }
    {
      bf16x8 kf[2][4];
#pragma unroll
      for (int ks = 0; ks < 2; ++ks)
#pragma unroll
        for (int mt = 0; mt < 4; ++mt) kf[ks][mt] = *(const LASP bf16x8*)(Kb + (comp * 64 + mt * 16 + l15) * 128 + (ks ? ko1 : ko0));
      __builtin_amdgcn_sched_barrier(0);
#pragma unroll
      for (int ks = 0; ks < 2; ++ks)
#pragma unroll
        for (int mt = 0; mt < 4; ++mt) {
          s[mt][0] = mfma16(kf[ks][mt], qf[0][ks], s[mt][0]);
          s[mt][1] = mfma16(kf[ks][mt], qf[1][ks], s[mt][1]);
        }
    }
    bf16x8 vf[8][2];
#pragma unroll
    for (int dvt = 0; dvt < 8; ++dvt)
#pragma unroll
      for (int g = 0; g < 2; ++g) vf[dvt][g] = *(const LASP bf16x8*)(Vb + (dvt * 16 + l15) * 128 + (g ? ko1 : ko0));
    __builtin_amdgcn_sched_barrier(0);
    bf16x8 pf[2][2];
#pragma unroll
    for (int qt = 0; qt < 2; ++qt) {
      float ps0 = 0.f, ps1 = 0.f, ps2 = 0.f, ps3 = 0.f;
#pragma unroll
      for (int j = 0; j < 4; ++j) {
        const float e0 = fexp2(s[0][qt][j]), e1 = fexp2(s[1][qt][j]), e2 = fexp2(s[2][qt][j]), e3 = fexp2(s[3][qt][j]);
        s[0][qt][j] = e0; s[1][qt][j] = e1; s[2][qt][j] = e2; s[3][qt][j] = e3;
        ps0 += e0; ps1 += e1; ps2 += e2; ps3 += e3;
      }
      lsum[qt] += (ps0 + ps1) + (ps2 + ps3);
      pf[0][qt] = pack8f(s[0][qt], s[1][qt]);
      pf[1][qt] = pack8f(s[2][qt], s[3][qt]);
    }
#pragma unroll
    for (int dvt = 0; dvt < 8; ++dvt)
#pragma unroll
      for (int g = 0; g < 2; ++g) {
        O[dvt][0] = mfma16(vf[dvt][g], pf[g][0], O[dvt][0]);
        O[dvt][1] = mfma16(vf[dvt][g], pf[g][1], O[dvt][1]);
      }
    slot = (slot + 1) & 3;
  }
#undef A_DMA
  __builtin_amdgcn_s_setprio(0);
  float inv[2];
#pragma unroll
  for (int qt = 0; qt < 2; ++qt) {
    float lt = lsum[qt];
    lt += __shfl_xor(lt, 16);
    lt += __shfl_xor(lt, 32);
    inv[qt] = 1.f / lt;
  }
  __syncthreads();
  float* ex = (float*)ldsg;
  if (comp == 1) {
#pragma unroll
    for (int dvt = 0; dvt < 8; ++dvt)
#pragma unroll
      for (int qt = 0; qt < 2; ++qt)
#pragma unroll
        for (int j = 0; j < 4; ++j) ex[(qp * 64 + (dvt * 2 + qt) * 4 + j) * 64 + lane] = O[dvt][qt][j] * inv[qt] * lam;
  }
  __syncthreads();
  if (comp == 0) {
    const float* sg = p.a_subln_g + l * 128;
#pragma unroll
    for (int qt = 0; qt < 2; ++qt) {
      float ss = 0.f;
#pragma unroll
      for (int dvt = 0; dvt < 8; ++dvt)
#pragma unroll
        for (int j = 0; j < 4; ++j) {
          const float o = O[dvt][qt][j] * inv[qt] - ex[(qp * 64 + (dvt * 2 + qt) * 4 + j) * 64 + lane];
          O[dvt][qt][j] = o;
          ss += o * o;
        }
      ss += __shfl_xor(ss, 16);
      ss += __shfl_xor(ss, 32);
      const float r = rsqrtf(ss * (1.f / 128.f) + EPS_) * (1.f - lam_init);
      u16* dst = p.YS + (qrow0 + qt * 16 + l15) * 2048 + YS_A + h * 128;
#pragma unroll
      for (int u = 0; u < 4; ++u) {
        const int dv0 = u * 32 + quad * 8;
        const float4 g0 = *(const float4*)(sg + dv0), g1 = *(const float4*)(sg + dv0 + 4);
        f32x4 a = O[2 * u][qt], b = O[2 * u + 1][qt];
        a[0] *= r * g0.x; a[1] *= r * g0.y; a[2] *= r * g0.z; a[3] *= r * g0.w;
        b[0] *= r * g1.x; b[1] *= r * g1.y; b[2] *= r * g1.z; b[3] *= r * g1.w;
        *(u32x4*)(dst + dv0) = pack8(a, b);
      }
    }
  }
}

template <bool CTXQ>
DEV void attnC_unit(const Params& p, int l, int bl, int h, int r, float* rpbs) {
  const int t = tid(), lane = t & 63, jw = t >> 6, l15 = lane & 15, quad = lane >> 4;
  constexpr int NG = CTXQ ? 8 : 16;
  constexpr int NL = CTXQ ? 0 : 8;
  if (!CTXQ) {
    __syncthreads();
    for (int i = t; i < 465; i += 256) rpbs[i] = p.c_rpb[(size_t)(l * 8 + h) * 465 + i] * LOG2E;
    __syncthreads();
  }
  const size_t qrow = CTXQ ? (size_t)LR + bl * 256 + r * 64 + jw * 16 + l15 : (size_t)bl * 2048 + r * 64 + jw * 16 + l15;
  bf16x8 qf[2];
#pragma unroll
  for (int ks = 0; ks < 2; ++ks) qf[ks] = *(const bf16x8*)(p.PX + qrow * PXW + PX_CQ + h * 64 + ks * 32 + quad * 8);
  const int rs = min(max(r - 4, 0), 24), band0 = min(max(jw * 16 - 8, 0), 32);
  const int kk = (l15 >> 2) * 8 + (l15 & 3);
  f32x4 s[NG][2];
#pragma unroll
  for (int g = 0; g < NG; ++g) {
    size_t krow;
    if (g < NL) krow = (size_t)bl * 2048 + (rs + g) * 64 + band0 + kk;
    else krow = (size_t)LR + bl * 256 + (g - NL) * 32 + kk;
#pragma unroll
    for (int hf = 0; hf < 2; ++hf) {
      const u16* kp = p.PX + (krow + hf * 4) * PXW + PX_CK + h * 64 + quad * 8;
      const bf16x8 k0 = *(const bf16x8*)kp, k1 = *(const bf16x8*)(kp + 32);
      f32x4 a = (f32x4){0.f, 0.f, 0.f, 0.f};
      a = mfma16(k0, qf[0], a);
      a = mfma16(k1, qf[1], a);
      s[g][hf] = a;
    }
  }
  if (!CTXQ) {
    const int qc = jw * 16 + l15;
    const int win0 = min(max(qc - 8, 0), 48);
#pragma unroll
    for (int g = 0; g < NL; ++g) {
      const int ri = (rs + g - r + 7) * 31;
#pragma unroll
      for (int hf = 0; hf < 2; ++hf)
#pragma unroll
        for (int j = 0; j < 4; ++j) {
          const int kc = band0 + quad * 8 + hf * 4 + j;
          const bool valid = (kc >= win0) && (kc < win0 + 16);
          const int dc = min(max(kc - qc + 15, 0), 30);
          const float bias = rpbs[ri + dc];
          s[g][hf][j] = valid ? s[g][hf][j] + bias : -INFINITY;
        }
    }
  }
  float mx = -INFINITY;
#pragma unroll
  for (int g = 0; g < NG; ++g)
#pragma unroll
    for (int hf = 0; hf < 2; ++hf)
#pragma unroll
      for (int j = 0; j < 4; ++j) mx = fmaxf(mx, s[g][hf][j]);
  mx = fmaxf(mx, __shfl_xor(mx, 16));
  mx = fmaxf(mx, __shfl_xor(mx, 32));
  float ls = 0.f;
#pragma unroll
  for (int g = 0; g < NG; ++g)
#pragma unroll
    for (int hf = 0; hf < 2; ++hf)
#pragma unroll
      for (int j = 0; j < 4; ++j) { const float e = fexp2(s[g][hf][j] - mx); s[g][hf][j] = e; ls += e; }
  ls += __shfl_xor(ls, 16);
  ls += __shfl_xor(ls, 32);
  f32x4 O[4];
#pragma unroll
  for (int i = 0; i < 4; ++i) O[i] = (f32x4){0.f, 0.f, 0.f, 0.f};
#pragma unroll
  for (int g = 0; g < NG; ++g) {
    const int keybase = (g < NL) ? (rs + g) * 64 + band0 : 2048 + (g - NL) * 32;
    const bf16x8 pf = pack8f(s[g][0], s[g][1]);
#pragma unroll
    for (int dvt = 0; dvt < 4; ++dvt) {
      const int dv = (dvt >> 1) * 32 + (l15 >> 2) * 8 + (dvt & 1) * 4 + (l15 & 3);
      const bf16x8 vf = *(const bf16x8*)(p.VTC + ((size_t)((bl * 8 + h) * 64 + dv)) * KV + keybase + quad * 8);
      O[dvt] = mfma16(vf, pf, O[dvt]);
    }
  }
  const float inv = 1.f / ls;
  u16* dst = p.YS + qrow * 2048 + YS_C + h * 64;
#pragma unroll
  for (int u = 0; u < 2; ++u) {
    f32x4 a = O[2 * u] * inv, b = O[2 * u + 1] * inv;
    *(u32x4*)(dst + u * 32 + quad * 8) = pack8(a, b);
  }
}

template <int WH>
DEV void pool_rows(const u16* __restrict__ pb, u16* Ys, int tt, int seg, int ch, int L) {
  constexpr int NR = 8 + 2 * WH - 1;
  const int ts0 = tt * 128 + seg * 8;
  u32x4 rows[NR];
#pragma unroll
  for (int j = 0; j < NR; ++j) {
    const int tk = ts0 - WH + j;
    const int tkc = min(max(tk, 0), L - 1);
    rows[j] = *(const u32x4*)(pb + (size_t)tkc * PXW);
    if (tk < 0 || tk >= L) rows[j] = (u32x4){0u, 0u, 0u, 0u};
  }
  float a[8];
#pragma unroll
  for (int e = 0; e < 8; ++e) a[e] = 0.f;
#pragma unroll
  for (int j = 0; j < 2 * WH; ++j) {
    const u32x4 q = rows[j];
    a[0] += bflo(q.x); a[1] += bfhi(q.x); a[2] += bflo(q.y); a[3] += bfhi(q.y);
    a[4] += bflo(q.z); a[5] += bfhi(q.z); a[6] += bflo(q.w); a[7] += bfhi(q.w);
  }
#pragma unroll
  for (int i = 0; i < 8; ++i) {
    const int tl = seg * 8 + i, ts = ts0 + i;
    const int lo = max(ts - WH, 0), hi = min(ts + WH, L);
    const float ic = 1.f / (float)(hi - lo);
    const u32x4 own = rows[i + WH];
    u32x4 o;
    o.x = cvt_pk(a[0] * ic - bflo(own.x), a[1] * ic - bfhi(own.x));
    o.y = cvt_pk(a[2] * ic - bflo(own.y), a[3] * ic - bfhi(own.y));
    o.z = cvt_pk(a[4] * ic - bflo(own.z), a[5] * ic - bfhi(own.z));
    o.w = cvt_pk(a[6] * ic - bflo(own.w), a[7] * ic - bfhi(own.w));
    *(u32x4*)(Ys + perm32(tl) * 136 + ch * 8) = o;
    if (i < 7) {
      const u32x4 q0 = rows[i], q1 = rows[i + 2 * WH];
      a[0] += bflo(q1.x) - bflo(q0.x); a[1] += bfhi(q1.x) - bfhi(q0.x); a[2] += bflo(q1.y) - bflo(q0.y); a[3] += bfhi(q1.y) - bfhi(q0.y);
      a[4] += bflo(q1.z) - bflo(q0.z); a[5] += bfhi(q1.z) - bfhi(q0.z); a[6] += bflo(q1.w) - bflo(q0.w); a[7] += bfhi(q1.w) - bfhi(q0.w);
    }
  }
}

template <int ST>
DEV void attnC_stage_load(const Params& p, int bl, int h, int rs, u32x4 (&rg)[8]) {
  const int t = tid();
  if (ST < 3) {
    const size_t rowbase = ST == 2 ? (size_t)LR + bl * 256 : (size_t)bl * 2048 + rs * 64 + ST * 256;
    const u16* b = p.PX + rowbase * PXW + PX_CK + h * 64;
    const unsigned o = (unsigned)((t >> 3) * PXW + (t & 7) * 8);
#pragma unroll
    for (int i = 0; i < 8; ++i) rg[i] = *(const u32x4*)((b + (size_t)(32 * i) * PXW) + o);
  } else {
    const int keybase = ST == 5 ? 2048 : rs * 64 + (ST - 3) * 256;
    const u16* b = p.VTC + ((size_t)((bl * 8 + h) * 64)) * KV + keybase;
    const unsigned o = (unsigned)((t >> 5) * KV + (t & 31) * 8);
#pragma unroll
    for (int i = 0; i < 8; ++i) rg[i] = *(const u32x4*)((b + (size_t)(8 * i) * KV) + o);
  }
}
template <int ST>
DEV void attnC_stage_store(u16* buf, const u32x4 (&rg)[8]) {
  const int t = tid();
  if (ST < 3) {
#pragma unroll
    for (int i = 0; i < 8; ++i) {
      const int row = (t >> 3) + 32 * i, c = t & 7, key = ((row >> 3) & 3) * 2 + ((row >> 1) & 1);
      *(u32x4*)(buf + row * 64 + ((c ^ key) << 3)) = rg[i];
    }
  } else {
#pragma unroll
    for (int i = 0; i < 8; ++i) {
      const int dv = (t >> 5) + 8 * i, c = t & 31, key = ((dv >> 3) & 3) * 4 + (dv & 3);
      *(u32x4*)(buf + dv * 256 + ((c ^ key) << 3)) = rg[i];
    }
  }
}
DEV bf16x8 attnC_kfrag(const u16* buf, int row, int chunk) {
  const int key = ((row >> 3) & 3) * 2 + ((row >> 1) & 1);
  return *(const bf16x8*)(buf + row * 64 + ((chunk ^ key) << 3));
}
DEV bf16x8 attnC_vfrag(const u16* buf, int dv, int chunk) {
  const int key = ((dv >> 3) & 3) * 4 + (dv & 3);
  return *(const bf16x8*)(buf + dv * 256 + ((chunk ^ key) << 3));
}

DEV void attnC_lds_unit(const Params& p, int l, int bl, int h, int r, u16* lds) {
  const int t = tid(), lane = t & 63, jw = t >> 6, l15 = lane & 15, quad = lane >> 4;
  u16* buf0 = lds;
  u16* buf1 = lds + 16384;
  float* rpbs = (float*)(lds + 32768);
  const int rs = min(max(r - 4, 0), 24), band0 = min(max(jw * 16 - 8, 0), 32);
  const int kk = (l15 >> 2) * 8 + (l15 & 3);
  u32x4 rg[8];
  attnC_stage_load<0>(p, bl, h, rs, rg);
  __syncthreads();
  for (int i = t; i < 465; i += 256) rpbs[i] = p.c_rpb[(size_t)(l * 8 + h) * 465 + i] * LOG2E;
  attnC_stage_store<0>(buf0, rg);
  attnC_stage_load<1>(p, bl, h, rs, rg);
  const size_t qrow = (size_t)bl * 2048 + r * 64 + jw * 16 + l15;
  bf16x8 qf[2];
#pragma unroll
  for (int ks = 0; ks < 2; ++ks) qf[ks] = *(const bf16x8*)(p.PX + qrow * PXW + PX_CQ + h * 64 + ks * 32 + quad * 8);
  __syncthreads();
  f32x4 s[16][2];
  f32x4 O[4];
#pragma unroll
  for (int i = 0; i < 4; ++i) O[i] = (f32x4){0.f, 0.f, 0.f, 0.f};
  float ls = 0.f;
#pragma unroll
  for (int st = 0; st < 2; ++st) {
    const u16* buf = st ? buf1 : buf0;
#pragma unroll
    for (int hf = 0; hf < 2; ++hf) {
      bf16x8 kf[4][2];
#pragma unroll
      for (int kr = 0; kr < 4; ++kr) {
        const int row = kr * 64 + band0 + kk + hf * 4;
        kf[kr][0] = attnC_kfrag(buf, row, quad);
        kf[kr][1] = attnC_kfrag(buf, row, 4 + quad);
      }
#pragma unroll
      for (int kr = 0; kr < 4; ++kr) {
        f32x4 a = (f32x4){0.f, 0.f, 0.f, 0.f};
        a = mfma16(kf[kr][0], qf[0], a);
        a = mfma16(kf[kr][1], qf[1], a);
        s[st * 4 + kr][hf] = a;
      }
    }
    if (st == 0) { attnC_stage_store<1>(buf1, rg); attnC_stage_load<2>(p, bl, h, rs, rg); }
    else { attnC_stage_store<2>(buf0, rg); attnC_stage_load<3>(p, bl, h, rs, rg); }
    __syncthreads();
  }
  {
#pragma unroll
    for (int gh = 0; gh < 4; ++gh) {
      bf16x8 kf[4][2];
#pragma unroll
      for (int i = 0; i < 4; ++i) {
        const int g = gh * 2 + (i >> 1), hf = i & 1;
        const int row = g * 32 + kk + hf * 4;
        kf[i][0] = attnC_kfrag(buf0, row, quad);
        kf[i][1] = attnC_kfrag(buf0, row, 4 + quad);
      }
#pragma unroll
      for (int i = 0; i < 4; ++i) {
        f32x4 a = (f32x4){0.f, 0.f, 0.f, 0.f};
        a = mfma16(kf[i][0], qf[0], a);
        a = mfma16(kf[i][1], qf[1], a);
        s[8 + gh * 2 + (i >> 1)][i & 1] = a;
      }
    }
    attnC_stage_store<3>(buf1, rg);
    attnC_stage_load<4>(p, bl, h, rs, rg);
    const int qc = jw * 16 + l15;
    const int win0 = min(max(qc - 8, 0), 48);
#pragma unroll
    for (int g = 0; g < 8; ++g) {
      const int ri = (rs + g - r + 7) * 31;
#pragma unroll
      for (int hf = 0; hf < 2; ++hf)
#pragma unroll
        for (int j = 0; j < 4; ++j) {
          const int kc = band0 + quad * 8 + hf * 4 + j;
          const bool valid = (kc >= win0) && (kc < win0 + 16);
          const int dc = min(max(kc - qc + 15, 0), 30);
          const float bias = rpbs[ri + dc];
          s[g][hf][j] = valid ? s[g][hf][j] + bias : -INFINITY;
        }
    }
    float mx = -INFINITY;
#pragma unroll
    for (int g = 0; g < 16; ++g)
#pragma unroll
      for (int hf = 0; hf < 2; ++hf)
#pragma unroll
        for (int j = 0; j < 4; ++j) mx = fmaxf(mx, s[g][hf][j]);
    mx = fmaxf(mx, __shfl_xor(mx, 16));
    mx = fmaxf(mx, __shfl_xor(mx, 32));
#pragma unroll
    for (int g = 0; g < 16; ++g)
#pragma unroll
      for (int hf = 0; hf < 2; ++hf)
#pragma unroll
        for (int j = 0; j < 4; ++j) { const float e = fexp2(s[g][hf][j] - mx); s[g][hf][j] = e; ls += e; }
    ls += __shfl_xor(ls, 16);
    ls += __shfl_xor(ls, 32);
    __syncthreads();
  }
#pragma unroll
  for (int st = 0; st < 2; ++st) {
    const u16* buf = st ? buf0 : buf1;
#pragma unroll
    for (int kh = 0; kh < 2; ++kh) {
      bf16x8 vf[2][4];
#pragma unroll
      for (int k2 = 0; k2 < 2; ++k2) {
        const int c = (kh * 2 + k2) * 8 + (band0 >> 3) + quad;
#pragma unroll
        for (int dvt = 0; dvt < 4; ++dvt) {
          const int dv = (dvt >> 1) * 32 + (l15 >> 2) * 8 + (dvt & 1) * 4 + (l15 & 3);
          vf[k2][dvt] = attnC_vfrag(buf, dv, c);
        }
      }
#pragma unroll
      for (int k2 = 0; k2 < 2; ++k2) {
        const int kr = kh * 2 + k2;
        const bf16x8 pf = pack8f(s[st * 4 + kr][0], s[st * 4 + kr][1]);
#pragma unroll
        for (int dvt = 0; dvt < 4; ++dvt) O[dvt] = mfma16(vf[k2][dvt], pf, O[dvt]);
      }
    }
    if (st == 0) { attnC_stage_store<4>(buf0, rg); attnC_stage_load<5>(p, bl, h, rs, rg); }
    else { attnC_stage_store<5>(buf1, rg); }
    __syncthreads();
  }
#pragma unroll
  for (int gh = 0; gh < 4; ++gh) {
    bf16x8 vf[2][4];
#pragma unroll
    for (int k2 = 0; k2 < 2; ++k2) {
      const int c = (gh * 2 + k2) * 4 + quad;
#pragma unroll
      for (int dvt = 0; dvt < 4; ++dvt) {
        const int dv = (dvt >> 1) * 32 + (l15 >> 2) * 8 + (dvt & 1) * 4 + (l15 & 3);
        vf[k2][dvt] = attnC_vfrag(buf1, dv, c);
      }
    }
#pragma unroll
    for (int k2 = 0; k2 < 2; ++k2) {
      const int g = gh * 2 + k2;
      const bf16x8 pf = pack8f(s[8 + g][0], s[8 + g][1]);
#pragma unroll
      for (int dvt = 0; dvt < 4; ++dvt) O[dvt] = mfma16(vf[k2][dvt], pf, O[dvt]);
    }
  }
  const float inv = 1.f / ls;
  u16* dst = p.YS + qrow * 2048 + YS_C + h * 64;
#pragma unroll
  for (int u = 0; u < 2; ++u) {
    f32x4 a = O[2 * u] * inv, b = O[2 * u + 1] * inv;
    *(u32x4*)(dst + u * 32 + quad * 8) = pack8(a, b);
  }
}

template <int ST>
DEV void c2_load(const Params& p, int bl, int h, int base, u32x4 (&rg)[4]) {
  const int t = ptid();
  if (ST < 3) {
    const u16* b = p.PX + (size_t)bl * 2048 * PXW + PX_CK + h * 64;
#pragma unroll
    for (int i = 0; i < 3; ++i) {
      const int id = t + 512 * i, key = id >> 3, c = id & 7;
      const int row = min(base + ST * 3 + (key >> 6), 31);
      rg[i] = *(const u32x4*)(b + (size_t)(row * 64 + (key & 63)) * PXW + c * 8);
    }
  } else if (ST == 3) {
    const u16* b = p.PX + ((size_t)LR + bl * 256) * PXW + PX_CK + h * 64;
    const unsigned o = (unsigned)((t >> 3) * PXW + (t & 7) * 8);
#pragma unroll
    for (int i = 0; i < 4; ++i) rg[i] = *(const u32x4*)((b + (size_t)(64 * i) * PXW) + o);
  } else if (ST < 7) {
    const u16* b = p.VTC + ((size_t)((bl * 8 + h) * 64)) * KV + (base + (ST - 4) * 3) * 64;
#pragma unroll
    for (int i = 0; i < 3; ++i) {
      const int id = t + 512 * i, dv = id / 24, c = id - dv * 24;
      rg[i] = *(const u32x4*)(b + (size_t)dv * KV + c * 8);
    }
  } else {
    const u16* b = p.VTC + ((size_t)((bl * 8 + h) * 64)) * KV + 2048;
    const unsigned o = (unsigned)((t >> 5) * KV + (t & 31) * 8);
#pragma unroll
    for (int i = 0; i < 4; ++i) rg[i] = *(const u32x4*)((b + (size_t)(16 * i) * KV) + o);
  }
}
template <int ST>
DEV void c2_store(u16* buf, const u32x4 (&rg)[4]) {
  const int t = ptid();
  if (ST <= 3) {
    constexpr int N = (ST == 3) ? 4 : 3;
#pragma unroll
    for (int i = 0; i < N; ++i) {
      const int id = t + 512 * i, row = id >> 3, c = id & 7, key = ((row >> 3) & 3) * 2 + ((row >> 1) & 1);
      *(u32x4*)(buf + row * 64 + ((c ^ key) << 3)) = rg[i];
    }
  } else if (ST < 7) {
#pragma unroll
    for (int i = 0; i < 3; ++i) {
      const int id = t + 512 * i, dv = id / 24, c = id - dv * 24, key = ((dv >> 3) & 3) * 4 + (dv & 3);
      *(u32x4*)(buf + dv * 256 + ((c ^ key) << 3)) = rg[i];
    }
  } else {
#pragma unroll
    for (int i = 0; i < 4; ++i) {
      const int id = t + 512 * i, dv = id >> 5, c = id & 31, key = ((dv >> 3) & 3) * 4 + (dv & 3);
      *(u32x4*)(buf + dv * 256 + ((c ^ key) << 3)) = rg[i];
    }
  }
}
DEV bf16x8 c2k(const LASP unsigned char* buf, int row, int chunk) {
  const int key = ((row >> 3) & 3) * 2 + ((row >> 1) & 1);
  return *(const LASP bf16x8*)(buf + row * 128 + ((chunk ^ key) << 4));
}
DEV bf16x8 c2v(const LASP unsigned char* buf, int dv, int chunk) {
  const int key = ((dv >> 3) & 3) * 4 + (dv & 3);
  return *(const LASP bf16x8*)(buf + dv * 512 + ((chunk ^ key) << 4));
}
template <int ST>
DEV void c2_dma(const Params& p, int bl, int h, int base, LASP unsigned char* slot, int w, int lane) {
  if (ST <= 3) {
    constexpr int NB = (ST == 3) ? 4 : 3;
#pragma unroll
    for (int i = 0; i < NB; ++i) {
      const int b = w * NB + i;
      const int row = b * 8 + (lane >> 3), c = (lane & 7) ^ (((row >> 3) & 3) * 2 + ((row >> 1) & 1));
      const u16* src;
      if (ST < 3) {
        const int grow = min(base + ST * 3 + (row >> 6), 31);
        src = p.PX + ((size_t)bl * 2048 + grow * 64 + (row & 63)) * PXW + PX_CK + h * 64 + c * 8;
      } else {
        src = p.PX + ((size_t)LR + bl * 256 + row) * PXW + PX_CK + h * 64 + c * 8;
      }
      __builtin_amdgcn_global_load_lds((const unsigned*)src, (LASP unsigned*)(slot + b * 1024), 16, 0, 0);
    }
  } else {
#pragma unroll
    for (int i = 0; i < 4; ++i) {
      const int b = w * 4 + i;
      const int dv = b * 2 + (lane >> 5);
      int c = (lane & 31) ^ (((dv >> 3) & 3) * 4 + (dv & 3));
      const u16* vb = p.VTC + ((size_t)((bl * 8 + h) * 64 + dv)) * KV;
      const u16* src;
      if (ST < 7) { if (c >= 24) c -= 8; src = vb + (base + (ST - 4) * 3) * 64 + c * 8; }
      else src = vb + 2048 + c * 8;
      __builtin_amdgcn_global_load_lds((const unsigned*)src, (LASP unsigned*)(slot + b * 1024), 16, 0, 0);
    }
  }
}
template <int K3>
DEV void c2_kloc(const LASP unsigned char* buf, f32x4 (&sl)[9][2], const bf16x8 (&qf)[2], int band0, int kk, int quad) {
#pragma unroll
  for (int hf = 0; hf < 2; ++hf) {
    bf16x8 kf[3][2];
#pragma unroll
    for (int i = 0; i < 3; ++i) {
      const int row = i * 64 + band0 + kk + hf * 4;
      kf[i][0] = c2k(buf, row, quad);
      kf[i][1] = c2k(buf, row, 4 + quad);
    }
#pragma unroll
    for (int i = 0; i < 3; ++i) {
      f32x4 a = (f32x4){0.f, 0.f, 0.f, 0.f};
      a = mfma16(kf[i][0], qf[0], a);
      a = mfma16(kf[i][1], qf[1], a);
      sl[K3 * 3 + i][hf] = a;
    }
  }
}
template <int K3>
DEV void c2_vloc(const LASP unsigned char* buf, f32x4 (&sl)[9][2], f32x4 (&O)[4], int band0, int l15, int quad) {
  bf16x8 vf[3][4];
#pragma unroll
  for (int i = 0; i < 3; ++i) {
    const int c = i * 8 + (band0 >> 3) + quad;
#pragma unroll
    for (int dvt = 0; dvt < 4; ++dvt) {
      const int dv = (dvt >> 1) * 32 + (l15 >> 2) * 8 + (dvt & 1) * 4 + (l15 & 3);
      vf[i][dvt] = c2v(buf, dv, c);
    }
  }
#pragma unroll
  for (int i = 0; i < 3; ++i) {
    const bf16x8 pf = pack8f(sl[K3 * 3 + i][0], sl[K3 * 3 + i][1]);
#pragma unroll
    for (int dvt = 0; dvt < 4; ++dvt) O[dvt] = mfma16(vf[i][dvt], pf, O[dvt]);
  }
}

DEV void attnC2_unit(const Params& p, int l, int bl, int h, int rp, u16* ldsg) {
  const int t = ptid(), lane = t & 63, w = __builtin_amdgcn_readfirstlane(t >> 6), l15 = lane & 15, quad = lane >> 4;
  const int qr = w >> 2, jw = w & 3;
  LASP unsigned char* L = (LASP unsigned char*)ldsg;
  float* rpbs = (float*)(ldsg + 65536);
  const int r0 = rp * 2;
  const int base = min(max(r0 - 4, 0), 24);
  const int d = qr ? (min(max(r0 - 3, 0), 24) - base) : 0;
  const int r = r0 + qr;
  const int band0 = min(max(jw * 16 - 8, 0), 32);
  const int kk = (l15 >> 2) * 8 + (l15 & 3);
#define C2_WAIT(n) asm volatile("s_waitcnt vmcnt(" #n ")" ::: "memory")
  __syncthreads();
  for (int i = t; i < 465; i += 512) rpbs[i] = p.c_rpb[(size_t)(l * 8 + h) * 465 + i] * LOG2E;
  const size_t qrow = (size_t)bl * 2048 + r * 64 + jw * 16 + l15;
  bf16x8 qf[2];
#pragma unroll
  for (int ks = 0; ks < 2; ++ks) qf[ks] = *(const bf16x8*)(p.PX + qrow * PXW + PX_CQ + h * 64 + ks * 32 + quad * 8);
  c2_dma<0>(p, bl, h, base, L, w, lane);
  c2_dma<1>(p, bl, h, base, L + 32768, w, lane);
  c2_dma<2>(p, bl, h, base, L + 65536, w, lane);
  f32x4 sl[9][2], sc[8][2];
  f32x4 O[4];
#pragma unroll
  for (int i = 0; i < 4; ++i) O[i] = (f32x4){0.f, 0.f, 0.f, 0.f};
  float ls = 0.f;
  asm volatile("s_waitcnt lgkmcnt(0)" ::: "memory");
  C2_WAIT(6); __builtin_amdgcn_s_barrier();
  c2_dma<3>(p, bl, h, base, L + 98304, w, lane);
  c2_kloc<0>(L, sl, qf, band0, kk, quad);
  C2_WAIT(7); __builtin_amdgcn_s_barrier();
  c2_dma<4>(p, bl, h, base, L, w, lane);
  c2_kloc<1>(L + 32768, sl, qf, band0, kk, quad);
  C2_WAIT(8); __builtin_amdgcn_s_barrier();
  c2_dma<5>(p, bl, h, base, L + 32768, w, lane);
  c2_kloc<2>(L + 65536, sl, qf, band0, kk, quad);
  C2_WAIT(8); __builtin_amdgcn_s_barrier();
  c2_dma<6>(p, bl, h, base, L + 65536, w, lane);
  {
#pragma unroll
    for (int gh = 0; gh < 4; ++gh) {
      bf16x8 kf[4][2];
#pragma unroll
      for (int i = 0; i < 4; ++i) {
        const int g = gh * 2 + (i >> 1), hf = i & 1;
        const int row = g * 32 + kk + hf * 4;
        kf[i][0] = c2k(L + 98304, row, quad);
        kf[i][1] = c2k(L + 98304, row, 4 + quad);
      }
#pragma unroll
      for (int i = 0; i < 4; ++i) {
        f32x4 a = (f32x4){0.f, 0.f, 0.f, 0.f};
        a = mfma16(kf[i][0], qf[0], a);
        a = mfma16(kf[i][1], qf[1], a);
        sc[gh * 2 + (i >> 1)][i & 1] = a;
      }
    }
    const int qc = jw * 16 + l15;
    const int win0 = min(max(qc - 8, 0), 48);
#pragma unroll
    for (int a = 0; a < 9; ++a) {
      const bool rowvalid = (a >= d) && (a < d + 8);
      const int ri = min(max(base + a - r + 7, 0), 14) * 31;
#pragma unroll
      for (int hf = 0; hf < 2; ++hf)
#pragma unroll
        for (int j = 0; j < 4; ++j) {
          const int kc = band0 + quad * 8 + hf * 4 + j;
          const bool valid = rowvalid && (kc >= win0) && (kc < win0 + 16);
          const int dc = min(max(kc - qc + 15, 0), 30);
          const float bias = rpbs[ri + dc];
          sl[a][hf][j] = valid ? sl[a][hf][j] + bias : -INFINITY;
        }
    }
    float mx = -INFINITY;
#pragma unroll
    for (int a = 0; a < 9; ++a)
#pragma unroll
      for (int hf = 0; hf < 2; ++hf)
#pragma unroll
        for (int j = 0; j < 4; ++j) mx = fmaxf(mx, sl[a][hf][j]);
#pragma unroll
    for (int g = 0; g < 8; ++g)
#pragma unroll
      for (int hf = 0; hf < 2; ++hf)
#pragma unroll
        for (int j = 0; j < 4; ++j) mx = fmaxf(mx, sc[g][hf][j]);
    mx = fmaxf(mx, __shfl_xor(mx, 16));
    mx = fmaxf(mx, __shfl_xor(mx, 32));
#pragma unroll
    for (int a = 0; a < 9; ++a)
#pragma unroll
      for (int hf = 0; hf < 2; ++hf)
#pragma unroll
        for (int j = 0; j < 4; ++j) { const float e = fexp2(sl[a][hf][j] - mx); sl[a][hf][j] = e; ls += e; }
#pragma unroll
    for (int g = 0; g < 8; ++g)
#pragma unroll
      for (int hf = 0; hf < 2; ++hf)
#pragma unroll
        for (int j = 0; j < 4; ++j) { const float e = fexp2(sc[g][hf][j] - mx); sc[g][hf][j] = e; ls += e; }
    ls += __shfl_xor(ls, 16);
    ls += __shfl_xor(ls, 32);
  }
  C2_WAIT(8); __builtin_amdgcn_s_barrier();
  c2_dma<7>(p, bl, h, base, L + 98304, w, lane);
  c2_vloc<0>(L, sl, O, band0, l15, quad);
  C2_WAIT(8); __builtin_amdgcn_s_barrier();
  c2_vloc<1>(L + 32768, sl, O, band0, l15, quad);
  C2_WAIT(4); __builtin_amdgcn_s_barrier();
  c2_vloc<2>(L + 65536, sl, O, band0, l15, quad);
  C2_WAIT(0); __builtin_amdgcn_s_barrier();
#pragma unroll
  for (int gh = 0; gh < 4; ++gh) {
    bf16x8 vf[2][4];
#pragma unroll
    for (int k2 = 0; k2 < 2; ++k2) {
      const int c = (gh * 2 + k2) * 4 + quad;
#pragma unroll
      for (int dvt = 0; dvt < 4; ++dvt) {
        const int dv = (dvt >> 1) * 32 + (l15 >> 2) * 8 + (dvt & 1) * 4 + (l15 & 3);
        vf[k2][dvt] = c2v(L + 98304, dv, c);
      }
    }
#pragma unroll
    for (int k2 = 0; k2 < 2; ++k2) {
      const int g = gh * 2 + k2;
      const bf16x8 pf = pack8f(sc[g][0], sc[g][1]);
#pragma unroll
      for (int dvt = 0; dvt < 4; ++dvt) O[dvt] = mfma16(vf[k2][dvt], pf, O[dvt]);
    }
  }
#undef C2_WAIT
  const float inv = 1.f / ls;
  u16* dst = p.YS + qrow * 2048 + YS_C + h * 64;
#pragma unroll
  for (int u = 0; u < 2; ++u) {
    f32x4 a = O[2 * u] * inv, b = O[2 * u + 1] * inv;
    *(u32x4*)(dst + u * 32 + quad * 8) = pack8(a, b);
  }
}

DEV void attnC2_ctx_unit(const Params& p, int l, int bl, int h, int hq, u16* lds) {
  const int t = ptid(), lane = t & 63, w = t >> 6, l15 = lane & 15, quad = lane >> 4;
  u16* buf0 = lds;
  u16* buf1 = lds + 16384;
  const int kk = (l15 >> 2) * 8 + (l15 & 3);
  u32x4 rg[4];
  c2_load<3>(p, bl, h, 0, rg);
  __syncthreads();
  c2_store<3>(buf0, rg);
  c2_load<7>(p, bl, h, 0, rg);
  const size_t qrow = (size_t)LR + bl * 256 + hq * 128 + w * 16 + l15;
  bf16x8 qf[2];
#pragma unroll
  for (int ks = 0; ks < 2; ++ks) qf[ks] = *(const bf16x8*)(p.PX + qrow * PXW + PX_CQ + h * 64 + ks * 32 + quad * 8);
  __syncthreads();
  f32x4 sc[8][2];
#pragma unroll
  for (int gh = 0; gh < 4; ++gh) {
    bf16x8 kf[4][2];
#pragma unroll
    for (int i = 0; i < 4; ++i) {
      const int g = gh * 2 + (i >> 1), hf = i & 1;
      const int row = g * 32 + kk + hf * 4;
      kf[i][0] = attnC_kfrag(buf0, row, quad);
      kf[i][1] = attnC_kfrag(buf0, row, 4 + quad);
    }
#pragma unroll
    for (int i = 0; i < 4; ++i) {
      f32x4 a = (f32x4){0.f, 0.f, 0.f, 0.f};
      a = mfma16(kf[i][0], qf[0], a);
      a = mfma16(kf[i][1], qf[1], a);
      sc[gh * 2 + (i >> 1)][i & 1] = a;
    }
  }
  c2_store<7>(buf1, rg);
  float mx = -INFINITY, ls = 0.f;
#pragma unroll
  for (int g = 0; g < 8; ++g)
#pragma unroll
    for (int hf = 0; hf < 2; ++hf)
#pragma unroll
      for (int j = 0; j < 4; ++j) mx = fmaxf(mx, sc[g][hf][j]);
  mx = fmaxf(mx, __shfl_xor(mx, 16));
  mx = fmaxf(mx, __shfl_xor(mx, 32));
#pragma unroll
  for (int g = 0; g < 8; ++g)
#pragma unroll
    for (int hf = 0; hf < 2; ++hf)
#pragma unroll
      for (int j = 0; j < 4; ++j) { const float e = fexp2(sc[g][hf][j] - mx); sc[g][hf][j] = e; ls += e; }
  ls += __shfl_xor(ls, 16);
  ls += __shfl_xor(ls, 32);
  __syncthreads();
  f32x4 O[4];
#pragma unroll
  for (int i = 0; i < 4; ++i) O[i] = (f32x4){0.f, 0.f, 0.f, 0.f};
#pragma unroll
  for (int gh = 0; gh < 4; ++gh) {
    bf16x8 vf[2][4];
#pragma unroll
    for (int k2 = 0; k2 < 2; ++k2) {
      const int c = (gh * 2 + k2) * 4 + quad;
#pragma unroll
      for (int dvt = 0; dvt < 4; ++dvt) {
        const int dv = (dvt >> 1) * 32 + (l15 >> 2) * 8 + (dvt & 1) * 4 + (l15 & 3);
        vf[k2][dvt] = attnC_vfrag(buf1, dv, c);
      }
    }
#pragma unroll
    for (int k2 = 0; k2 < 2; ++k2) {
      const int g = gh * 2 + k2;
      const bf16x8 pf = pack8f(sc[g][0], sc[g][1]);
#pragma unroll
      for (int dvt = 0; dvt < 4; ++dvt) O[dvt] = mfma16(vf[k2][dvt], pf, O[dvt]);
    }
  }
  const float inv = 1.f / ls;
  u16* dst = p.YS + qrow * 2048 + YS_C + h * 64;
#pragma unroll
  for (int u = 0; u < 2; ++u) {
    f32x4 a = O[2 * u] * inv, b = O[2 * u + 1] * inv;
    *(u32x4*)(dst + u * 32 + quad * 8) = pack8(a, b);
  }
}

DEV void poolB_unit(const Params& p, int l, int bl, int tt, int g, bool isc, u16* lds) {
  const int t = tid(), lane = t & 63, w = t >> 6, l15 = lane & 15, quad = lane >> 4, wx = w & 1, wy = w >> 1;
  u16* Xs = lds;
  u16* Ys = lds + 128 * 136;
  const int L = isc ? 256 : 2048;
  const size_t rowbase = isc ? (size_t)LR + bl * 256 : (size_t)bl * 2048;
  const int wh = 1 << g;
  __syncthreads();
  {
    const int ch = t & 15, seg = t >> 4;
    const u16* pb = p.PX + rowbase * PXW + PX_B + g * 128 + ch * 8;
    switch (g) {
      case 0: pool_rows<1>(pb, Ys, tt, seg, ch, L); break;
      case 1: pool_rows<2>(pb, Ys, tt, seg, ch, L); break;
      case 2: pool_rows<4>(pb, Ys, tt, seg, ch, L); break;
      default: pool_rows<8>(pb, Ys, tt, seg, ch, L); break;
    }
    const u16* wp = p.WPOOL + (size_t)(l * 4 + g) * 16384;
#pragma unroll
    for (int i = 0; i < 8; ++i) {
      const int id = t + 256 * i, d = id >> 4, c8 = id & 15;
      *(u32x4*)(Xs + perm32(d) * 136 + c8 * 8) = *(const u32x4*)(wp + d * 128 + c8 * 8);
    }
  }
  __syncthreads();
  f32x4 acc[4][4];
  zero_acc(acc);
  wave_mma<4, 136>(Xs, Ys, acc, wx, wy, l15, quad);
  const float* sp = p.b_pool_s + l * 512 + g * 128;
#pragma unroll
  for (int yt = 0; yt < 4; ++yt) {
    const size_t row = rowbase + tt * 128 + yidx(wy, yt, l15);
#pragma unroll
    for (int u = 0; u < 2; ++u) {
      const int x0 = xidx(wx, u, quad);
      const float4 s0 = *(const float4*)(sp + x0), s1 = *(const float4*)(sp + x0 + 4);
      f32x4 a = acc[2 * u][yt], b = acc[2 * u + 1][yt];
      a[0] *= s0.x; a[1] *= s0.y; a[2] *= s0.z; a[3] *= s0.w;
      b[0] *= s1.x; b[1] *= s1.y; b[2] *= s1.z; b[3] *= s1.w;
      *(u32x4*)(p.YS + row * 2048 + YS_B + g * 128 + x0) = pack8(a, b);
    }
  }
}

DEV void gateD_unit(const Params& p, int l, int bl, int n, int g, bool isc, u16* lds) {
  const int t = tid(), lane = t & 63, w = t >> 6, l15 = lane & 15, quad = lane >> 4, wx = w & 1, wy = w >> 1;
  u16* Xs = lds;
  u16* Ys = lds + 128 * 136;
  float* rr = (float*)(lds + 2 * 128 * 136);
  const size_t rowbase = (isc ? (size_t)LR + bl * 256 : (size_t)bl * 2048) + n * 128;
  __syncthreads();
  {
    const int q = t >> 1, hl = t & 1;
    const u16* vp = p.PX + (rowbase + q) * PXW + PX_DV + hl * 256;
    float ss = 0.f;
#pragma unroll 8
    for (int i = 0; i < 32; ++i) {
      const u32x4 v = *(const u32x4*)(vp + i * 8);
      const float a0 = bflo(v.x), a1 = bfhi(v.x), a2 = bflo(v.y), a3 = bfhi(v.y), a4 = bflo(v.z), a5 = bfhi(v.z), a6 = bflo(v.w), a7 = bfhi(v.w);
      ss += a0 * a0 + a1 * a1 + a2 * a2 + a3 * a3 + a4 * a4 + a5 * a5 + a6 * a6 + a7 * a7;
    }
    ss += __shfl_xor(ss, 1);
    if (hl == 0) rr[q] = rsqrtf(ss * (1.f / 512.f) + EPS_);
  }
  {
    __syncthreads();
    const u16* wp = p.WSB + (size_t)(l * 4 + g) * 16384;
#pragma unroll
    for (int i = 0; i < 8; ++i) {
      const int id = t + 256 * i, pr = id >> 4, c8 = id & 15;
      *(u32x4*)(Ys + perm32(pr) * 136 + c8 * 8) = *(const u32x4*)(wp + pr * 128 + c8 * 8);
    }
    const float* gv = p.d_vn_g + l * 512 + g * 128;
#pragma unroll 4
    for (int i = 0; i < 8; ++i) {
      const int id = t + 256 * i, q = id >> 4, c8 = id & 15;
      const u32x4 v = *(const u32x4*)(p.PX + (rowbase + q) * PXW + PX_DV + g * 128 + c8 * 8);
      const float rq = rr[q];
      const float4 g0 = *(const float4*)(gv + c8 * 8), g1 = *(const float4*)(gv + c8 * 8 + 4);
      const unsigned o0 = cvt_pk(bflo(v.x) * rq * g0.x, bfhi(v.x) * rq * g0.y);
      const unsigned o1 = cvt_pk(bflo(v.y) * rq * g0.z, bfhi(v.y) * rq * g0.w);
      const unsigned o2 = cvt_pk(bflo(v.z) * rq * g1.x, bfhi(v.z) * rq * g1.y);
      const unsigned o3 = cvt_pk(bflo(v.w) * rq * g1.z, bfhi(v.w) * rq * g1.w);
      const int c = c8 * 8;
      Xs[perm32(c + 0) * 136 + q] = (u16)(o0 & 0xffff); Xs[perm32(c + 1) * 136 + q] = (u16)(o0 >> 16);
      Xs[perm32(c + 2) * 136 + q] = (u16)(o1 & 0xffff); Xs[perm32(c + 3) * 136 + q] = (u16)(o1 >> 16);
      Xs[perm32(c + 4) * 136 + q] = (u16)(o2 & 0xffff); Xs[perm32(c + 5) * 136 + q] = (u16)(o2 >> 16);
      Xs[perm32(c + 6) * 136 + q] = (u16)(o3 & 0xffff); Xs[perm32(c + 7) * 136 + q] = (u16)(o3 >> 16);
    }
    __syncthreads();
    f32x4 acc[4][4];
    zero_acc(acc);
    wave_mma<4, 136>(Xs, Ys, acc, wx, wy, l15, quad);
    const float* bs = p.d_bs + (size_t)(l * 4 + g) * 128;
#pragma unroll
    for (int yt = 0; yt < 4; ++yt) {
      const int pr = yidx(wy, yt, l15);
      const float bb = bs[pr];
      const size_t row = rowbase + pr;
#pragma unroll
      for (int u = 0; u < 2; ++u) {
        const int x0 = xidx(wx, u, quad);
        const u32x4 uu = *(const u32x4*)(p.PX + row * PXW + PX_DU + g * 128 + x0);
        f32x4 a = acc[2 * u][yt], b = acc[2 * u + 1][yt];
        a[0] = (a[0] + bb) * bflo(uu.x); a[1] = (a[1] + bb) * bfhi(uu.x); a[2] = (a[2] + bb) * bflo(uu.y); a[3] = (a[3] + bb) * bfhi(uu.y);
        b[0] = (b[0] + bb) * bflo(uu.z); b[1] = (b[1] + bb) * bfhi(uu.z); b[2] = (b[2] + bb) * bflo(uu.w); b[3] = (b[3] + bb) * bfhi(uu.w);
        *(u32x4*)(p.YS + row * 2048 + YS_D + g * 128 + x0) = pack8(a, b);
      }
    }
  }
}

DEV void phase_mixers(const Params& p, int l, int hf, u16* lds, u16* lds0) {
  const bool last = (l == NLAYER - 1);
  {
    const int PG = (int)gridDim.x, pb = pbid();
    const bool swz = ((PG & 7) == 0) && (1024 % PG == 0);
    for (int v = pb; v < 1024; v += PG) {
      int a, qb;
      if (swz) { const int i = v / PG, s2 = i * (PG >> 3) + (pb >> 3); a = (s2 >> 4) * 8 + (pb & 7); qb = s2 & 15; }
      else { a = v >> 4; qb = v & 15; }
      attnA_unit<false>(p, l, a >> 2, a & 3, qb, lds0);
    }
    if (!last) for (int v = pb; v < 128; v += PG) attnA_unit<true>(p, l, v >> 3, (v >> 1) & 3, v & 1, lds0);
    __syncthreads();
    for (int v = pb; v < 2048; v += PG) attnC2_unit(p, l, v >> 7, (v >> 4) & 7, v & 15, lds0);
    if (!last) for (int v = pb; v < 256; v += PG) attnC2_ctx_unit(p, l, v >> 4, (v >> 1) & 7, v & 1, lds0);
  }
  __syncthreads();
  const int G = vgrid();
  const int nC = 0, nB = 1024, nD = 1024;
  const int nCc = 0, nBc = last ? 0 : 128, nDc = last ? 0 : 128;
  const int e1 = nC, e2 = e1 + nB, e3 = e2 + nD, e5 = e3 + nCc, e6 = e5 + nBc, e7 = e6 + nDc;
  for (int v = bid(); v < e7; v += G) {
    if (v < e1) {
      const int u = v;
      attnC_lds_unit(p, l, u >> 8, (u >> 5) & 7, u & 31, lds);
    } else if (v < e2) {
      const int u = v - e1;
      poolB_unit(p, l, u >> 6, (u >> 2) & 15, u & 3, false, lds);
    } else if (v < e3) {
      const int u = v - e2;
      gateD_unit(p, l, u >> 6, (u >> 2) & 15, u & 3, false, lds);
    } else if (v < e5) {
      const int u = v - e3;
      attnC_unit<true>(p, l, u >> 5, (u >> 2) & 7, u & 3, (float*)lds);
    } else if (v < e6) {
      const int u = v - e5;
      poolB_unit(p, l, u >> 3, (u >> 2) & 1, u & 3, true, lds);
    } else {
      const int u = v - e6;
      gateD_unit(p, l, u >> 3, (u >> 2) & 1, u & 3, true, lds);
    }
  }
}

DEV void phase_merge(const Params& p, int l, int hf, u16* lds) {
  const bool last = (l == NLAYER - 1);
  const int RT = last ? 256 : 288;
  const int t = tid(), lane = t & 63, w = t >> 6, l15 = lane & 15, quad = lane >> 4, wx = w & 1, wy = w >> 1;
  int rt, ct;
  for (int it = 0; next_tile(it, RT, 8, 8, 8, rt, ct); ++it) {
    f32x4 tot[4][4];
    zero_acc(tot);
#pragma unroll 1
    for (int i = 0; i < 4; ++i) {
      f32x4 acc[4][4];
      zero_acc(acc);
      gemm_kloop(p.WBR + ((size_t)l * 1024 + ct * 128) * 2048 + i * 512, 2048, p.YS + (size_t)rt * 128 * 2048 + i * 512, 2048, 8, acc, lds);
#pragma unroll
      for (int yt = 0; yt < 4; ++yt) {
        const size_t row = (size_t)rt * 128 + yidx(wy, yt, l15);
#pragma unroll
        for (int u = 0; u < 2; ++u) {
          const u32x4 gq = *(const u32x4*)(p.PX + row * PXW + PX_G + i * 1024 + ct * 128 + xidx(wx, u, quad));
          tot[2 * u][yt][0] += sigmoidf_(bflo(gq.x)) * acc[2 * u][yt][0];
          tot[2 * u][yt][1] += sigmoidf_(bfhi(gq.x)) * acc[2 * u][yt][1];
          tot[2 * u][yt][2] += sigmoidf_(bflo(gq.y)) * acc[2 * u][yt][2];
          tot[2 * u][yt][3] += sigmoidf_(bfhi(gq.y)) * acc[2 * u][yt][3];
          tot[2 * u + 1][yt][0] += sigmoidf_(bflo(gq.z)) * acc[2 * u + 1][yt][0];
          tot[2 * u + 1][yt][1] += sigmoidf_(bfhi(gq.z)) * acc[2 * u + 1][yt][1];
          tot[2 * u + 1][yt][2] += sigmoidf_(bflo(gq.w)) * acc[2 * u + 1][yt][2];
          tot[2 * u + 1][yt][3] += sigmoidf_(bfhi(gq.w)) * acc[2 * u + 1][yt][3];
        }
      }
    }
#pragma unroll
    for (int yt = 0; yt < 4; ++yt) {
      const size_t row = (size_t)rt * 128 + yidx(wy, yt, l15);
#pragma unroll
      for (int u = 0; u < 2; ++u)
        *(u32x4*)(p.HX + row * 1024 + ct * 128 + xidx(wx, u, quad)) = pack8(tot[2 * u][yt], tot[2 * u + 1][yt]);
    }
  }
}

DEV void phase_resgemm(const Params& p, int l, int hf, int which, u16* lds) {
  const bool last = (l == NLAYER - 1);
  const int RT = last ? 256 : 288;
  const int t = tid(), lane = t & 63, w = t >> 6, l15 = lane & 15, quad = lane >> 4, wx = w & 1, wy = w >> 1;
  const bool first = (which == 0 && l == 0);
  const float* xs = first ? p.x : p.out;
  const float* cs = first ? p.ctx : p.CTXC;
  int rt, ct;
  for (int it = 0; next_tile(it, RT, 8, 8, 8, rt, ct); ++it) {
    f32x4 acc[4][4];
    zero_acc(acc);
    if (which == 0) gemm_kloop(p.WOUT + ((size_t)l * 1024 + ct * 128) * 1024, 1024, p.HX + (size_t)rt * 128 * 1024, 1024, 16, acc, lds);
    else gemm_kloop(p.WDN + ((size_t)l * 1024 + ct * 128) * FH, FH, p.PX + (size_t)rt * 128 * FH, FH, FH / 64, acc, lds);
    int b, idx0; bool isc;
    rowmap(hf, rt * 128, b, idx0, isc);
    const float* gate = p.MOD + ((size_t)l * 33 + (isc ? 32 : b)) * 6144 + (which ? 5 : 2) * 1024 + ct * 128;
    const size_t rb = isc ? ((size_t)b * 256 + idx0) * 1024 : ((size_t)b * 2048 + idx0) * 1024;
    const float* src = (isc ? cs : xs) + rb + ct * 128;
    float* dst = (isc ? p.CTXC : p.out) + rb + ct * 128;
#pragma unroll
    for (int u = 0; u < 2; ++u) {
      const int x0 = xidx(wx, u, quad);
      const float4 g0 = *(const float4*)(gate + x0), g1 = *(const float4*)(gate + x0 + 4);
#pragma unroll
      for (int yt = 0; yt < 4; ++yt) {
        const size_t ro = (size_t)yidx(wy, yt, l15) * 1024 + x0;
        const float4 r0 = *(const float4*)(src + ro), r1 = *(const float4*)(src + ro + 4);
        float4 o0, o1;
        o0.x = r0.x + g0.x * acc[2 * u][yt][0]; o0.y = r0.y + g0.y * acc[2 * u][yt][1];
        o0.z = r0.z + g0.z * acc[2 * u][yt][2]; o0.w = r0.w + g0.w * acc[2 * u][yt][3];
        o1.x = r1.x + g1.x * acc[2 * u + 1][yt][0]; o1.y = r1.y + g1.y * acc[2 * u + 1][yt][1];
        o1.z = r1.z + g1.z * acc[2 * u + 1][yt][2]; o1.w = r1.w + g1.w * acc[2 * u + 1][yt][3];
        *(float4*)(dst + ro) = o0;
        *(float4*)(dst + ro + 4) = o1;
      }
    }
  }
}

DEV void phase_ffnup(const Params& p, int l, u16* lds) {
  const bool last = (l == NLAYER - 1);
  const int t = ptid(), lane = t & 63, w = t >> 6, l15 = lane & 15, quad = lane >> 4, wx = w & 1, wy = w >> 1;
  int rt, ct;
  for (int it = 0; next_tile_p(it, 288, 22, 16, 2, rt, ct); ++it) {
    if (last && (rt % 144) >= 128) continue;
    f32x4 acc[8][4];
    zero_acc8(acc);
    gemm_kloop256(p.WGU + ((size_t)l * 2 * FH + ct * 256) * 1024, 1024, p.YS + (size_t)rt * 256 * 1024, 1024, 16, acc, lds);
#pragma unroll
    for (int yt = 0; yt < 4; ++yt) {
      const size_t row = (size_t)rt * 256 + yidx(wy, yt, l15);
#pragma unroll
      for (int u = 0; u < 4; ++u) {
        const f32x4 a = acc[2 * u][yt], b = acc[2 * u + 1][yt];
        u32x2 o;
        o.x = cvt_pk(a[0] * sigmoidf_(a[0]) * b[0], a[1] * sigmoidf_(a[1]) * b[1]);
        o.y = cvt_pk(a[2] * sigmoidf_(a[2]) * b[2], a[3] * sigmoidf_(a[3]) * b[3]);
        *(u32x2*)(p.PX + row * FH + ct * 128 + (xidx8(wx, u, quad) >> 1)) = o;
      }
    }
  }
}

DEV void phase_down(const Params& p, int l, u16* lds) {
  const bool last = (l == NLAYER - 1);
  const int t = ptid(), lane = t & 63, w = t >> 6, l15 = lane & 15, quad = lane >> 4, wx = w & 1, wy = w >> 1;
  int rt, ct;
  for (int it = 0; next_tile_p(it, 288, 4, 8, 4, rt, ct); ++it) {
    const int hf = rt >= 144 ? 1 : 0;
    const int rl = rt - hf * 144;
    if (last && rl >= 128) continue;
    f32x4 acc[8][4];
    zero_acc8(acc);
    gemm_kloop256(p.WDN + ((size_t)l * 1024 + ct * 256) * FH, FH, p.PX + (size_t)rt * 256 * FH, FH, FH / 64, acc, lds);
    int b, idx0; bool isc;
    rowmap(hf, rl * 256, b, idx0, isc);
    const float* gate = p.MOD + ((size_t)l * 33 + (isc ? 32 : b)) * 6144 + 5 * 1024 + ct * 256;
    const size_t rb = isc ? ((size_t)b * 256 + idx0) * 1024 : ((size_t)b * 2048 + idx0) * 1024;
    float* dst = (isc ? p.CTXC : p.out) + rb + ct * 256;
#pragma unroll
    for (int u = 0; u < 4; ++u) {
      const int x0 = xidx8(wx, u, quad);
      const float4 g0 = *(const float4*)(gate + x0), g1 = *(const float4*)(gate + x0 + 4);
#pragma unroll
      for (int yt = 0; yt < 4; ++yt) {
        const size_t ro = (size_t)yidx(wy, yt, l15) * 1024 + x0;
        const float4 r0 = *(const float4*)(dst + ro), r1 = *(const float4*)(dst + ro + 4);
        float4 o0, o1;
        o0.x = r0.x + g0.x * acc[2 * u][yt][0]; o0.y = r0.y + g0.y * acc[2 * u][yt][1];
        o0.z = r0.z + g0.z * acc[2 * u][yt][2]; o0.w = r0.w + g0.w * acc[2 * u][yt][3];
        o1.x = r1.x + g1.x * acc[2 * u + 1][yt][0]; o1.y = r1.y + g1.y * acc[2 * u + 1][yt][1];
        o1.z = r1.z + g1.z * acc[2 * u + 1][yt][2]; o1.w = r1.w + g1.w * acc[2 * u + 1][yt][3];
        *(float4*)(dst + ro) = o0;
        *(float4*)(dst + ro + 4) = o1;
      }
    }
  }
}

namespace pg8 {
#define PG8_LAS __attribute__((address_space(3)))
typedef unsigned short bf16_t;
typedef short bf16x8 __attribute__((ext_vector_type(8)));
typedef float f32x4 __attribute__((ext_vector_type(4)));
constexpr int BM = 256, BK = 64, HALF = 128, HTB = HALF * BK * 2, STAGE_BYTES = 8 * HTB;
__host__ __device__ __forceinline__ int lds_byte(int r, int c) { const int st = (r >> 4) * 2 + (c >> 5), rr = r & 15, cc = c & 31, ob = rr * 64 + cc * 2; return st * 1024 + (ob ^ (((ob >> 9) & 1) << 5)); }
__host__ __device__ __forceinline__ void stage_rc(int b, int& R, int& C) { const int st = b / 1024, sb = b % 1024, swz = sb ^ (((sb >> 9) & 1) << 5); R = (st >> 1) * 16 + swz / 64; C = (st & 1) * 32 + (swz % 64) / 2; }
__host__ __device__ __forceinline__ int perm32(int rho) { const int n = rho >> 4, i = rho & 15; return 8 * (i >> 2) + 4 * n + (i & 3); }
struct Unit { const char* a; const char* b; int pm, pn, kind; };
template <class Epi, class Sched, bool ALIGN_EPI = false, bool SP2 = false>
__device__ __forceinline__ void gemm_phase(PG8_LAS unsigned char* lds, const int K_, const int lda, const int ldb, const Sched& S, const Epi& E) {
    const int tid = ptid(), wid = __builtin_amdgcn_readfirstlane(tid >> 6), lane = tid & 63, wr = wid >> 2, wc = wid & 3, fr = lane & 15, fq = lane >> 4;
    const int K = K_, nt = K / BK;
    unsigned voffA[2], voffB[2];
#pragma unroll
    for (int i = 0; i < 2; ++i) { int R, C; stage_rc(tid * 16 + i * 8192, R, C); const int Rb = 64 * ((R >> 5) & 3) + perm32(R & 31);
        voffA[i] = (unsigned)(R * lda + C) * 2u; voffB[i] = (unsigned)(Rb * ldb + C) * 2u; }
    const size_t kstep = (size_t)(BK * 2);
    const size_t hstep = (size_t)HALF * lda * 2;
    const size_t hstepB = (size_t)32 * ldb * 2;
    const unsigned ldsw = (unsigned)wid * 1024u;
    const int aoff = lds_byte(wr * 64 + fr, fq * 8), boff = lds_byte(wc * 32 + fr, fq * 8);
#define PG8_SA(b, h) (((b) * 2 + (h)) * HTB)
#define PG8_SB(b, h) ((4 + (b) * 2 + (h)) * HTB)
#define PG8_STAGE(bufoff, gbase, voff) do { _Pragma("unroll") for (int _i = 0; _i < 2; ++_i) \
        __builtin_amdgcn_global_load_lds((const unsigned*)((const char*)(gbase) + (voff)[_i]), (PG8_LAS unsigned*)(lds + (bufoff) + ldsw + _i * 8192), 16, 0, 0); } while (0)
#define PG8_LDA(dst, b, h) do { _Pragma("unroll") for (int m = 0; m < 4; ++m) _Pragma("unroll") for (int k = 0; k < 2; ++k) dst[m][k] = *(const PG8_LAS bf16x8*)(lds + PG8_SA(b, h) + aoff + m * 2048 + k * 1024); } while (0)
#define PG8_LDB(dst, b, h) do { _Pragma("unroll") for (int n = 0; n < 2; ++n) _Pragma("unroll") for (int k = 0; k < 2; ++k) dst[n][k] = *(const PG8_LAS bf16x8*)(lds + PG8_SB(b, h) + boff + n * 2048 + k * 1024); } while (0)
#define PG8_MMA(ai, bj, At, Bt) do { __builtin_amdgcn_s_setprio(1); _Pragma("unroll") for (int m = 0; m < 4; ++m) _Pragma("unroll") for (int n = 0; n < 2; ++n) _Pragma("unroll") for (int k = 0; k < 2; ++k) \
        acc[ai][bj][m][n] = __builtin_amdgcn_mfma_f32_16x16x32_bf16(Bt[n][k], At[m][k], acc[ai][bj][m][n], 0, 0, 0); __builtin_amdgcn_s_setprio(0); } while (0)
#define PG8_WAIT_V(n) asm volatile("s_waitcnt vmcnt(" #n ")" ::: "memory")
#define PG8_WAIT_L(n) asm volatile("s_waitcnt lgkmcnt(" #n ")" ::: "memory")
#define PG8_BAR __builtin_amdgcn_s_barrier()
#define PG8_SCHED __builtin_amdgcn_sched_barrier(0)
    Unit cur, nxt; int ui = 0;
    if (!S.next(0, cur)) return;
    f32x4 acc[2][2][4][2];
#pragma unroll
    for (int a = 0; a < 2; ++a)
#pragma unroll
        for (int b = 0; b < 2; ++b)
#pragma unroll
            for (int m = 0; m < 4; ++m)
#pragma unroll
                for (int n = 0; n < 2; ++n) acc[a][b][m][n] = (f32x4){0.f, 0.f, 0.f, 0.f};
    bf16x8 At[4][2], B0[2][2], B1[2][2];
    const char* cA = cur.a; const char* cB = cur.b;
    S.a_ready(cur);
    if constexpr (SP2) {
        PG8_STAGE(PG8_SB(0, 0), cB, voffB); PG8_STAGE(PG8_SB(0, 1), cB + hstepB, voffB); PG8_STAGE(PG8_SA(0, 0), cA, voffA); PG8_STAGE(PG8_SA(0, 1), cA + hstep, voffA);
        if (wr == 1) PG8_BAR;
        PG8_WAIT_V(2); PG8_BAR;
        PG8_STAGE(PG8_SB(1, 0), cB + kstep, voffB); PG8_STAGE(PG8_SA(1, 0), cA + kstep, voffA); PG8_STAGE(PG8_SB(1, 1), cB + hstepB + kstep, voffB);
        PG8_WAIT_V(6); PG8_BAR;
    } else {
        PG8_STAGE(PG8_SB(0, 0), cB, voffB); PG8_STAGE(PG8_SA(0, 0), cA, voffA); PG8_STAGE(PG8_SB(0, 1), cB + hstepB, voffB); PG8_STAGE(PG8_SA(0, 1), cA + hstep, voffA);
        if (wr == 1) PG8_BAR;
        PG8_WAIT_V(4); PG8_BAR;
        PG8_STAGE(PG8_SB(1, 0), cB + kstep, voffB); PG8_STAGE(PG8_SA(1, 0), cA + kstep, voffA); PG8_STAGE(PG8_SB(1, 1), cB + hstepB + kstep, voffB);
        PG8_WAIT_V(6); PG8_BAR;
    }
    for (;;) {
        const bool has_next = S.next(ui + 1, nxt);
        const char* nA = has_next ? nxt.a : cA; const char* nB = has_next ? nxt.b : cB;
        for (int t = 0; t < nt; t += 2) {
            const bool last = (t == nt - 2);
            const char* a1 = cA + (size_t)(t + 1) * kstep;
            const char* a2 = last ? nA : cA + (size_t)(t + 2) * kstep; const char* b2 = last ? nB : cB + (size_t)(t + 2) * kstep;
            const char* a3 = a2 + kstep; const char* b3 = b2 + kstep;
            if (last && has_next) S.a_ready(nxt);
            if constexpr (SP2) {
            PG8_LDB(B0, 0, 0); PG8_LDB(B1, 0, 1); PG8_SCHED; PG8_LDA(At, 0, 0); PG8_STAGE(PG8_SA(1, 1), a1 + hstep, voffA);
            PG8_WAIT_V(8); PG8_WAIT_L(0); PG8_BAR; PG8_MMA(0, 0, At, B0); PG8_MMA(0, 1, At, B1); PG8_BAR; PG8_SCHED;
            PG8_LDA(At, 0, 1); PG8_STAGE(PG8_SB(0, 0), b2, voffB); PG8_STAGE(PG8_SB(0, 1), b2 + hstepB, voffB); PG8_STAGE(PG8_SA(0, 0), a2, voffA);
            PG8_WAIT_V(8); PG8_WAIT_L(0); PG8_BAR; PG8_MMA(1, 0, At, B0); PG8_MMA(1, 1, At, B1); PG8_BAR; PG8_SCHED;
            PG8_LDB(B0, 1, 0); PG8_LDB(B1, 1, 1); PG8_SCHED; PG8_LDA(At, 1, 0); PG8_STAGE(PG8_SA(0, 1), a2 + hstep, voffA);
            PG8_WAIT_V(8); PG8_WAIT_L(0); PG8_BAR; PG8_MMA(0, 0, At, B0); PG8_MMA(0, 1, At, B1); PG8_BAR; PG8_SCHED;
            PG8_LDA(At, 1, 1); PG8_STAGE(PG8_SB(1, 0), b3, voffB); PG8_STAGE(PG8_SB(1, 1), b3 + hstepB, voffB); PG8_STAGE(PG8_SA(1, 0), a3, voffA);
            PG8_WAIT_V(8); PG8_WAIT_L(0); PG8_BAR; PG8_MMA(1, 0, At, B0); PG8_MMA(1, 1, At, B1); PG8_BAR; PG8_SCHED;
            } else {
            PG8_LDB(B0, 0, 0); PG8_SCHED; PG8_LDA(At, 0, 0); PG8_STAGE(PG8_SA(1, 1), a1 + hstep, voffA);
            PG8_WAIT_L(8); PG8_BAR; PG8_WAIT_L(0); PG8_MMA(0, 0, At, B0); PG8_BAR; PG8_SCHED;
            PG8_LDB(B1, 0, 1); PG8_STAGE(PG8_SB(0, 0), b2, voffB);
            PG8_BAR; PG8_WAIT_L(0); PG8_MMA(0, 1, At, B1); PG8_BAR;
            PG8_LDA(At, 0, 1); PG8_STAGE(PG8_SA(0, 0), a2, voffA);
            PG8_BAR; PG8_WAIT_L(0); PG8_MMA(1, 0, At, B0); PG8_BAR; PG8_SCHED;
            PG8_STAGE(PG8_SB(0, 1), b2 + hstepB, voffB);
            PG8_WAIT_V(6); PG8_BAR; PG8_MMA(1, 1, At, B1); PG8_BAR;
            PG8_LDB(B0, 1, 0); PG8_SCHED; PG8_LDA(At, 1, 0); PG8_STAGE(PG8_SA(0, 1), a2 + hstep, voffA);
            PG8_WAIT_L(8); PG8_BAR; PG8_WAIT_L(0); PG8_MMA(0, 0, At, B0); PG8_BAR; PG8_SCHED;
            PG8_LDB(B1, 1, 1); PG8_STAGE(PG8_SB(1, 0), b3, voffB);
            PG8_BAR; PG8_WAIT_L(0); PG8_MMA(0, 1, At, B1); PG8_BAR;
            PG8_LDA(At, 1, 1); PG8_STAGE(PG8_SA(1, 0), a3, voffA);
            PG8_BAR; PG8_WAIT_L(0); PG8_MMA(1, 0, At, B0); PG8_BAR; PG8_SCHED;
            PG8_STAGE(PG8_SB(1, 1), b3 + hstepB, voffB);
            PG8_WAIT_V(6); PG8_BAR; PG8_MMA(1, 1, At, B1); PG8_BAR;
            }
        }
        if constexpr (ALIGN_EPI) { if (wr == 0) PG8_BAR; }
        if constexpr (!Epi::AFTER_DRAIN) { E(acc, cur, wr, wc, fr, fq); S.done(cur); }
        if (!has_next) break;
#pragma unroll
        for (int a = 0; a < 2; ++a)
#pragma unroll
            for (int b = 0; b < 2; ++b)
#pragma unroll
                for (int m = 0; m < 4; ++m)
#pragma unroll
                    for (int n = 0; n < 2; ++n) acc[a][b][m][n] = (f32x4){0.f, 0.f, 0.f, 0.f};
        cur = nxt; cA = nA; cB = nB; ++ui;
        if constexpr (ALIGN_EPI) { if (wr == 1) PG8_BAR; }
    }
    PG8_WAIT_V(0);
    if constexpr (!ALIGN_EPI) { if (wr == 0) PG8_BAR; }
    PG8_BAR;
    if constexpr (Epi::AFTER_DRAIN) { E.fused(acc, cur, wr, wc, fr, fq, lds, wid, lane); S.done(cur); }
#undef PG8_SA
#undef PG8_SB
#undef PG8_STAGE
#undef PG8_LDA
#undef PG8_LDB
#undef PG8_MMA
#undef PG8_WAIT_V
#undef PG8_WAIT_L
#undef PG8_BAR
#undef PG8_SCHED
}
}

DEV bool tile_p(int it, int RT, int CT, int PR, int PC, int& rt, int& ct) {
  const int b = pbid();
  const int G = (int)gridDim.x;
  if (G != 8 * PR * PC) {
    const int v = it * G + b;
    if (v >= RT * CT) return false;
    rt = v / CT; ct = v - rt * CT;
    return true;
  }
  const int x = b & 7, lb = b >> 3;
  const int gp = it * 8 + x;
  const int npc = CT / PC, npr = RT / PR;
  if (gp >= npc * npr) return false;
  const int prow = gp / npc, pcol = gp - prow * npc;
  rt = prow * PR + lb / PC;
  ct = pcol * PC + lb % PC;
  return true;
}
struct SchedInproj {
  const char* hx; const char* win; bool last;
  DEV bool next(int i, pg8::Unit& u) const {
    int cnt = -1;
    for (int it = 0;; ++it) {
      int rt, ct;
      if (!tile_p(it, 144, 34, 16, 2, rt, ct)) return false;
      const bool ctxrow = rt >= 128;
      const bool valid = !(last && ctxrow && !((ct >= 2 && ct < 6) || (ct >= 10 && ct < 14)));
      if (valid && ++cnt == i) {
        const bool isv = (ct == 4 || ct == 5 || ct == 12 || ct == 13);
        const char* at = hx + (size_t)rt * (256 * 1024 * 2);
        const char* wt = win + (size_t)ct * (256 * 1024 * 2);
        u.a = isv ? wt : at; u.b = isv ? at : wt; u.pm = rt; u.pn = ct; u.kind = isv ? 1 : 0;
        return true;
      }
    }
  }
  DEV void a_ready(const pg8::Unit&) const {}
  DEV void done(const pg8::Unit&) const {}
};
struct SchedFull {
  const char* A; const char* W; size_t tstep; int CT, PR, PC; bool last;
  DEV bool next(int i, pg8::Unit& u) const {
    int cnt = -1;
    for (int it = 0;; ++it) {
      int rt, ct;
      if (!tile_p(it, 288, CT, PR, PC, rt, ct)) return false;
      const bool valid = !(last && (rt % 144) >= 128);
      if (valid && ++cnt == i) { u.a = A + (size_t)rt * tstep; u.b = W + (size_t)ct * tstep; u.pm = rt; u.pn = ct; u.kind = 0; return true; }
    }
  }
  DEV void a_ready(const pg8::Unit&) const {}
  DEV void done(const pg8::Unit&) const {}
};

struct EpiInproj {
  static constexpr bool PERM = true, AFTER_DRAIN = false;
  const Params& p; int l;
  DEV void operator()(f32x4 (&acc)[2][2][4][2], const pg8::Unit& u, int wr, int wc, int fr, int fq) const {
    const int rt = u.pm, ct = u.pn;
    const bool ctxrow = rt >= 128;
    if (u.kind == 0) {
      if (ct < 4 || (ct >= 8 && ct < 12)) {
        const int seg = ct < 4 ? (ct >> 1) : 2 + ((ct - 8) >> 1);
        const float* gq = (seg < 2 ? p.a_qk_g : p.c_qk_g) + l * 128 + (seg & 1) * 64;
        const float qs = (seg == 0 || seg == 2) ? 0.125f * LOG2E : 1.f;
        const bool dorope = (seg < 2) && !ctxrow;
        float gl[2][2][4], inv[8];
        int q2 = fq;
        asm volatile("" : "+v"(q2) : "v"(acc[0][0][0][0][0]));
#pragma unroll
        for (int bj = 0; bj < 2; ++bj)
#pragma unroll
          for (int n = 0; n < 2; ++n)
#pragma unroll
            for (int j = 0; j < 4; ++j) gl[bj][n][j] = gq[bj * 32 + q2 * 8 + n * 4 + j] * qs;
#pragma unroll
        for (int k = 0; k < 8; ++k) inv[k] = fexp2(-(float)((q2 & 1) * 8 + k) * (13.287712379549449f / 16.f));
#pragma unroll
        for (int ai = 0; ai < 2; ++ai)
#pragma unroll
          for (int m = 0; m < 4; ++m) {
            __builtin_amdgcn_sched_barrier(0);
            float ss = 0.f;
#pragma unroll
            for (int bj = 0; bj < 2; ++bj)
#pragma unroll
              for (int n = 0; n < 2; ++n)
#pragma unroll
                for (int j = 0; j < 4; ++j) ss += acc[ai][bj][m][n][j] * acc[ai][bj][m][n][j];
            ss += __shfl_xor(ss, 16);
            ss += __shfl_xor(ss, 32);
            const float r = rsqrtf(ss * (1.f / 64.f) + EPS_);
#pragma unroll
            for (int bj = 0; bj < 2; ++bj)
#pragma unroll
              for (int n = 0; n < 2; ++n)
#pragma unroll
                for (int j = 0; j < 4; ++j) acc[ai][bj][m][n][j] *= r * gl[bj][n][j];
            if (dorope) {
              int sq = (rt * 256 + ai * 128 + wr * 64 + m * 16 + fr) & 2047;
              asm volatile("" : "+v"(sq) : "v"(acc[ai][0][m][0][0]));
              const float frow = (float)(sq >> 6), fcol = (float)(sq & 63);
#pragma unroll
              for (int bj = 0; bj < 2; ++bj)
#pragma unroll
                for (int n = 0; n < 2; ++n)
#pragma unroll
                  for (int j = 0; j < 4; ++j) {
                    const float ang = (bj ? fcol : frow) * inv[n * 4 + j];
                    const float cs = __cosf(ang), sn = __sinf(ang);
                    const float v = acc[ai][bj][m][n][j];
                    const float pv = __shfl_xor(v, 32);
                    acc[ai][bj][m][n][j] = (q2 < 2) ? v * cs - pv * sn : v * cs + pv * sn;
                  }
            }
          }
      }
      const int c0 = ct * 256;
      const int pxc = c0 < 1024 ? c0 : (c0 < 3072 ? c0 - 512 : c0 - 1024);
#pragma unroll
      for (int ai = 0; ai < 2; ++ai)
#pragma unroll
        for (int m = 0; m < 4; ++m) {
          const size_t row = (size_t)rt * 256 + ai * 128 + wr * 64 + m * 16 + fr;
#pragma unroll
          for (int bj = 0; bj < 2; ++bj)
            *(u32x4*)(p.PX + row * PXW + pxc + wc * 64 + bj * 32 + fq * 8) = pack8(acc[ai][bj][m][0], acc[ai][bj][m][1]);
        }
    } else {
      int bl, key0;
      if (!ctxrow) { bl = rt >> 3; key0 = (rt & 7) * 256; } else { bl = rt - 128; key0 = 2048; }
      const bool isva = ct < 8;
#pragma unroll
      for (int ai = 0; ai < 2; ++ai)
#pragma unroll
        for (int m = 0; m < 4; ++m) {
          const int n = ai * 128 + wr * 64 + m * 16 + fr;
          u16* dst;
          if (isva) dst = p.VTA + ((size_t)((bl * 4 + (ct - 4) * 2 + (n >> 7)) * 128 + (n & 127))) * KV + key0;
          else dst = p.VTC + ((size_t)((bl * 8 + (ct - 12) * 4 + (n >> 6)) * 64 + (n & 63))) * KV + key0;
#pragma unroll
          for (int bj = 0; bj < 2; ++bj) *(u32x4*)(dst + wc * 64 + bj * 32 + fq * 8) = pack8(acc[ai][bj][m][0], acc[ai][bj][m][1]);
        }
    }
  }
};
struct EpiFfnUp {
  static constexpr bool PERM = true, AFTER_DRAIN = false;
  u16* hid;
  DEV void operator()(f32x4 (&acc)[2][2][4][2], const pg8::Unit& u, int wr, int wc, int fr, int fq) const {
#pragma unroll
    for (int ai = 0; ai < 2; ++ai)
#pragma unroll
      for (int m = 0; m < 4; ++m) {
        const size_t row = (size_t)u.pm * 256 + ai * 128 + wr * 64 + m * 16 + fr;
#pragma unroll
        for (int bj = 0; bj < 2; ++bj) {
          const f32x4 a = acc[ai][bj][m][0], b = acc[ai][bj][m][1];
          u32x2 o;
          o.x = cvt_pk(a[0] * sigmoidf_(a[0]) * b[0], a[1] * sigmoidf_(a[1]) * b[1]);
          o.y = cvt_pk(a[2] * sigmoidf_(a[2]) * b[2], a[3] * sigmoidf_(a[3]) * b[3]);
          *(u32x2*)(hid + row * FH + u.pn * 128 + wc * 32 + bj * 16 + fq * 4) = o;
        }
      }
  }
};
struct EpiDown {
  static constexpr bool PERM = true, AFTER_DRAIN = false;
  const Params& p; int l;
  DEV void operator()(f32x4 (&acc)[2][2][4][2], const pg8::Unit& u, int wr, int wc, int fr, int fq) const {
    const int rt = u.pm, ct = u.pn;
    const int hf = rt >= 144 ? 1 : 0;
    const int rl = rt - hf * 144;
    int b, idx0; bool isc;
    rowmap(hf, rl * 256, b, idx0, isc);
    const float* gate = p.MOD + ((size_t)l * 33 + (isc ? 32 : b)) * 6144 + 5 * 1024 + ct * 256;
    const size_t rb = isc ? ((size_t)b * 256 + idx0) * 1024 : ((size_t)b * 2048 + idx0) * 1024;
    float* dst = (isc ? p.CTXC : p.out) + rb + ct * 256;
#pragma unroll
    for (int bj = 0; bj < 2; ++bj) {
      const int x0 = wc * 64 + bj * 32 + fq * 8;
      const float4 g0 = *(const float4*)(gate + x0), g1 = *(const float4*)(gate + x0 + 4);
#pragma unroll
      for (int ai = 0; ai < 2; ++ai) {
      f32x4 r0[2][4], r1[2][4];
#pragma unroll
        for (int m = 0; m < 4; ++m) {
          const size_t ro = (size_t)(ai * 128 + wr * 64 + m * 16 + fr) * 1024 + x0;
          r0[ai][m] = *(const f32x4*)(dst + ro); r1[ai][m] = *(const f32x4*)(dst + ro + 4);
        }
#pragma unroll
        for (int m = 0; m < 4; ++m) {
          const size_t ro = (size_t)(ai * 128 + wr * 64 + m * 16 + fr) * 1024 + x0;
          const f32x4 a0 = acc[ai][bj][m][0], a1 = acc[ai][bj][m][1];
          f32x4 o0 = r0[ai][m], o1 = r1[ai][m];
          o0[0] += g0.x * a0[0]; o0[1] += g0.y * a0[1]; o0[2] += g0.z * a0[2]; o0[3] += g0.w * a0[3];
          o1[0] += g1.x * a1[0]; o1[1] += g1.y * a1[1]; o1[2] += g1.z * a1[2]; o1[3] += g1.w * a1[3];
          *(f32x4*)(dst + ro) = o0;
          *(f32x4*)(dst + ro + 4) = o1;
        }
      }
    }
  }
};

DEV void phase_inproj8(const Params& p, int l, int hf, char* lds) {
  SchedInproj S{(const char*)p.HX, (const char*)(p.WIN + (size_t)l * INC * 1024), l == NLAYER - 1};
  EpiInproj E{p, l};
  pg8::gemm_phase<EpiInproj, SchedInproj, true, true>((PG8_LAS unsigned char*)lds, 1024, 1024, 1024, S, E);
}
DEV void phase_ffnup8(const Params& p, int l, char* lds) {
  SchedFull S{(const char*)p.YS, (const char*)(p.WGU + (size_t)l * 2 * FH * 1024), (size_t)256 * 1024 * 2, 22, 16, 2, l == NLAYER - 1};
  EpiFfnUp E{p.PX};
  pg8::gemm_phase<EpiFfnUp, SchedFull, true, true>((PG8_LAS unsigned char*)lds, 1024, 1024, 1024, S, E);
}
DEV void phase_down8(const Params& p, int l, char* lds) {
  SchedFull S{(const char*)p.PX, (const char*)(p.WDN + (size_t)l * 1024 * FH), (size_t)256 * FH * 2, 4, 8, 4, l == NLAYER - 1};
  EpiDown E{p, l};
  pg8::gemm_phase<EpiDown, SchedFull, true, true>((PG8_LAS unsigned char*)lds, FH, FH, FH, S, E);
}


struct SchedMerge {
  const char* ys; const char* wbr; int RT;
  DEV bool next(int i, pg8::Unit& u) const {
    int rt, ct;
    if (!tile_p(i >> 2, RT, 4, 8, 4, rt, ct)) return false;
    const int br = i & 3;
    u.a = ys + ((size_t)rt * 256 * 2048 + br * 512) * 2;
    u.b = wbr + ((size_t)ct * 256 * 2048 + br * 512) * 2;
    u.pm = rt; u.pn = ct; u.kind = br;
    return true;
  }
  DEV void a_ready(const pg8::Unit&) const {}
  DEV void done(const pg8::Unit&) const {}
};
struct EpiMerge {
  static constexpr bool PERM = true, AFTER_DRAIN = false;
  const u16* px; u16* dstb;
  DEV void operator()(f32x4 (&acc)[2][2][4][2], const pg8::Unit& u, int wr, int wc, int fr, int fq) const {
    const int br = u.kind;
#pragma unroll
    for (int aim = 0; aim < 4; ++aim) {
      const int ai = aim >> 1, m0 = (aim & 1) * 2;
      u32x4 gq[4][2], pv[4][2];
#pragma unroll
      for (int m = m0; m < m0 + 2; ++m) {
        const size_t row = (size_t)u.pm * 256 + ai * 128 + wr * 64 + m * 16 + fr;
#pragma unroll
        for (int bj = 0; bj < 2; ++bj) {
          const int col = u.pn * 256 + wc * 64 + bj * 32 + fq * 8;
          gq[m][bj] = *(const u32x4*)(px + row * PXW + PX_G + br * 1024 + col);
          pv[m][bj] = (u32x4){0u, 0u, 0u, 0u};
          if (br) pv[m][bj] = *(const u32x4*)(dstb + row * 1024 + col);
        }
      }
#pragma unroll
      for (int m = m0; m < m0 + 2; ++m) {
        const size_t row = (size_t)u.pm * 256 + ai * 128 + wr * 64 + m * 16 + fr;
#pragma unroll
        for (int bj = 0; bj < 2; ++bj) {
          const int col = u.pn * 256 + wc * 64 + bj * 32 + fq * 8;
          const u32x4 g = gq[m][bj], q = pv[m][bj];
          f32x4 a = acc[ai][bj][m][0], b = acc[ai][bj][m][1];
          a[0] = bflo(q.x) + sigmoidf_(bflo(g.x)) * a[0]; a[1] = bfhi(q.x) + sigmoidf_(bfhi(g.x)) * a[1];
          a[2] = bflo(q.y) + sigmoidf_(bflo(g.y)) * a[2]; a[3] = bfhi(q.y) + sigmoidf_(bfhi(g.y)) * a[3];
          b[0] = bflo(q.z) + sigmoidf_(bflo(g.z)) * b[0]; b[1] = bfhi(q.z) + sigmoidf_(bfhi(g.z)) * b[1];
          b[2] = bflo(q.w) + sigmoidf_(bflo(g.w)) * b[2]; b[3] = bfhi(q.w) + sigmoidf_(bfhi(g.w)) * b[3];
          *(u32x4*)(dstb + row * 1024 + col) = pack8(a, b);
        }
      }
    }
  }
};
struct EpiOut {
  static constexpr bool PERM = true, AFTER_DRAIN = false;
  const Params& p; int l;
  DEV void operator()(f32x4 (&acc)[2][2][4][2], const pg8::Unit& u, int wr, int wc, int fr, int fq) const {
    const int rt = u.pm, ct = u.pn;
    const int hf = rt >= 144 ? 1 : 0;
    const int rl = rt - hf * 144;
    int b, idx0; bool isc;
    rowmap(hf, rl * 256, b, idx0, isc);
    const float* gate = p.MOD + ((size_t)l * 33 + (isc ? 32 : b)) * 6144 + 2 * 1024 + ct * 256;
    const size_t rb = isc ? ((size_t)b * 256 + idx0) * 1024 : ((size_t)b * 2048 + idx0) * 1024;
    const float* src = (l == 0 ? (isc ? p.ctx : p.x) : (isc ? (const float*)p.CTXC : (const float*)p.out)) + rb + ct * 256;
    float* dst = (isc ? p.CTXC : p.out) + rb + ct * 256;
#pragma unroll
    for (int bj = 0; bj < 2; ++bj) {
      const int x0 = wc * 64 + bj * 32 + fq * 8;
      const float4 g0 = *(const float4*)(gate + x0), g1 = *(const float4*)(gate + x0 + 4);
#pragma unroll
      for (int ai = 0; ai < 2; ++ai) {
      f32x4 r0[2][4], r1[2][4];
#pragma unroll
        for (int m = 0; m < 4; ++m) {
          const size_t ro = (size_t)(ai * 128 + wr * 64 + m * 16 + fr) * 1024 + x0;
          r0[ai][m] = *(const f32x4*)(src + ro); r1[ai][m] = *(const f32x4*)(src + ro + 4);
        }
#pragma unroll
        for (int m = 0; m < 4; ++m) {
          const size_t ro = (size_t)(ai * 128 + wr * 64 + m * 16 + fr) * 1024 + x0;
          const f32x4 a0 = acc[ai][bj][m][0], a1 = acc[ai][bj][m][1];
          f32x4 o0 = r0[ai][m], o1 = r1[ai][m];
          o0[0] += g0.x * a0[0]; o0[1] += g0.y * a0[1]; o0[2] += g0.z * a0[2]; o0[3] += g0.w * a0[3];
          o1[0] += g1.x * a1[0]; o1[1] += g1.y * a1[1]; o1[2] += g1.z * a1[2]; o1[3] += g1.w * a1[3];
          *(f32x4*)(dst + ro) = o0;
          *(f32x4*)(dst + ro + 4) = o1;
        }
      }
    }
  }
};
DEV void phase_merge8(const Params& p, int l, int hf, char* lds) {
  SchedMerge S{(const char*)p.YS, (const char*)(p.WBR + (size_t)l * 1024 * 2048), (l == NLAYER - 1) ? 128 : 144};
  EpiMerge E{p.PX, hf ? p.HX : p.ACC0};
  pg8::gemm_phase<EpiMerge, SchedMerge, true, true>((PG8_LAS unsigned char*)lds, 512, 2048, 2048, S, E);
}
DEV void phase_out8(const Params& p, int l, char* lds) {
  SchedFull S{(const char*)p.ACC0, (const char*)(p.WOUT + (size_t)l * 1024 * 1024), (size_t)256 * 1024 * 2, 4, 8, 4, l == NLAYER - 1};
  EpiOut E{p, l};
  pg8::gemm_phase<EpiOut, SchedFull, true, true>((PG8_LAS unsigned char*)lds, 1024, 1024, 1024, S, E);
}

DEV void run_phase(const Params& p, int ph, char* lds0) {
  char* lds = lds0 + vhalf() * 73728;
  if (ph == 0) { phase_prep(p, lds); return; }
  const int q = ph - 1;
  const int l = q / 11, k = q % 11;
  switch (k) {
    case 0: phase_norm(p, l, 0, 0); break;
    case 1: phase_inproj8(p, l, 0, lds0); break;
    case 2: phase_mixers(p, l, 0, (u16*)lds, (u16*)lds0); break;
    case 3: phase_merge8(p, l, 0, lds0); phase_norm(p, l, 1, 0); break;
    case 4: phase_inproj8(p, l, 1, lds0); break;
    case 5: phase_mixers(p, l, 1, (u16*)lds, (u16*)lds0); break;
    case 6: phase_merge8(p, l, 1, lds0); break;
    case 7: phase_out8(p, l, lds0); break;
    case 8: phase_norm(p, l, 0, 1); break;
    case 9: phase_ffnup8(p, l, lds0); break;
    default: phase_down8(p, l, lds0); break;
  }
}

#define XB_TMO      128
#define XB_XCNT(j)  (256  + 64 * (j))
#define XB_XSUB(j)  (1280 + 64 * (j))
#define XB_XGEN(j)  (2304 + 64 * (j))
#define XB_TOP      3328
#define XB_TOPGEN   3392
#define XCD_BAR_WORDS 3456
#define XB_SPIN_CAP (1u << 24)
#define LAS __attribute__((address_space(3)))
DEV unsigned xb_ld(unsigned* p) { return __hip_atomic_load(p, __ATOMIC_RELAXED, __HIP_MEMORY_SCOPE_AGENT); }
DEV unsigned xb_add(unsigned* p, unsigned v) { return __hip_atomic_fetch_add(p, v, __ATOMIC_RELAXED, __HIP_MEMORY_SCOPE_AGENT); }
DEV unsigned xb_xcc_id() { return (unsigned)__builtin_amdgcn_s_getreg((3 << 11) | 20) & 0xFu; }
#define XB_SPIN(cond, bar) do { unsigned _sp = 0; while (cond) { __builtin_amdgcn_s_sleep(1); \
    if ((++_sp & 255u) == 0u) { if (xb_ld(&(bar)[XB_TMO])) break; if (_sp > XB_SPIN_CAP) { atomicAdd(&(bar)[XB_TMO], 1u); break; } } } } while (0)
struct XcdBarrier { unsigned* bar; unsigned x; volatile LAS unsigned* st; };
DEV XcdBarrier xcd_barrier_post(unsigned* bar, volatile LAS unsigned* st) {
  XcdBarrier b; b.bar = bar; b.x = xb_xcc_id(); b.st = st;
  if (threadIdx.x == 0) (void)xb_add(&bar[XB_XCNT(b.x)], 1u);
  return b;
}
DEV void xcd_barrier_complete(unsigned* bar, unsigned x, unsigned& nloc, unsigned& nx) {
  const unsigned G = gridDim.x * gridDim.y * gridDim.z;
  unsigned sum, cnt, mine, sp = 0u;
  for (;;) {
    sum = 0u; cnt = 0u; mine = 0u;
#pragma unroll
    for (unsigned j = 0; j < 16; ++j) { const unsigned c = xb_ld(&bar[XB_XCNT(j)]); sum += c; cnt += (c > 0u) ? 1u : 0u; mine = (j == x) ? c : mine; }
    if (sum == G) break;
    __builtin_amdgcn_s_sleep(1);
    if ((++sp & 255u) == 0u) { if (xb_ld(&bar[XB_TMO])) break; if (sp > XB_SPIN_CAP) { atomicAdd(&bar[XB_TMO], 1u); break; } }
  }
  nloc = mine > 0u ? mine : 1u; nx = cnt > 0u ? cnt : 1u;
}
DEV void xcd_barrier(const XcdBarrier& b) {
  asm volatile("s_waitcnt vmcnt(0)" ::: "memory");
  __syncthreads();
  if (threadIdx.x == 0) {
    unsigned* bar = b.bar;
    __builtin_amdgcn_s_waitcnt(0);
    unsigned nloc = b.st[0], nx = b.st[1];
    if (nloc == 0u) { xcd_barrier_complete(bar, b.x, nloc, nx); b.st[0] = nloc; b.st[1] = nx; }
    const unsigned old = xb_add(&bar[XB_XSUB(b.x)], 1u);
    const unsigned gen = old / nloc;
    if (old + 1u == (gen + 1u) * nloc) {
      __builtin_amdgcn_fence(__ATOMIC_RELEASE, "agent");
      asm volatile("s_waitcnt vmcnt(0)" ::: "memory");
      const unsigned og = xb_add(&bar[XB_TOP], 1u);
      const unsigned tg = og / nx;
      if (og + 1u == (tg + 1u) * nx) xb_add(&bar[XB_TOPGEN], 1u);
      else XB_SPIN(xb_ld(&bar[XB_TOPGEN]) == tg, bar);
      __builtin_amdgcn_fence(__ATOMIC_ACQUIRE, "agent");
      xb_add(&bar[XB_XGEN(b.x)], 1u);
      asm volatile("s_waitcnt vmcnt(0)" ::: "memory");
    } else {
      XB_SPIN(xb_ld(&bar[XB_XGEN(b.x)]) == gen, bar);
      __builtin_amdgcn_fence(__ATOMIC_ACQUIRE, "agent");
      asm volatile("s_waitcnt vmcnt(0)" ::: "memory");
    }
  }
  __syncthreads();
}

__global__ void __launch_bounds__(512, 2) fwd_kernel(Params p) {
  extern __shared__ __attribute__((aligned(16))) char smem[];
  cg::grid_group grid = cg::this_grid();
  volatile LAS unsigned* st = (volatile LAS unsigned*)(smem + 2 * 73728);
  if (threadIdx.x == 0) { st[0] = 0u; st[1] = 0u; st[2] = 0u; st[3] = 0u; }
  __syncthreads();
  XcdBarrier xb = xcd_barrier_post(p.BAR, st);
  for (int ph = p.ph0; ph < p.ph1; ++ph) {
    run_phase(p, ph, smem);
    if (ph + 1 < p.ph1) { if (ph == 0) grid.sync(); else xcd_barrier(xb); }
  }
}

extern "C" void kernel_launch(void* const* d_in, const int* in_sizes, int n_in, void* d_out, int out_size, void* d_ws, size_t ws_size,
                              hipStream_t stream) {
  static int grid_blocks = 0;
  if (!grid_blocks) {
    int dev = 0, cus = 0, per_cu = 0;
    hipGetDevice(&dev);
    hipDeviceGetAttribute(&cus, hipDeviceAttributeMultiprocessorCount, dev);
    hipFuncSetAttribute((const void*)fwd_kernel, hipFuncAttributeMaxDynamicSharedMemorySize, LDS_BYTES);
    hipOccupancyMaxActiveBlocksPerMultiprocessor(&per_cu, fwd_kernel, 512, LDS_BYTES);
    if (per_cu > 1) per_cu = 1;
    if (per_cu < 1) per_cu = 1;
    grid_blocks = cus * per_cu;
    grid_blocks &= ~7;
    if (grid_blocks < 8) grid_blocks = 8;
  }
  Params p{};
  const float* const* in = (const float* const*)d_in;
  p.x = in[0]; p.c = in[1]; p.ctx = in[2]; p.c_ctx = in[3]; p.w_mod = in[4]; p.b_mod = in[5]; p.norm1_g = in[6]; p.w_in = in[7];
  p.a_qk_g = in[8]; p.a_lambda = in[9]; p.a_subln_g = in[10]; p.b_pool_w = in[11]; p.b_pool_s = in[12]; p.c_qk_g = in[13];
  p.c_rpb = in[14]; p.d_vn_g = in[15]; p.d_ws = in[16]; p.d_bs = in[17]; p.w_branch = in[18]; p.w_out = in[19]; p.norm2_g = in[20];
  p.w_gu = in[21]; p.w_down = in[22];
  p.out = (float*)d_out;
  char* ws = (char*)d_ws;
  size_t off = 0;
  auto carve = [&](size_t bytes) { char* r = ws + off; off += (bytes + 255) & ~(size_t)255; return r; };
  p.BAR = (unsigned*)carve((size_t)4096 * 4);
  p.WIN = (u16*)carve((size_t)NLAYER * INC * 1024 * 2);
  p.WBR = (u16*)carve((size_t)NLAYER * 1024 * 2048 * 2);
  p.WOUT = (u16*)carve((size_t)NLAYER * 1024 * 1024 * 2);
  p.WGU = (u16*)carve((size_t)NLAYER * 2 * FH * 1024 * 2);
  p.WDN = (u16*)carve((size_t)NLAYER * 1024 * FH * 2);
  p.WPOOL = (u16*)carve((size_t)NLAYER * 4 * 16384 * 2);
  p.WSB = (u16*)carve((size_t)NLAYER * 4 * 16384 * 2);
  p.MOD = (float*)carve((size_t)NLAYER * 33 * 6144 * 4);
  p.CTXC = (float*)carve((size_t)32 * 256 * 1024 * 4);
  p.ACC0 = (u16*)carve((size_t)HR * 1024 * 2);
  p.HX = (u16*)carve((size_t)HR * 1024 * 2);
  p.PX = (u16*)carve((size_t)HR * PXW * 2);
  p.VTA = (u16*)carve((size_t)HB * 4 * 128 * KV * 2);
  p.VTC = (u16*)carve((size_t)HB * 8 * 64 * KV * 2);
  p.YS = (u16*)carve((size_t)HR * 2048 * 2);
  if (off > ws_size) { fprintf(stderr, "workspace too small: need %zu have %zu\n", off, ws_size); return; }
#if MULTI_LAUNCH
  for (int ph = 0; ph < NPHASE; ++ph) {
    p.ph0 = ph; p.ph1 = ph + 1;
    hipLaunchKernelGGL(fwd_kernel, dim3(grid_blocks), dim3(512), LDS_BYTES, stream, p);
  }
#else
  p.ph0 = 0; p.ph1 = NPHASE;
  (void)hipMemsetAsync(p.BAR, 0, (size_t)4096 * 4, stream);
  void* args[] = {&p};
  hipError_t e = hipLaunchCooperativeKernel((const void*)fwd_kernel, dim3(grid_blocks), dim3(512), args, LDS_BYTES, stream);
  if (e != hipSuccess) fprintf(stderr, "cooperative launch failed: %s (grid %d)\n", hipGetErrorString(e), grid_blocks);
#endif
}
```

```cpp
#include <hip/hip_runtime.h>
#include <hip/hip_cooperative_groups.h>
#include <cstdio>
#include <cstdint>
namespace cg = cooperative_groups;

#ifndef P13
#define P13 255
#endif
#ifndef MXMASK
#define MXMASK 63
#endif
#ifndef MULTI_LAUNCH
#define MULTI_LAUNCH 0
#endif

typedef unsigned short u16;
typedef short bf16x8 __attribute__((ext_vector_type(8)));
typedef float f32x4 __attribute__((ext_vector_type(4)));
typedef __bf16 bf2_t __attribute__((ext_vector_type(2)));
typedef float f2_t __attribute__((ext_vector_type(2)));
typedef unsigned u32x4 __attribute__((ext_vector_type(4)));
typedef unsigned u32x2 __attribute__((ext_vector_type(2)));

#define DEV __device__ __forceinline__

constexpr int NLAYER = 2;
constexpr int INC = 8704, PXW = 7680, FH = 2816;
constexpr int HB = 16;
constexpr int LR = HB * 2048;
constexpr int HR = LR + HB * 256;
constexpr int KV = 2304;
constexpr int PX_AQ = 0, PX_AK = 512, PX_B = 1024, PX_CQ = 1536, PX_CK = 2048, PX_DU = 2560, PX_DV = 3072, PX_G = 3584;
constexpr int YS_A = 0, YS_B = 512, YS_C = 1024, YS_D = 1536;
constexpr int LDS_BYTES = 2 * 73728 + 16;
constexpr float EPS_ = 1e-6f;
constexpr float LOG2E = 1.4426950408889634f;
constexpr int NPHASE = 1 + NLAYER * 11;

struct Params {
  const float *x, *c, *ctx, *c_ctx, *w_mod, *b_mod, *norm1_g, *w_in, *a_qk_g, *a_lambda, *a_subln_g, *b_pool_w, *b_pool_s,
      *c_qk_g, *c_rpb, *d_vn_g, *d_ws, *d_bs, *w_branch, *w_out, *norm2_g, *w_gu, *w_down;
  float* out;
  u16 *WIN, *WBR, *WOUT, *WGU, *WDN, *WPOOL, *WSB;
  float *MOD, *CTXC;
  u16 *HX, *PX, *VTA, *VTC, *YS, *ACC0;
  unsigned* BAR;
  int ph0, ph1;
};

DEV int tid() { int t = threadIdx.x & 255; asm volatile("" : "+v"(t)); return t; }
DEV int vhalf() { return __builtin_amdgcn_readfirstlane((int)(threadIdx.x >> 8)); }
DEV int bid() { int b = (((int)blockIdx.x >> 3) * 2 + vhalf()) * 8 + ((int)blockIdx.x & 7); asm volatile("" : "+s"(b)); return b; }
DEV int vgrid() { return (int)gridDim.x * 2; }
DEV unsigned cvt_pk(float lo, float hi) {
  f2_t v = {lo, hi};
  bf2_t b = __builtin_convertvector(v, bf2_t);
  return __builtin_bit_cast(unsigned, b);
}
DEV float bflo(unsigned u) { return __uint_as_float(u << 16); }
DEV float bfhi(unsigned u) { return __uint_as_float(u & 0xffff0000u); }
DEV int perm32(int r) { return (r & ~31) | (((r >> 2) & 1) << 4) | (((r >> 3) & 3) << 2) | (r & 3); }
DEV f32x4 mfma16(bf16x8 a, bf16x8 b, f32x4 c) { return __builtin_amdgcn_mfma_f32_16x16x32_bf16(a, b, c, 0, 0, 0); }
DEV u32x4 pack8(const f32x4& a, const f32x4& b) {
  u32x4 o;
  o.x = cvt_pk(a[0], a[1]); o.y = cvt_pk(a[2], a[3]); o.z = cvt_pk(b[0], b[1]); o.w = cvt_pk(b[2], b[3]);
  return o;
}
DEV bf16x8 pack8f(const f32x4& a, const f32x4& b) { return __builtin_bit_cast(bf16x8, pack8(a, b)); }
DEV float fexp2(float x) { return __builtin_amdgcn_exp2f(x); }
DEV float frcp(float x) { return __builtin_amdgcn_rcpf(x); }
DEV float sigmoidf_(float x) { return frcp(1.f + fexp2(-x * LOG2E)); }

DEV int xidx(int wx, int u, int quad) { return wx * 64 + u * 32 + quad * 8; }
DEV int yidx(int wy, int yt, int l15) { return wy * 64 + (yt >> 1) * 32 + (l15 >> 2) * 8 + (yt & 1) * 4 + (l15 & 3); }

DEV void zero_acc(f32x4 (&acc)[4][4]) {
#pragma unroll
  for (int i = 0; i < 4; ++i)
#pragma unroll
    for (int j = 0; j < 4; ++j) acc[i][j] = (f32x4){0.f, 0.f, 0.f, 0.f};
}

template <int KS, int STRIDE>
DEV void wave_mma(const u16* Xs, const u16* Ys, f32x4 (&acc)[4][4], int wx, int wy, int l15, int quad) {
#pragma unroll
  for (int ks = 0; ks < KS; ++ks) {
    bf16x8 xf[4], yf[4];
#pragma unroll
    for (int i = 0; i < 4; ++i) xf[i] = *(const bf16x8*)(Xs + (wx * 64 + i * 16 + l15) * STRIDE + ks * 32 + quad * 8);
#pragma unroll
    for (int i = 0; i < 4; ++i) yf[i] = *(const bf16x8*)(Ys + (wy * 64 + i * 16 + l15) * STRIDE + ks * 32 + quad * 8);
#pragma unroll
    for (int a = 0; a < 4; ++a)
#pragma unroll
      for (int b = 0; b < 4; ++b) acc[a][b] = mfma16(xf[a], yf[b], acc[a][b]);
  }
}

DEV void gemm_kloop(const u16* __restrict__ Xg, int ldx, const u16* __restrict__ Yg, int ldy, int nkt, f32x4 (&acc)[4][4], u16* lds) {
  const int t = tid(), lane = t & 63, w = t >> 6, l15 = lane & 15, quad = lane >> 4;
  const int wx = w & 1, wy = w >> 1;
  const int lr = t >> 3, kc = t & 7;
  const unsigned xo = (unsigned)(lr * ldx + kc * 8), yo = (unsigned)(lr * ldy + kc * 8);
  const int pr = perm32(lr);
  const int sofs = pr * 64 + ((kc ^ ((pr >> 1) & 7)) << 3);
  const int m7 = (l15 >> 1) & 7;
  const int xrow = (wx * 64 + l15) * 64, yrow = 8192 + (wy * 64 + l15) * 64;
  const int ko0 = ((0 + quad) ^ m7) << 3, ko1 = ((4 + quad) ^ m7) << 3;
  u32x4 rx[4], ry[4];
#define GK_LOAD(KT)                                                                \
  _Pragma("unroll") for (int i = 0; i < 4; ++i) {                                  \
    rx[i] = *(const u32x4*)((Xg + (size_t)(32 * i) * ldx + (size_t)(KT) * 64) + xo); \
    ry[i] = *(const u32x4*)((Yg + (size_t)(32 * i) * ldy + (size_t)(KT) * 64) + yo); \
  }
#define GK_STORE(B)                                                                \
  _Pragma("unroll") for (int i = 0; i < 4; ++i) {                                  \
    *(u32x4*)(lds + (B) * 16384 + sofs + i * 32 * 64) = rx[i];                     \
    *(u32x4*)(lds + (B) * 16384 + 8192 + sofs + i * 32 * 64) = ry[i];              \
  }
  GK_LOAD(0)
  __syncthreads();
  GK_STORE(0)
  if (nkt > 1) { GK_LOAD(1) }
  __syncthreads();
  for (int kt = 0; kt < nkt; ++kt) {
    const int cur = kt & 1;
    if (kt + 1 < nkt) {
      GK_STORE(cur ^ 1)
      if (kt + 2 < nkt) { GK_LOAD(kt + 2) }
    }
    const u16* B = lds + cur * 16384;
#pragma unroll
    for (int ks = 0; ks < 2; ++ks) {
      const int ko = ks ? ko1 : ko0;
      bf16x8 xf[4], yf[4];
#pragma unroll
      for (int i = 0; i < 4; ++i) xf[i] = *(const bf16x8*)(B + xrow + i * 16 * 64 + ko);
#pragma unroll
      for (int i = 0; i < 4; ++i) yf[i] = *(const bf16x8*)(B + yrow + i * 16 * 64 + ko);
#pragma unroll
      for (int a = 0; a < 4; ++a)
#pragma unroll
        for (int b = 0; b < 4; ++b) acc[a][b] = mfma16(xf[a], yf[b], acc[a][b]);
    }
    __syncthreads();
  }
#undef GK_LOAD
#undef GK_STORE
}

DEV int ptid() { int t = threadIdx.x; asm volatile("" : "+v"(t)); return t; }
DEV int pbid() { int b = blockIdx.x; asm volatile("" : "+s"(b)); return b; }
DEV void zero_acc8(f32x4 (&acc)[8][4]) {
#pragma unroll
  for (int i = 0; i < 8; ++i)
#pragma unroll
    for (int j = 0; j < 4; ++j) acc[i][j] = (f32x4){0.f, 0.f, 0.f, 0.f};
}
DEV int xidx8(int wx, int u, int quad) { return wx * 128 + u * 32 + quad * 8; }
DEV void gemm_kloop256(const u16* __restrict__ Xg, int ldx, const u16* __restrict__ Yg, int ldy, int nkt, f32x4 (&acc)[8][4], u16* lds) {
  const int t = ptid(), lane = t & 63, w = t >> 6, l15 = lane & 15, quad = lane >> 4;
  const int wx = w & 1, wy = w >> 1;
  const int lr = t >> 3, kc = t & 7;
  const unsigned xo = (unsigned)(lr * ldx + kc * 8), yo = (unsigned)(lr * ldy + kc * 8);
  const int pr = perm32(lr);
  const int sofs = pr * 64 + ((kc ^ ((pr >> 1) & 7)) << 3);
  const int m7 = (l15 >> 1) & 7;
  const int xrow = (wx * 128 + l15) * 64, yrow = 16384 + (wy * 64 + l15) * 64;
  const int ko0 = ((0 + quad) ^ m7) << 3, ko1 = ((4 + quad) ^ m7) << 3;
  u32x4 rx[4], ry[4];
#define GK_LOAD(KT)                                                                \
  _Pragma("unroll") for (int i = 0; i < 4; ++i) {                                  \
    rx[i] = *(const u32x4*)((Xg + (size_t)(64 * i) * ldx + (size_t)(KT) * 64) + xo); \
    ry[i] = *(const u32x4*)((Yg + (size_t)(64 * i) * ldy + (size_t)(KT) * 64) + yo); \
  }
#define GK_STORE(B)                                                                \
  _Pragma("unroll") for (int i = 0; i < 4; ++i) {                                  \
    *(u32x4*)(lds + (B) * 32768 + sofs + i * 64 * 64) = rx[i];                     \
    *(u32x4*)(lds + (B) * 32768 + 16384 + sofs + i * 64 * 64) = ry[i];             \
  }
  GK_LOAD(0)
  __syncthreads();
  GK_STORE(0)
  if (nkt > 1) { GK_LOAD(1) }
  __syncthreads();
  for (int kt = 0; kt < nkt; ++kt) {
    const int cur = kt & 1;
    if (kt + 1 < nkt) {
      GK_STORE(cur ^ 1)
      if (kt + 2 < nkt) { GK_LOAD(kt + 2) }
    }
    const u16* B = lds + cur * 32768;
#pragma unroll
    for (int ks = 0; ks < 2; ++ks) {
      const int ko = ks ? ko1 : ko0;
      bf16x8 yf[4];
#pragma unroll
      for (int i = 0; i < 4; ++i) yf[i] = *(const bf16x8*)(B + yrow + i * 16 * 64 + ko);
#pragma unroll
      for (int a = 0; a < 8; ++a) {
        const bf16x8 xf = *(const bf16x8*)(B + xrow + a * 16 * 64 + ko);
#pragma unroll
        for (int b = 0; b < 4; ++b) acc[a][b] = mfma16(xf, yf[b], acc[a][b]);
      }
    }
    __syncthreads();
  }
#undef GK_LOAD
#undef GK_STORE
}
DEV bool next_tile_p(int it, int RT, int CT, int PR, int PC, int& rt, int& ct) {
  const int G = (int)gridDim.x;
  const int b = pbid();
  if ((G & 7) == 0 && (G >> 3) == PR * PC) {
    const int x = b & 7, lb = b >> 3;
    const int gp = it * 8 + x;
    const int npc = CT / PC, npr = RT / PR;
    if (gp >= npc * npr) return false;
    const int prow = gp / npc, pcol = gp - prow * npc;
    rt = prow * PR + lb / PC;
    ct = pcol * PC + lb % PC;
    return true;
  } else {
    const int v = it * G + b;
    if (v >= RT * CT) return false;
    rt = v / CT; ct = v - rt * CT;
    return true;
  }
}

DEV bool next_tile(int it, int RT, int CT, int PR, int PC, int& rt, int& ct) {
  const int G = vgrid();
  if ((G & 7) == 0) {
    const int x = bid() & 7, nbx = G >> 3, lb = bid() >> 3;
    const int s = it * nbx + lb;
    const int ps = s >> 6, j = s & 63;
    const int gp = ps * 8 + x;
    const int npc = CT / PC, npr = RT / PR;
    if (gp >= npc * npr) return false;
    const int prow = gp / npc, pcol = gp - prow * npc;
    rt = prow * PR + j / PC;
    ct = pcol * PC + j % PC;
    return true;
  } else {
    const int v = it * G + bid();
    if (v >= RT * CT) return false;
    rt = v / CT; ct = v - rt * CT;
    return true;
  }
}

DEV void rowmap(int hf, int R, int& b, int& idx, bool& isc) {
  if (R < LR) { b = hf * HB + (R >> 11); idx = R & 2047; isc = false; }
  else { const int q = R - LR; b = hf * HB + (q >> 8); idx = q & 255; isc = true; }
}

DEV void tconv(const float* __restrict__ src, int K, int N, u16* __restrict__ dst, int mode, float* lds) {
  const int t = tid();
  const int ntn = N >> 6, ntk = K >> 6, ntiles = ntn * ntk;
  for (int base = 0; base < ntiles; base += vgrid()) {
    const int tile = base + bid();
    const bool active = tile < ntiles;
    const int kt = active ? tile / ntn : 0, nt = active ? tile - kt * ntn : 0;
    const int k0 = kt * 64, n0 = nt * 64;
    __syncthreads();
    if (active) {
      const int c = t & 63, r0 = t >> 6;
#pragma unroll
      for (int i = 0; i < 16; ++i) {
        const int k = r0 + 4 * i;
        lds[k * 65 + c] = src[(size_t)(k0 + k) * N + n0 + c];
      }
    }
    __syncthreads();
    if (active) {
      const int kk = t & 63, r0 = t >> 6;
#pragma unroll
      for (int i = 0; i < 16; ++i) {
        const int n = n0 + r0 + 4 * i;
        int dr = n;
        if (mode == 1) { if (n < FH) dr = ((n >> 2) << 3) + (n & 3); else { const int hh = n - FH; dr = ((hh >> 2) << 3) + 4 + (hh & 3); } }
        const float v = lds[kk * 65 + (r0 + 4 * i)];
        dst[(size_t)dr * K + k0 + kk] = (u16)(cvt_pk(v, 0.f) & 0xffffu);
      }
    }
  }
}

DEV void phase_prep(const Params& p, char* ldsc) {
  float* lds = (float*)ldsc;
  const int t = tid();
  for (int l = 0; l < NLAYER; ++l) {
    tconv(p.w_in + (size_t)l * 1024 * INC, 1024, INC, p.WIN + (size_t)l * INC * 1024, 0, lds);
    tconv(p.w_branch + (size_t)l * 2048 * 1024, 2048, 1024, p.WBR + (size_t)l * 1024 * 2048, 0, lds);
    tconv(p.w_out + (size_t)l * 1024 * 1024, 1024, 1024, p.WOUT + (size_t)l * 1024 * 1024, 0, lds);
    tconv(p.w_gu + (size_t)l * 1024 * 2 * FH, 1024, 2 * FH, p.WGU + (size_t)l * 2 * FH * 1024, 1, lds);
    tconv(p.w_down + (size_t)l * FH * 1024, FH, 1024, p.WDN + (size_t)l * 1024 * FH, 0, lds);
    for (int g = 0; g < 4; ++g)
      tconv(p.b_pool_w + (size_t)(l * 4 + g) * 16384, 128, 128, p.WPOOL + (size_t)(l * 4 + g) * 16384, 0, lds);
  }
  for (int i = bid() * 256 + t; i < NLAYER * 4 * 16384; i += vgrid() * 256) p.WSB[i] = (u16)(cvt_pk(p.d_ws[i], 0.f) & 0xffffu);
  for (int base = 0; base < NLAYER * 96; base += vgrid()) {
    const int item0 = base + vgrid() - 1 - bid();
    const bool active = item0 < NLAYER * 96;
    const int item = active ? item0 : 0;
    const int l = item / 96, n0 = (item % 96) * 64;
    const int c = t & 63, w = t >> 6;
    float acc[9];
#pragma unroll
    for (int i = 0; i < 9; ++i) acc[i] = 0.f;
    const float* wm = p.w_mod + (size_t)l * 1024 * 6144 + n0 + c;
    for (int kc = 0; kc < 4; ++kc) {
      __syncthreads();
      for (int i = 0; i < 36; ++i) {
        const int idx = t + 256 * i, r = idx >> 8, k = idx & 255;
        float v = 0.f;
        if (r < 32) v = p.c[r * 1024 + kc * 256 + k]; else if (r == 32) v = p.c_ctx[kc * 256 + k];
        lds[idx] = v / (1.f + __expf(-v));
      }
      __syncthreads();
      for (int k4 = 0; k4 < 64; ++k4) {
        const size_t kb = (size_t)(kc * 256 + k4 * 4) * 6144;
        const float w0 = wm[kb], w1 = wm[kb + 6144], w2 = wm[kb + 2 * 6144], w3 = wm[kb + 3 * 6144];
#pragma unroll
        for (int i = 0; i < 9; ++i) {
          const float4 s = *(const float4*)(lds + (w + 4 * i) * 256 + k4 * 4);
          acc[i] += s.x * w0 + s.y * w1 + s.z * w2 + s.w * w3;
        }
      }
    }
    const float bm = p.b_mod[l * 6144 + n0 + c];
#pragma unroll
    for (int i = 0; i < 9; ++i) {
      const int r = w + 4 * i;
      if (active && r < 33) p.MOD[((size_t)l * 33 + r) * 6144 + n0 + c] = acc[i] + bm;
    }
  }
}

DEV void phase_norm(const Params& p, int l, int hf0, int which) {
  const bool last = (l == NLAYER - 1);
  const int lane = tid() & 63;
  const int gw = (bid() * 256 + tid()) >> 6, nw = vgrid() * 4;
  const float* g = (which ? p.norm2_g : p.norm1_g) + l * 1024;
  const bool first = (which == 0 && l == 0);
  const float* xs = first ? p.x : p.out;
  const float* cs = first ? p.ctx : p.CTXC;
  const int nrows = which ? 2 * HR : HR;
  u16* dstb = which ? p.YS : p.HX;
  for (int GR = gw; GR < nrows; GR += nw) {
    const int hf = which ? (GR >= HR ? 1 : 0) : hf0;
    const int R = which ? GR - hf * HR : GR;
    if (which && last && R >= LR) continue;
    int b, idx; bool isc;
    rowmap(hf, R, b, idx, isc);
    const float* src = isc ? cs + ((size_t)b * 256 + idx) * 1024 : xs + ((size_t)b * 2048 + idx) * 1024;
    const float* md = p.MOD + ((size_t)l * 33 + (isc ? 32 : b)) * 6144 + (which ? 3 : 0) * 1024;
    float4 v[4];
    float ss = 0.f;
#pragma unroll
    for (int i = 0; i < 4; ++i) {
      { const f32x4 q_ = __builtin_nontemporal_load((const f32x4*)(src + i * 256 + lane * 4)); v[i] = make_float4(q_[0], q_[1], q_[2], q_[3]); }
      ss += v[i].x * v[i].x + v[i].y * v[i].y + v[i].z * v[i].z + v[i].w * v[i].w;
    }
#pragma unroll
    for (int o = 32; o >= 1; o >>= 1) ss += __shfl_xor(ss, o);
    const float r = rsqrtf(ss * (1.f / 1024.f) + EPS_);
#pragma unroll
    for (int i = 0; i < 4; ++i) {
      const int col = i * 256 + lane * 4;
      const float4 g4 = *(const float4*)(g + col), sh = *(const float4*)(md + col), sc = *(const float4*)(md + 1024 + col);
      const float o0 = v[i].x * r * g4.x * (1.f + sc.x) + sh.x;
      const float o1 = v[i].y * r * g4.y * (1.f + sc.y) + sh.y;
      const float o2 = v[i].z * r * g4.z * (1.f + sc.z) + sh.z;
      const float o3 = v[i].w * r * g4.w * (1.f + sc.w) + sh.w;
      u32x2 o; o.x = cvt_pk(o0, o1); o.y = cvt_pk(o2, o3);
      *(u32x2*)(dstb + (size_t)GR * 1024 + col) = o;
    }
  }
}

DEV void phase_inproj(const Params& p, int l, int hf, u16* lds) {
  const bool last = (l == NLAYER - 1);
  const int t = ptid(), lane = t & 63, w = t >> 6, l15 = lane & 15, quad = lane >> 4, wx = w & 1, wy = w >> 1;
  int rt, ct;
  for (int it = 0; next_tile_p(it, 144, 34, 16, 2, rt, ct); ++it) {
    const bool ctxrow = rt >= 128;
    if (last && ctxrow && !((ct >= 2 && ct < 6) || (ct >= 10 && ct < 14))) continue;
    const u16* W = p.WIN + ((size_t)l * INC + ct * 256) * 1024;
    const u16* A = p.HX + (size_t)rt * 256 * 1024;
    f32x4 acc[8][4];
    zero_acc8(acc);
    const bool isva = (ct == 4 || ct == 5), isvc = (ct == 12 || ct == 13);
    if (!(isva || isvc)) {
      gemm_kloop256(W, 1024, A, 1024, 16, acc, lds);
      if (ct < 4 || (ct >= 8 && ct < 12)) {
        const int seg = ct < 4 ? (ct >> 1) : 2 + ((ct - 8) >> 1);
        const float* gq = (seg < 2 ? p.a_qk_g : p.c_qk_g) + l * 128 + (seg & 1) * 64;
        const float qs = (seg == 0 || seg == 2) ? 0.125f * LOG2E : 1.f;
        const bool dorope = (seg < 2) && !ctxrow;
        float gl[4][4], inv[8];
        int q2 = quad;
        asm volatile("" : "+v"(q2) : "v"(acc[0][0][0]));
#pragma unroll
        for (int xt = 0; xt < 4; ++xt)
#pragma unroll
          for (int j = 0; j < 4; ++j) gl[xt][j] = gq[(xt >> 1) * 32 + q2 * 8 + (xt & 1) * 4 + j] * qs;
#pragma unroll
        for (int k = 0; k < 8; ++k) inv[k] = fexp2(-(float)((q2 & 1) * 8 + k) * (13.287712379549449f / 16.f));
#pragma unroll
        for (int gi = 0; gi < 2; ++gi)
#pragma unroll
          for (int yt = 0; yt < 4; ++yt) {
            __builtin_amdgcn_sched_barrier(0);
            float ss = 0.f;
#pragma unroll
            for (int xt = 0; xt < 4; ++xt)
#pragma unroll
              for (int j = 0; j < 4; ++j) ss += acc[gi * 4 + xt][yt][j] * acc[gi * 4 + xt][yt][j];
            ss += __shfl_xor(ss, 16);
            ss += __shfl_xor(ss, 32);
            const float r = rsqrtf(ss * (1.f / 64.f) + EPS_);
#pragma unroll
            for (int xt = 0; xt < 4; ++xt)
#pragma unroll
              for (int j = 0; j < 4; ++j) acc[gi * 4 + xt][yt][j] *= r * gl[xt][j];
            if (dorope) {
              int sq = (rt * 256 + yidx(wy, yt, l15)) & 2047;
              asm volatile("" : "+v"(sq) : "v"(acc[gi * 4][yt][0]));
              const float frow = (float)(sq >> 6), fcol = (float)(sq & 63);
#pragma unroll
              for (int xt = 0; xt < 4; ++xt)
#pragma unroll
                for (int j = 0; j < 4; ++j) {
                  const float ang = ((xt >> 1) ? fcol : frow) * inv[(xt & 1) * 4 + j];
                  const float cs = __cosf(ang), sn = __sinf(ang);
                  const float v = acc[gi * 4 + xt][yt][j];
                  const float pv = __shfl_xor(v, 32);
                  acc[gi * 4 + xt][yt][j] = (quad < 2) ? v * cs - pv * sn : v * cs + pv * sn;
                }
            }
          }
      }
      const int c0 = ct * 256;
      const int pxc = c0 < 1024 ? c0 : (c0 < 3072 ? c0 - 512 : c0 - 1024);
#pragma unroll
      for (int yt = 0; yt < 4; ++yt) {
        const size_t row = (size_t)rt * 256 + yidx(wy, yt, l15);
#pragma unroll
        for (int u = 0; u < 4; ++u)
          *(u32x4*)(p.PX + row * PXW + pxc + xidx8(wx, u, quad)) = pack8(acc[2 * u][yt], acc[2 * u + 1][yt]);
      }
    } else {
      gemm_kloop256(A, 1024, W, 1024, 16, acc, lds);
      int bl, key0;
      if (!ctxrow) { bl = rt >> 3; key0 = (rt & 7) * 256; } else { bl = rt - 128; key0 = 2048; }
#pragma unroll
      for (int yt = 0; yt < 4; ++yt) {
        const int n = yidx(wy, yt, l15);
        u16* dst;
        if (isva) dst = p.VTA + ((size_t)((bl * 4 + (ct - 4) * 2 + (n >> 7)) * 128 + (n & 127))) * KV + key0;
        else dst = p.VTC + ((size_t)((bl * 8 + (ct - 12) * 4 + (n >> 6)) * 64 + (n & 63))) * KV + key0;
#pragma unroll
        for (int u = 0; u < 4; ++u) *(u32x4*)(dst + xidx8(wx, u, quad)) = pack8(acc[2 * u][yt], acc[2 * u + 1][yt]);
      }
    }
  }
}

DEV void phase_qk(const Params& p, int l, int hf) {
  const bool last = (l == NLAYER - 1);
  const int total = HR * 32;
  for (int id = bid() * 256 + tid(); id < total; id += vgrid() * 256) {
    const int R = id >> 5, gi = id & 31, seg = gi >> 3, grp = gi & 7;
    const bool isc = R >= LR;
    if (last && isc && !(seg == 1 || seg == 3)) continue;
    const int colbase = seg == 0 ? PX_AQ : (seg == 1 ? PX_AK : (seg == 2 ? PX_CQ : PX_CK));
    u16* ptr = p.PX + (size_t)R * PXW + colbase + grp * 64;
    const float* g = (seg < 2 ? p.a_qk_g : p.c_qk_g) + l * 128 + (seg & 1) * 64;
    float v[64];
    float ss = 0.f;
#pragma unroll
    for (int i = 0; i < 8; ++i) {
      const u32x4 q = *(const u32x4*)(ptr + i * 8);
      v[i * 8 + 0] = bflo(q.x); v[i * 8 + 1] = bfhi(q.x); v[i * 8 + 2] = bflo(q.y); v[i * 8 + 3] = bfhi(q.y);
      v[i * 8 + 4] = bflo(q.z); v[i * 8 + 5] = bfhi(q.z); v[i * 8 + 6] = bflo(q.w); v[i * 8 + 7] = bfhi(q.w);
    }
#pragma unroll
    for (int i = 0; i < 64; ++i) ss += v[i] * v[i];
    float r = rsqrtf(ss * (1.f / 64.f) + EPS_);
#pragma unroll
    for (int i = 0; i < 64; ++i) v[i] = v[i] * r * g[i];
    if (seg < 2 && !isc) {
      const int s = R & 2047;
      const float frow = (float)(s >> 6), fcol = (float)(s & 63);
#pragma unroll
      for (int d = 0; d < 16; ++d) {
        const float inv = exp2f(-(float)d * (13.287712379549449f / 16.f));
        const float ar = frow * inv, ac = fcol * inv;
        const float cr = __cosf(ar), sr = __sinf(ar), cc = __cosf(ac), sc = __sinf(ac);
        const float a = v[d], b = v[16 + d], c2 = v[32 + d], d2 = v[48 + d];
        v[d] = a * cr - b * sr; v[16 + d] = b * cr + a * sr;
        v[32 + d] = c2 * cc - d2 * sc; v[48 + d] = d2 * cc + c2 * sc;
      }
    }
    const float qs = (seg == 0 || seg == 2) ? 0.125f * LOG2E : 1.f;
#pragma unroll
    for (int i = 0; i < 8; ++i) {
      u32x4 q;
      q.x = cvt_pk(v[i * 8 + 0] * qs, v[i * 8 + 1] * qs); q.y = cvt_pk(v[i * 8 + 2] * qs, v[i * 8 + 3] * qs);
      q.z = cvt_pk(v[i * 8 + 4] * qs, v[i * 8 + 5] * qs); q.w = cvt_pk(v[i * 8 + 6] * qs, v[i * 8 + 7] * qs);
      *(u32x4*)(ptr + i * 8) = q;
    }
  }
}

#define LASP __attribute__((address_space(3)))
DEV int invperm32(int s_) { return (s_ & ~31) | (((s_ >> 4) & 1) << 2) | (((s_ >> 2) & 3) << 3) | (s_ & 3); }
template <bool CTXQ>
DEV void attnA_unit(const Params& p, int l, int bl, int h, int qb, u16* ldsg) {
  const int t = ptid(), lane = t & 63, w = __builtin_amdgcn_readfirstlane(t >> 6), l15 = lane & 15, quad = lane >> 4;
  const int comp = w & 1, qp = w >> 1;
  LASP unsigned char* lds = (LASP unsigned char*)ldsg;
  float lam, lam_init, gmax;
  {
    const float* al = p.a_lambda + l * 256;
    float p1 = al[lane] * al[64 + lane], p2 = al[128 + lane] * al[192 + lane];
    float gm = fabsf(p.a_qk_g[l * 128 + 64 + lane]);
#pragma unroll
    for (int o = 32; o >= 1; o >>= 1) { p1 += __shfl_xor(p1, o); p2 += __shfl_xor(p2, o); gm = fmaxf(gm, __shfl_xor(gm, o)); }
    lam_init = 0.8f - 0.6f * __expf(-0.3f * (float)l);
    lam = __expf(p1) - __expf(p2) + lam_init;
    gmax = gm;
  }
  const size_t qrow0 = CTXQ ? (size_t)LR + bl * 256 + qb * 128 + qp * 32 : (size_t)bl * 2048 + qb * 128 + qp * 32;
  bf16x8 qf[2][2];
#pragma unroll
  for (int qt = 0; qt < 2; ++qt)
#pragma unroll
    for (int ks = 0; ks < 2; ++ks)
      qf[qt][ks] = *(const bf16x8*)(p.PX + (qrow0 + qt * 16 + l15) * PXW + PX_AQ + h * 128 + comp * 64 + ks * 32 + quad * 8);
  float mq[2];
#pragma unroll
  for (int qt = 0; qt < 2; ++qt) {
    float ss = 0.f;
#pragma unroll
    for (int ks = 0; ks < 2; ++ks)
#pragma unroll
      for (int e = 0; e < 8; ++e) { const float v = bflo((unsigned)(unsigned short)qf[qt][ks][e]); ss += v * v; }
    ss += __shfl_xor(ss, 16);
    ss += __shfl_xor(ss, 32);
    mq[qt] = sqrtf(ss) * (8.f * 1.01f) * gmax;
  }
  unsigned koff[2], voff[2];
#pragma unroll
  for (int i = 0; i < 2; ++i) {
    const int rho = (w * 2 + i) * 8 + (lane >> 3), c = (lane & 7) ^ ((rho >> 1) & 7);
    koff[i] = (unsigned)(invperm32(rho & 63) * PXW + (rho >> 6) * 64 + c * 8);
    voff[i] = (unsigned)(invperm32(rho) * KV + c * 8);
  }
  const int nkt = CTXQ ? 4 : 36, kt0 = CTXQ ? 32 : 0;
  const u16* vbase = p.VTA + ((size_t)((bl * 4 + h) * 128)) * KV;
#define A_DMA(KT, SLOT) do {                                                                                                          \
    const int kt_ = (KT);                                                                                                              \
    const size_t rowbase_ = kt_ < 32 ? (size_t)bl * 2048 + kt_ * 64 : (size_t)LR + bl * 256 + (kt_ - 32) * 64;                          \
    const u16* kb_ = p.PX + rowbase_ * PXW + PX_AK + h * 128;                                                                          \
    const u16* vb_ = vbase + kt_ * 64;                                                                                                 \
    _Pragma("unroll") for (int i_ = 0; i_ < 2; ++i_) {                                                                                 \
      __builtin_amdgcn_global_load_lds((const unsigned*)(kb_ + koff[i_]), (LASP unsigned*)(lds + (SLOT) * 16384 + (w * 2 + i_) * 1024), 16, 0, 0);          \
      __builtin_amdgcn_global_load_lds((const unsigned*)(vb_ + voff[i_]), (LASP unsigned*)(lds + 49152 + (SLOT) * 16384 + (w * 2 + i_) * 1024), 16, 0, 0);  \
    } } while (0)
  __syncthreads();
  LASP unsigned char* Qs = lds + 98304 + w * 4096;
#pragma unroll
  for (int qt = 0; qt < 2; ++qt)
#pragma unroll
    for (int ks = 0; ks < 2; ++ks) *(LASP bf16x8*)(Qs + ((qt * 2 + ks) * 64 + lane) * 16) = qf[qt][ks];
  A_DMA(kt0, 0);
  if (nkt > 1) A_DMA(kt0 + 1, 1);
  f32x4 O[8][2];
#pragma unroll
  for (int i = 0; i < 8; ++i) { O[i][0] = (f32x4){0.f, 0.f, 0.f, 0.f}; O[i][1] = (f32x4){0.f, 0.f, 0.f, 0.f}; }
  float lsum[2] = {0.f, 0.f};
  const int m7 = (l15 >> 1) & 7;
  const int ko0 = (((0 + quad) ^ m7) << 4), ko1 = (((4 + quad) ^ m7) << 4);
  int slot = 0;
  if (w >= 4) __builtin_amdgcn_s_setprio(1);
  for (int it = 0; it < nkt; ++it) {
    if (it + 1 < nkt) asm volatile("s_waitcnt vmcnt(4)" ::: "memory"); else asm volatile("s_waitcnt vmcnt(0)" ::: "memory");
    __builtin_amdgcn_s_barrier();
    if (it + 2 < nkt) { const int s2 = slot == 0 ? 2 : slot - 1; A_DMA(kt0 + it + 2, s2); }
    const LASP unsigned char* Kb = lds + slot * 16384;
    const LASP unsigned char* Vb = lds + 49152 + slot * 16384;
    f32x4 s[4][2];
#pragma unroll
    for (int mt = 0; mt < 4; ++mt) {
      s[mt][0] = (f32x4){-mq[0], -mq[0], -mq[0], -mq[0]};
      s[mt][1] = (f32x4){-mq[1], -mq[1], -mq[1], -mq[1]};
    }
    {
      bf16x8 kf[2][4];
#pragma unroll
      for (int ks = 0; ks < 2; ++ks)
#pragma unroll
        for (int mt = 0; mt < 4; ++mt) kf[ks][mt] = *(const LASP bf16x8*)(Kb + (comp * 64 + mt * 16 + l15) * 128 + (ks ? ko1 : ko0));
      __builtin_amdgcn_sched_barrier(0);
#pragma unroll
      for (int ks = 0; ks < 2; ++ks)
#pragma unroll
        for (int mt = 0; mt < 4; ++mt) {
          s[mt][0] = mfma16(kf[ks][mt], qf[0][ks], s[mt][0]);
          s[mt][1] = mfma16(kf[ks][mt], qf[1][ks], s[mt][1]);
        }
    }
    bf16x8 vf[8][2];
#pragma unroll
    for (int dvt = 0; dvt < 8; ++dvt)
#pragma unroll
      for (int g = 0; g < 2; ++g) vf[dvt][g] = *(const LASP bf16x8*)(Vb + (dvt * 16 + l15) * 128 + (g ? ko1 : ko0));
    __builtin_amdgcn_sched_barrier(0);
    bf16x8 pf[2][2];
#pragma unroll
    for (int qt = 0; qt < 2; ++qt) {
      float ps0 = 0.f, ps1 = 0.f, ps2 = 0.f, ps3 = 0.f;
#pragma unroll
      for (int j = 0; j < 4; ++j) {
        const float e0 = fexp2(s[0][qt][j]), e1 = fexp2(s[1][qt][j]), e2 = fexp2(s[2][qt][j]), e3 = fexp2(s[3][qt][j]);
        s[0][qt][j] = e0; s[1][qt][j] = e1; s[2][qt][j] = e2; s[3][qt][j] = e3;
        ps0 += e0; ps1 += e1; ps2 += e2; ps3 += e3;
      }
      lsum[qt] += (ps0 + ps1) + (ps2 + ps3);
      pf[0][qt] = pack8f(s[0][qt], s[1][qt]);
      pf[1][qt] = pack8f(s[2][qt], s[3][qt]);
    }
#pragma unroll
    for (int dvt = 0; dvt < 8; ++dvt)
#pragma unroll
      for (int g = 0; g < 2; ++g) {
        O[dvt][0] = mfma16(vf[dvt][g], pf[g][0], O[dvt][0]);
        O[dvt][1] = mfma16(vf[dvt][g], pf[g][1], O[dvt][1]);
      }
    slot = slot == 2 ? 0 : slot + 1;
  }
#undef A_DMA
  __builtin_amdgcn_s_setprio(0);
  float inv[2];
#pragma unroll
  for (int qt = 0; qt < 2; ++qt) {
    float lt = lsum[qt];
    lt += __shfl_xor(lt, 16);
    lt += __shfl_xor(lt, 32);
    inv[qt] = 1.f / lt;
  }
  __syncthreads();
  float* ex = (float*)ldsg;
  if (comp == 1) {
#pragma unroll
    for (int dvt = 0; dvt < 8; ++dvt)
#pragma unroll
      for (int qt = 0; qt < 2; ++qt)
#pragma unroll
        for (int j = 0; j < 4; ++j) ex[(qp * 64 + (dvt * 2 + qt) * 4 + j) * 64 + lane] = O[dvt][qt][j] * inv[qt] * lam;
  }
  __syncthreads();
  if (comp == 0) {
    const float* sg = p.a_subln_g + l * 128;
#pragma unroll
    for (int qt = 0; qt < 2; ++qt) {
      float ss = 0.f;
#pragma unroll
      for (int dvt = 0; dvt < 8; ++dvt)
#pragma unroll
        for (int j = 0; j < 4; ++j) {
          const float o = O[dvt][qt][j] * inv[qt] - ex[(qp * 64 + (dvt * 2 + qt) * 4 + j) * 64 + lane];
          O[dvt][qt][j] = o;
          ss += o * o;
        }
      ss += __shfl_xor(ss, 16);
      ss += __shfl_xor(ss, 32);
      const float r = rsqrtf(ss * (1.f / 128.f) + EPS_) * (1.f - lam_init);
      u16* dst = p.YS + (qrow0 + qt * 16 + l15) * 2048 + YS_A + h * 128;
#pragma unroll
      for (int u = 0; u < 4; ++u) {
        const int dv0 = u * 32 + quad * 8;
        const float4 g0 = *(const float4*)(sg + dv0), g1 = *(const float4*)(sg + dv0 + 4);
        f32x4 a = O[2 * u][qt], b = O[2 * u + 1][qt];
        a[0] *= r * g0.x; a[1] *= r * g0.y; a[2] *= r * g0.z; a[3] *= r * g0.w;
        b[0] *= r * g1.x; b[1] *= r * g1.y; b[2] *= r * g1.z; b[3] *= r * g1.w;
        *(u32x4*)(dst + dv0) = pack8(a, b);
      }
    }
  }
}

template <bool CTXQ>
DEV void attnC_unit(const Params& p, int l, int bl, int h, int r, float* rpbs) {
  const int t = tid(), lane = t & 63, jw = t >> 6, l15 = lane & 15, quad = lane >> 4;
  constexpr int NG = CTXQ ? 8 : 16;
  constexpr int NL = CTXQ ? 0 : 8;
  if (!CTXQ) {
    __syncthreads();
    for (int i = t; i < 465; i += 256) rpbs[i] = p.c_rpb[(size_t)(l * 8 + h) * 465 + i] * LOG2E;
    __syncthreads();
  }
  const size_t qrow = CTXQ ? (size_t)LR + bl * 256 + r * 64 + jw * 16 + l15 : (size_t)bl * 2048 + r * 64 + jw * 16 + l15;
  bf16x8 qf[2];
#pragma unroll
  for (int ks = 0; ks < 2; ++ks) qf[ks] = *(const bf16x8*)(p.PX + qrow * PXW + PX_CQ + h * 64 + ks * 32 + quad * 8);
  const int rs = min(max(r - 4, 0), 24), band0 = min(max(jw * 16 - 8, 0), 32);
  const int kk = (l15 >> 2) * 8 + (l15 & 3);
  f32x4 s[NG][2];
#pragma unroll
  for (int g = 0; g < NG; ++g) {
    size_t krow;
    if (g < NL) krow = (size_t)bl * 2048 + (rs + g) * 64 + band0 + kk;
    else krow = (size_t)LR + bl * 256 + (g - NL) * 32 + kk;
#pragma unroll
    for (int hf = 0; hf < 2; ++hf) {
      const u16* kp = p.PX + (krow + hf * 4) * PXW + PX_CK + h * 64 + quad * 8;
      const bf16x8 k0 = *(const bf16x8*)kp, k1 = *(const bf16x8*)(kp + 32);
      f32x4 a = (f32x4){0.f, 0.f, 0.f, 0.f};
      a = mfma16(k0, qf[0], a);
      a = mfma16(k1, qf[1], a);
      s[g][hf] = a;
    }
  }
  if (!CTXQ) {
    const int qc = jw * 16 + l15;
    const int win0 = min(max(qc - 8, 0), 48);
#pragma unroll
    for (int g = 0; g < NL; ++g) {
      const int ri = (rs + g - r + 7) * 31;
#pragma unroll
      for (int hf = 0; hf < 2; ++hf)
#pragma unroll
        for (int j = 0; j < 4; ++j) {
          const int kc = band0 + quad * 8 + hf * 4 + j;
          const bool valid = (kc >= win0) && (kc < win0 + 16);
          const int dc = min(max(kc - qc + 15, 0), 30);
          const float bias = rpbs[ri + dc];
          s[g][hf][j] = valid ? s[g][hf][j] + bias : -INFINITY;
        }
    }
  }
  float mx = -INFINITY;
#pragma unroll
  for (int g = 0; g < NG; ++g)
#pragma unroll
    for (int hf = 0; hf < 2; ++hf)
#pragma unroll
      for (int j = 0; j < 4; ++j) mx = fmaxf(mx, s[g][hf][j]);
  mx = fmaxf(mx, __shfl_xor(mx, 16));
  mx = fmaxf(mx, __shfl_xor(mx, 32));
  float ls = 0.f;
#pragma unroll
  for (int g = 0; g < NG; ++g)
#pragma unroll
    for (int hf = 0; hf < 2; ++hf)
#pragma unroll
      for (int j = 0; j < 4; ++j) { const float e = fexp2(s[g][hf][j] - mx); s[g][hf][j] = e; ls += e; }
  ls += __shfl_xor(ls, 16);
  ls += __shfl_xor(ls, 32);
  f32x4 O[4];
#pragma unroll
  for (int i = 0; i < 4; ++i) O[i] = (f32x4){0.f, 0.f, 0.f, 0.f};
#pragma unroll
  for (int g = 0; g < NG; ++g) {
    const int keybase = (g < NL) ? (rs + g) * 64 + band0 : 2048 + (g - NL) * 32;
    const bf16x8 pf = pack8f(s[g][0], s[g][1]);
#pragma unroll
    for (int dvt = 0; dvt < 4; ++dvt) {
      const int dv = (dvt >> 1) * 32 + (l15 >> 2) * 8 + (dvt & 1) * 4 + (l15 & 3);
      const bf16x8 vf = *(const bf16x8*)(p.VTC + ((size_t)((bl * 8 + h) * 64 + dv)) * KV + keybase + quad * 8);
      O[dvt] = mfma16(vf, pf, O[dvt]);
    }
  }
  const float inv = 1.f / ls;
  u16* dst = p.YS + qrow * 2048 + YS_C + h * 64;
#pragma unroll
  for (int u = 0; u < 2; ++u) {
    f32x4 a = O[2 * u] * inv, b = O[2 * u + 1] * inv;
    *(u32x4*)(dst + u * 32 + quad * 8) = pack8(a, b);
  }
}

template <int WH>
DEV void pool_rows(const u16* __restrict__ pb, u16* Ys, int tt, int seg, int ch, int L) {
  constexpr int NR = 8 + 2 * WH - 1;
  const int ts0 = tt * 128 + seg * 8;
  u32x4 rows[NR];
#pragma unroll
  for (int j = 0; j < NR; ++j) {
    const int tk = ts0 - WH + j;
    const int tkc = min(max(tk, 0), L - 1);
    rows[j] = *(const u32x4*)(pb + (size_t)tkc * PXW);
    if (tk < 0 || tk >= L) rows[j] = (u32x4){0u, 0u, 0u, 0u};
  }
  float a[8];
#pragma unroll
  for (int e = 0; e < 8; ++e) a[e] = 0.f;
#pragma unroll
  for (int j = 0; j < 2 * WH; ++j) {
    const u32x4 q = rows[j];
    a[0] += bflo(q.x); a[1] += bfhi(q.x); a[2] += bflo(q.y); a[3] += bfhi(q.y);
    a[4] += bflo(q.z); a[5] += bfhi(q.z); a[6] += bflo(q.w); a[7] += bfhi(q.w);
  }
#pragma unroll
  for (int i = 0; i < 8; ++i) {
    const int tl = seg * 8 + i, ts = ts0 + i;
    const int lo = max(ts - WH, 0), hi = min(ts + WH, L);
    const float ic = 1.f / (float)(hi - lo);
    const u32x4 own = rows[i + WH];
    u32x4 o;
    o.x = cvt_pk(a[0] * ic - bflo(own.x), a[1] * ic - bfhi(own.x));
    o.y = cvt_pk(a[2] * ic - bflo(own.y), a[3] * ic - bfhi(own.y));
    o.z = cvt_pk(a[4] * ic - bflo(own.z), a[5] * ic - bfhi(own.z));
    o.w = cvt_pk(a[6] * ic - bflo(own.w), a[7] * ic - bfhi(own.w));
    *(u32x4*)(Ys + perm32(tl) * 136 + ch * 8) = o;
    if (i < 7) {
      const u32x4 q0 = rows[i], q1 = rows[i + 2 * WH];
      a[0] += bflo(q1.x) - bflo(q0.x); a[1] += bfhi(q1.x) - bfhi(q0.x); a[2] += bflo(q1.y) - bflo(q0.y); a[3] += bfhi(q1.y) - bfhi(q0.y);
      a[4] += bflo(q1.z) - bflo(q0.z); a[5] += bfhi(q1.z) - bfhi(q0.z); a[6] += bflo(q1.w) - bflo(q0.w); a[7] += bfhi(q1.w) - bfhi(q0.w);
    }
  }
}

template <int ST>
DEV void attnC_stage_load(const Params& p, int bl, int h, int rs, u32x4 (&rg)[8]) {
  const int t = tid();
  if (ST < 3) {
    const size_t rowbase = ST == 2 ? (size_t)LR + bl * 256 : (size_t)bl * 2048 + rs * 64 + ST * 256;
    const u16* b = p.PX + rowbase * PXW + PX_CK + h * 64;
    const unsigned o = (unsigned)((t >> 3) * PXW + (t & 7) * 8);
#pragma unroll
    for (int i = 0; i < 8; ++i) rg[i] = *(const u32x4*)((b + (size_t)(32 * i) * PXW) + o);
  } else {
    const int keybase = ST == 5 ? 2048 : rs * 64 + (ST - 3) * 256;
    const u16* b = p.VTC + ((size_t)((bl * 8 + h) * 64)) * KV + keybase;
    const unsigned o = (unsigned)((t >> 5) * KV + (t & 31) * 8);
#pragma unroll
    for (int i = 0; i < 8; ++i) rg[i] = *(const u32x4*)((b + (size_t)(8 * i) * KV) + o);
  }
}
template <int ST>
DEV void attnC_stage_store(u16* buf, const u32x4 (&rg)[8]) {
  const int t = tid();
  if (ST < 3) {
#pragma unroll
    for (int i = 0; i < 8; ++i) {
      const int row = (t >> 3) + 32 * i, c = t & 7, key = ((row >> 3) & 3) * 2 + ((row >> 1) & 1);
      *(u32x4*)(buf + row * 64 + ((c ^ key) << 3)) = rg[i];
    }
  } else {
#pragma unroll
    for (int i = 0; i < 8; ++i) {
      const int dv = (t >> 5) + 8 * i, c = t & 31, key = ((dv >> 3) & 3) * 4 + (dv & 3);
      *(u32x4*)(buf + dv * 256 + ((c ^ key) << 3)) = rg[i];
    }
  }
}
DEV bf16x8 attnC_kfrag(const u16* buf, int row, int chunk) {
  const int key = ((row >> 3) & 3) * 2 + ((row >> 1) & 1);
  return *(const bf16x8*)(buf + row * 64 + ((chunk ^ key) << 3));
}
DEV bf16x8 attnC_vfrag(const u16* buf, int dv, int chunk) {
  const int key = ((dv >> 3) & 3) * 4 + (dv & 3);
  return *(const bf16x8*)(buf + dv * 256 + ((chunk ^ key) << 3));
}

DEV void attnC_lds_unit(const Params& p, int l, int bl, int h, int r, u16* lds) {
  const int t = tid(), lane = t & 63, jw = t >> 6, l15 = lane & 15, quad = lane >> 4;
  u16* buf0 = lds;
  u16* buf1 = lds + 16384;
  float* rpbs = (float*)(lds + 32768);
  const int rs = min(max(r - 4, 0), 24), band0 = min(max(jw * 16 - 8, 0), 32);
  const int kk = (l15 >> 2) * 8 + (l15 & 3);
  u32x4 rg[8];
  attnC_stage_load<0>(p, bl, h, rs, rg);
  __syncthreads();
  for (int i = t; i < 465; i += 256) rpbs[i] = p.c_rpb[(size_t)(l * 8 + h) * 465 + i] * LOG2E;
  attnC_stage_store<0>(buf0, rg);
  attnC_stage_load<1>(p, bl, h, rs, rg);
  const size_t qrow = (size_t)bl * 2048 + r * 64 + jw * 16 + l15;
  bf16x8 qf[2];
#pragma unroll
  for (int ks = 0; ks < 2; ++ks) qf[ks] = *(const bf16x8*)(p.PX + qrow * PXW + PX_CQ + h * 64 + ks * 32 + quad * 8);
  __syncthreads();
  f32x4 s[16][2];
  f32x4 O[4];
#pragma unroll
  for (int i = 0; i < 4; ++i) O[i] = (f32x4){0.f, 0.f, 0.f, 0.f};
  float ls = 0.f;
#pragma unroll
  for (int st = 0; st < 2; ++st) {
    const u16* buf = st ? buf1 : buf0;
#pragma unroll
    for (int hf = 0; hf < 2; ++hf) {
      bf16x8 kf[4][2];
#pragma unroll
      for (int kr = 0; kr < 4; ++kr) {
        const int row = kr * 64 + band0 + kk + hf * 4;
        kf[kr][0] = attnC_kfrag(buf, row, quad);
        kf[kr][1] = attnC_kfrag(buf, row, 4 + quad);
      }
#pragma unroll
      for (int kr = 0; kr < 4; ++kr) {
        f32x4 a = (f32x4){0.f, 0.f, 0.f, 0.f};
        a = mfma16(kf[kr][0], qf[0], a);
        a = mfma16(kf[kr][1], qf[1], a);
        s[st * 4 + kr][hf] = a;
      }
    }
    if (st == 0) { attnC_stage_store<1>(buf1, rg); attnC_stage_load<2>(p, bl, h, rs, rg); }
    else { attnC_stage_store<2>(buf0, rg); attnC_stage_load<3>(p, bl, h, rs, rg); }
    __syncthreads();
  }
  {
#pragma unroll
    for (int gh = 0; gh < 4; ++gh) {
      bf16x8 kf[4][2];
#pragma unroll
      for (int i = 0; i < 4; ++i) {
        const int g = gh * 2 + (i >> 1), hf = i & 1;
        const int row = g * 32 + kk + hf * 4;
        kf[i][0] = attnC_kfrag(buf0, row, quad);
        kf[i][1] = attnC_kfrag(buf0, row, 4 + quad);
      }
#pragma unroll
      for (int i = 0; i < 4; ++i) {
        f32x4 a = (f32x4){0.f, 0.f, 0.f, 0.f};
        a = mfma16(kf[i][0], qf[0], a);
        a = mfma16(kf[i][1], qf[1], a);
        s[8 + gh * 2 + (i >> 1)][i & 1] = a;
      }
    }
    attnC_stage_store<3>(buf1, rg);
    attnC_stage_load<4>(p, bl, h, rs, rg);
    const int qc = jw * 16 + l15;
    const int win0 = min(max(qc - 8, 0), 48);
#pragma unroll
    for (int g = 0; g < 8; ++g) {
      const int ri = (rs + g - r + 7) * 31;
#pragma unroll
      for (int hf = 0; hf < 2; ++hf)
#pragma unroll
        for (int j = 0; j < 4; ++j) {
          const int kc = band0 + quad * 8 + hf * 4 + j;
          const bool valid = (kc >= win0) && (kc < win0 + 16);
          const int dc = min(max(kc - qc + 15, 0), 30);
          const float bias = rpbs[ri + dc];
          s[g][hf][j] = valid ? s[g][hf][j] + bias : -INFINITY;
        }
    }
    float mx = -INFINITY;
#pragma unroll
    for (int g = 0; g < 16; ++g)
#pragma unroll
      for (int hf = 0; hf < 2; ++hf)
#pragma unroll
        for (int j = 0; j < 4; ++j) mx = fmaxf(mx, s[g][hf][j]);
    mx = fmaxf(mx, __shfl_xor(mx, 16));
    mx = fmaxf(mx, __shfl_xor(mx, 32));
#pragma unroll
    for (int g = 0; g < 16; ++g)
#pragma unroll
      for (int hf = 0; hf < 2; ++hf)
#pragma unroll
        for (int j = 0; j < 4; ++j) { const float e = fexp2(s[g][hf][j] - mx); s[g][hf][j] = e; ls += e; }
    ls += __shfl_xor(ls, 16);
    ls += __shfl_xor(ls, 32);
    __syncthreads();
  }
#pragma unroll
  for (int st = 0; st < 2; ++st) {
    const u16* buf = st ? buf0 : buf1;
#pragma unroll
    for (int kh = 0; kh < 2; ++kh) {
      bf16x8 vf[2][4];
#pragma unroll
      for (int k2 = 0; k2 < 2; ++k2) {
        const int c = (kh * 2 + k2) * 8 + (band0 >> 3) + quad;
#pragma unroll
        for (int dvt = 0; dvt < 4; ++dvt) {
          const int dv = (dvt >> 1) * 32 + (l15 >> 2) * 8 + (dvt & 1) * 4 + (l15 & 3);
          vf[k2][dvt] = attnC_vfrag(buf, dv, c);
        }
      }
#pragma unroll
      for (int k2 = 0; k2 < 2; ++k2) {
        const int kr = kh * 2 + k2;
        const bf16x8 pf = pack8f(s[st * 4 + kr][0], s[st * 4 + kr][1]);
#pragma unroll
        for (int dvt = 0; dvt < 4; ++dvt) O[dvt] = mfma16(vf[k2][dvt], pf, O[dvt]);
      }
    }
    if (st == 0) { attnC_stage_store<4>(buf0, rg); attnC_stage_load<5>(p, bl, h, rs, rg); }
    else { attnC_stage_store<5>(buf1, rg); }
    __syncthreads();
  }
#pragma unroll
  for (int gh = 0; gh < 4; ++gh) {
    bf16x8 vf[2][4];
#pragma unroll
    for (int k2 = 0; k2 < 2; ++k2) {
      const int c = (gh * 2 + k2) * 4 + quad;
#pragma unroll
      for (int dvt = 0; dvt < 4; ++dvt) {
        const int dv = (dvt >> 1) * 32 + (l15 >> 2) * 8 + (dvt & 1) * 4 + (l15 & 3);
        vf[k2][dvt] = attnC_vfrag(buf1, dv, c);
      }
    }
#pragma unroll
    for (int k2 = 0; k2 < 2; ++k2) {
      const int g = gh * 2 + k2;
      const bf16x8 pf = pack8f(s[8 + g][0], s[8 + g][1]);
#pragma unroll
      for (int dvt = 0; dvt < 4; ++dvt) O[dvt] = mfma16(vf[k2][dvt], pf, O[dvt]);
    }
  }
  const float inv = 1.f / ls;
  u16* dst = p.YS + qrow * 2048 + YS_C + h * 64;
#pragma unroll
  for (int u = 0; u < 2; ++u) {
    f32x4 a = O[2 * u] * inv, b = O[2 * u + 1] * inv;
    *(u32x4*)(dst + u * 32 + quad * 8) = pack8(a, b);
  }
}

template <int ST>
DEV void c2_load(const Params& p, int bl, int h, int base, u32x4 (&rg)[4]) {
  const int t = ptid();
  if (ST < 3) {
    const u16* b = p.PX + (size_t)bl * 2048 * PXW + PX_CK + h * 64;
#pragma unroll
    for (int i = 0; i < 3; ++i) {
      const int id = t + 512 * i, key = id >> 3, c = id & 7;
      const int row = min(base + ST * 3 + (key >> 6), 31);
      rg[i] = *(const u32x4*)(b + (size_t)(row * 64 + (key & 63)) * PXW + c * 8);
    }
  } else if (ST == 3) {
    const u16* b = p.PX + ((size_t)LR + bl * 256) * PXW + PX_CK + h * 64;
    const unsigned o = (unsigned)((t >> 3) * PXW + (t & 7) * 8);
#pragma unroll
    for (int i = 0; i < 4; ++i) rg[i] = *(const u32x4*)((b + (size_t)(64 * i) * PXW) + o);
  } else if (ST < 7) {
    const u16* b = p.VTC + ((size_t)((bl * 8 + h) * 64)) * KV + (base + (ST - 4) * 3) * 64;
#pragma unroll
    for (int i = 0; i < 3; ++i) {
      const int id = t + 512 * i, dv = id / 24, c = id - dv * 24;
      rg[i] = *(const u32x4*)(b + (size_t)dv * KV + c * 8);
    }
  } else {
    const u16* b = p.VTC + ((size_t)((bl * 8 + h) * 64)) * KV + 2048;
    const unsigned o = (unsigned)((t >> 5) * KV + (t & 31) * 8);
#pragma unroll
    for (int i = 0; i < 4; ++i) rg[i] = *(const u32x4*)((b + (size_t)(16 * i) * KV) + o);
  }
}
template <int ST>
DEV void c2_store(u16* buf, const u32x4 (&rg)[4]) {
  const int t = ptid();
  if (ST <= 3) {
    constexpr int N = (ST == 3) ? 4 : 3;
#pragma unroll
    for (int i = 0; i < N; ++i) {
      const int id = t + 512 * i, row = id >> 3, c = id & 7, key = ((row >> 3) & 3) * 2 + ((row >> 1) & 1);
      *(u32x4*)(buf + row * 64 + ((c ^ key) << 3)) = rg[i];
    }
  } else if (ST < 7) {
#pragma unroll
    for (int i = 0; i < 3; ++i) {
      const int id = t + 512 * i, dv = id / 24, c = id - dv * 24, key = ((dv >> 3) & 3) * 4 + (dv & 3);
      *(u32x4*)(buf + dv * 256 + ((c ^ key) << 3)) = rg[i];
    }
  } else {
#pragma unroll
    for (int i = 0; i < 4; ++i) {
      const int id = t + 512 * i, dv = id >> 5, c = id & 31, key = ((dv >> 3) & 3) * 4 + (dv & 3);
      *(u32x4*)(buf + dv * 256 + ((c ^ key) << 3)) = rg[i];
    }
  }
}
DEV bf16x8 c2k(const LASP unsigned char* buf, int row, int chunk) {
  const int key = ((row >> 3) & 3) * 2 + ((row >> 1) & 1);
  return *(const LASP bf16x8*)(buf + row * 128 + ((chunk ^ key) << 4));
}
DEV bf16x8 c2v(const LASP unsigned char* buf, int dv, int chunk) {
  const int key = ((dv >> 3) & 3) * 4 + (dv & 3);
  return *(const LASP bf16x8*)(buf + dv * 512 + ((chunk ^ key) << 4));
}
template <int ST>
DEV void c2_dma(const Params& p, int bl, int h, int base, LASP unsigned char* slot, int w, int lane) {
  if (ST <= 3) {
    constexpr int NB = (ST == 3) ? 4 : 3;
#pragma unroll
    for (int i = 0; i < NB; ++i) {
      const int b = w * NB + i;
      const int row = b * 8 + (lane >> 3), c = (lane & 7) ^ (((row >> 3) & 3) * 2 + ((row >> 1) & 1));
      const u16* src;
      if (ST < 3) {
        const int grow = min(base + ST * 3 + (row >> 6), 31);
        src = p.PX + ((size_t)bl * 2048 + grow * 64 + (row & 63)) * PXW + PX_CK + h * 64 + c * 8;
      } else {
        src = p.PX + ((size_t)LR + bl * 256 + row) * PXW + PX_CK + h * 64 + c * 8;
      }
      __builtin_amdgcn_global_load_lds((const unsigned*)src, (LASP unsigned*)(slot + b * 1024), 16, 0, 0);
    }
  } else {
#pragma unroll
    for (int i = 0; i < 4; ++i) {
      const int b = w * 4 + i;
      const int dv = b * 2 + (lane >> 5);
      int c = (lane & 31) ^ (((dv >> 3) & 3) * 4 + (dv & 3));
      const u16* vb = p.VTC + ((size_t)((bl * 8 + h) * 64 + dv)) * KV;
      const u16* src;
      if (ST < 7) { if (c >= 24) c -= 8; src = vb + (base + (ST - 4) * 3) * 64 + c * 8; }
      else src = vb + 2048 + c * 8;
      __builtin_amdgcn_global_load_lds((const unsigned*)src, (LASP unsigned*)(slot + b * 1024), 16, 0, 0);
    }
  }
}
template <int K3>
DEV void c2_kloc(const LASP unsigned char* buf, f32x4 (&sl)[9][2], const bf16x8 (&qf)[2], int band0, int kk, int quad) {
#pragma unroll
  for (int hf = 0; hf < 2; ++hf) {
    bf16x8 kf[3][2];
#pragma unroll
    for (int i = 0; i < 3; ++i) {
      const int row = i * 64 + band0 + kk + hf * 4;
      kf[i][0] = c2k(buf, row, quad);
      kf[i][1] = c2k(buf, row, 4 + quad);
    }
#pragma unroll
    for (int i = 0; i < 3; ++i) {
      f32x4 a = (f32x4){0.f, 0.f, 0.f, 0.f};
      a = mfma16(kf[i][0], qf[0], a);
      a = mfma16(kf[i][1], qf[1], a);
      sl[K3 * 3 + i][hf] = a;
    }
  }
}
template <int K3>
DEV void c2_vloc(const LASP unsigned char* buf, f32x4 (&sl)[9][2], f32x4 (&O)[4], int band0, int l15, int quad) {
  bf16x8 vf[3][4];
#pragma unroll
  for (int i = 0; i < 3; ++i) {
    const int c = i * 8 + (band0 >> 3) + quad;
#pragma unroll
    for (int dvt = 0; dvt < 4; ++dvt) {
      const int dv = (dvt >> 1) * 32 + (l15 >> 2) * 8 + (dvt & 1) * 4 + (l15 & 3);
      vf[i][dvt] = c2v(buf, dv, c);
    }
  }
#pragma unroll
  for (int i = 0; i < 3; ++i) {
    const bf16x8 pf = pack8f(sl[K3 * 3 + i][0], sl[K3 * 3 + i][1]);
#pragma unroll
    for (int dvt = 0; dvt < 4; ++dvt) O[dvt] = mfma16(vf[i][dvt], pf, O[dvt]);
  }
}

DEV void attnC2_unit(const Params& p, int l, int bl, int h, int rp, u16* ldsg) {
  const int t = ptid(), lane = t & 63, w = __builtin_amdgcn_readfirstlane(t >> 6), l15 = lane & 15, quad = lane >> 4;
  const int qr = w >> 2, jw = w & 3;
  LASP unsigned char* L = (LASP unsigned char*)ldsg;
  float* rpbs = (float*)(ldsg + 65536);
  const int r0 = rp * 2;
  const int base = min(max(r0 - 4, 0), 24);
  const int d = qr ? (min(max(r0 - 3, 0), 24) - base) : 0;
  const int r = r0 + qr;
  const int band0 = min(max(jw * 16 - 8, 0), 32);
  const int kk = (l15 >> 2) * 8 + (l15 & 3);
#define C2_WAIT(n) asm volatile("s_waitcnt vmcnt(" #n ")" ::: "memory")
  __syncthreads();
  for (int i = t; i < 465; i += 512) rpbs[i] = p.c_rpb[(size_t)(l * 8 + h) * 465 + i] * LOG2E;
  const size_t qrow = (size_t)bl * 2048 + r * 64 + jw * 16 + l15;
  bf16x8 qf[2];
#pragma unroll
  for (int ks = 0; ks < 2; ++ks) qf[ks] = *(const bf16x8*)(p.PX + qrow * PXW + PX_CQ + h * 64 + ks * 32 + quad * 8);
  c2_dma<0>(p, bl, h, base, L, w, lane);
  c2_dma<1>(p, bl, h, base, L + 32768, w, lane);
  c2_dma<2>(p, bl, h, base, L + 65536, w, lane);
  f32x4 sl[9][2], sc[8][2];
  f32x4 O[4];
#pragma unroll
  for (int i = 0; i < 4; ++i) O[i] = (f32x4){0.f, 0.f, 0.f, 0.f};
  float ls = 0.f;
  asm volatile("s_waitcnt lgkmcnt(0)" ::: "memory");
  C2_WAIT(6); __builtin_amdgcn_s_barrier();
  c2_dma<3>(p, bl, h, base, L + 98304, w, lane);
  c2_kloc<0>(L, sl, qf, band0, kk, quad);
  C2_WAIT(7); __builtin_amdgcn_s_barrier();
  c2_dma<4>(p, bl, h, base, L, w, lane);
  c2_kloc<1>(L + 32768, sl, qf, band0, kk, quad);
  C2_WAIT(8); __builtin_amdgcn_s_barrier();
  c2_dma<5>(p, bl, h, base, L + 32768, w, lane);
  c2_kloc<2>(L + 65536, sl, qf, band0, kk, quad);
  C2_WAIT(8); __builtin_amdgcn_s_barrier();
  c2_dma<6>(p, bl, h, base, L + 65536, w, lane);
  {
#pragma unroll
    for (int gh = 0; gh < 4; ++gh) {
      bf16x8 kf[4][2];
#pragma unroll
      for (int i = 0; i < 4; ++i) {
        const int g = gh * 2 + (i >> 1), hf = i & 1;
        const int row = g * 32 + kk + hf * 4;
        kf[i][0] = c2k(L + 98304, row, quad);
        kf[i][1] = c2k(L + 98304, row, 4 + quad);
      }
#pragma unroll
      for (int i = 0; i < 4; ++i) {
        f32x4 a = (f32x4){0.f, 0.f, 0.f, 0.f};
        a = mfma16(kf[i][0], qf[0], a);
        a = mfma16(kf[i][1], qf[1], a);
        sc[gh * 2 + (i >> 1)][i & 1] = a;
      }
    }
    const int qc = jw * 16 + l15;
    const int win0 = min(max(qc - 8, 0), 48);
#pragma unroll
    for (int a = 0; a < 9; ++a) {
      const bool rowvalid = (a >= d) && (a < d + 8);
      const int ri = min(max(base + a - r + 7, 0), 14) * 31;
#pragma unroll
      for (int hf = 0; hf < 2; ++hf)
#pragma unroll
        for (int j = 0; j < 4; ++j) {
          const int kc = band0 + quad * 8 + hf * 4 + j;
          const bool valid = rowvalid && (kc >= win0) && (kc < win0 + 16);
          const int dc = min(max(kc - qc + 15, 0), 30);
          const float bias = rpbs[ri + dc];
          sl[a][hf][j] = valid ? sl[a][hf][j] + bias : -INFINITY;
        }
    }
    float mx = -INFINITY;
#pragma unroll
    for (int a = 0; a < 9; ++a)
#pragma unroll
      for (int hf = 0; hf < 2; ++hf)
#pragma unroll
        for (int j = 0; j < 4; ++j) mx = fmaxf(mx, sl[a][hf][j]);
#pragma unroll
    for (int g = 0; g < 8; ++g)
#pragma unroll
      for (int hf = 0; hf < 2; ++hf)
#pragma unroll
        for (int j = 0; j < 4; ++j) mx = fmaxf(mx, sc[g][hf][j]);
    mx = fmaxf(mx, __shfl_xor(mx, 16));
    mx = fmaxf(mx, __shfl_xor(mx, 32));
#pragma unroll
    for (int a = 0; a < 9; ++a)
#pragma unroll
      for (int hf = 0; hf < 2; ++hf)
#pragma unroll
        for (int j = 0; j < 4; ++j) { const float e = fexp2(sl[a][hf][j] - mx); sl[a][hf][j] = e; ls += e; }
#pragma unroll
    for (int g = 0; g < 8; ++g)
#pragma unroll
      for (int hf = 0; hf < 2; ++hf)
#pragma unroll
        for (int j = 0; j < 4; ++j) { const float e = fexp2(sc[g][hf][j] - mx); sc[g][hf][j] = e; ls += e; }
    ls += __shfl_xor(ls, 16);
    ls += __shfl_xor(ls, 32);
  }
  C2_WAIT(8); __builtin_amdgcn_s_barrier();
  c2_dma<7>(p, bl, h, base, L + 98304, w, lane);
  c2_vloc<0>(L, sl, O, band0, l15, quad);
  C2_WAIT(8); __builtin_amdgcn_s_barrier();
  c2_vloc<1>(L + 32768, sl, O, band0, l15, quad);
  C2_WAIT(4); __builtin_amdgcn_s_barrier();
  c2_vloc<2>(L + 65536, sl, O, band0, l15, quad);
  C2_WAIT(0); __builtin_amdgcn_s_barrier();
#pragma unroll
  for (int gh = 0; gh < 4; ++gh) {
    bf16x8 vf[2][4];
#pragma unroll
    for (int k2 = 0; k2 < 2; ++k2) {
      const int c = (gh * 2 + k2) * 4 + quad;
#pragma unroll
      for (int dvt = 0; dvt < 4; ++dvt) {
        const int dv = (dvt >> 1) * 32 + (l15 >> 2) * 8 + (dvt & 1) * 4 + (l15 & 3);
        vf[k2][dvt] = c2v(L + 98304, dv, c);
      }
    }
#pragma unroll
    for (int k2 = 0; k2 < 2; ++k2) {
      const int g = gh * 2 + k2;
      const bf16x8 pf = pack8f(sc[g][0], sc[g][1]);
#pragma unroll
      for (int dvt = 0; dvt < 4; ++dvt) O[dvt] = mfma16(vf[k2][dvt], pf, O[dvt]);
    }
  }
#undef C2_WAIT
  const float inv = 1.f / ls;
  u16* dst = p.YS + qrow * 2048 + YS_C + h * 64;
#pragma unroll
  for (int u = 0; u < 2; ++u) {
    f32x4 a = O[2 * u] * inv, b = O[2 * u + 1] * inv;
    *(u32x4*)(dst + u * 32 + quad * 8) = pack8(a, b);
  }
}

DEV void attnC2_ctx_unit(const Params& p, int l, int bl, int h, int hq, u16* lds) {
  const int t = ptid(), lane = t & 63, w = t >> 6, l15 = lane & 15, quad = lane >> 4;
  u16* buf0 = lds;
  u16* buf1 = lds + 16384;
  const int kk = (l15 >> 2) * 8 + (l15 & 3);
  u32x4 rg[4];
  c2_load<3>(p, bl, h, 0, rg);
  __syncthreads();
  c2_store<3>(buf0, rg);
  c2_load<7>(p, bl, h, 0, rg);
  const size_t qrow = (size_t)LR + bl * 256 + hq * 128 + w * 16 + l15;
  bf16x8 qf[2];
#pragma unroll
  for (int ks = 0; ks < 2; ++ks) qf[ks] = *(const bf16x8*)(p.PX + qrow * PXW + PX_CQ + h * 64 + ks * 32 + quad * 8);
  __syncthreads();
  f32x4 sc[8][2];
#pragma unroll
  for (int gh = 0; gh < 4; ++gh) {
    bf16x8 kf[4][2];
#pragma unroll
    for (int i = 0; i < 4; ++i) {
      const int g = gh * 2 + (i >> 1), hf = i & 1;
      const int row = g * 32 + kk + hf * 4;
      kf[i][0] = attnC_kfrag(buf0, row, quad);
      kf[i][1] = attnC_kfrag(buf0, row, 4 + quad);
    }
#pragma unroll
    for (int i = 0; i < 4; ++i) {
      f32x4 a = (f32x4){0.f, 0.f, 0.f, 0.f};
      a = mfma16(kf[i][0], qf[0], a);
      a = mfma16(kf[i][1], qf[1], a);
      sc[gh * 2 + (i >> 1)][i & 1] = a;
    }
  }
  c2_store<7>(buf1, rg);
  float mx = -INFINITY, ls = 0.f;
#pragma unroll
  for (int g = 0; g < 8; ++g)
#pragma unroll
    for (int hf = 0; hf < 2; ++hf)
#pragma unroll
      for (int j = 0; j < 4; ++j) mx = fmaxf(mx, sc[g][hf][j]);
  mx = fmaxf(mx, __shfl_xor(mx, 16));
  mx = fmaxf(mx, __shfl_xor(mx, 32));
#pragma unroll
  for (int g = 0; g < 8; ++g)
#pragma unroll
    for (int hf = 0; hf < 2; ++hf)
#pragma unroll
      for (int j = 0; j < 4; ++j) { const float e = fexp2(sc[g][hf][j] - mx); sc[g][hf][j] = e; ls += e; }
  ls += __shfl_xor(ls, 16);
  ls += __shfl_xor(ls, 32);
  __syncthreads();
  f32x4 O[4];
#pragma unroll
  for (int i = 0; i < 4; ++i) O[i] = (f32x4){0.f, 0.f, 0.f, 0.f};
#pragma unroll
  for (int gh = 0; gh < 4; ++gh) {
    bf16x8 vf[2][4];
#pragma unroll
    for (int k2 = 0; k2 < 2; ++k2) {
      const int c = (gh * 2 + k2) * 4 + quad;
#pragma unroll
      for (int dvt = 0; dvt < 4; ++dvt) {
        const int dv = (dvt >> 1) * 32 + (l15 >> 2) * 8 + (dvt & 1) * 4 + (l15 & 3);
        vf[k2][dvt] = attnC_vfrag(buf1, dv, c);
      }
    }
#pragma unroll
    for (int k2 = 0; k2 < 2; ++k2) {
      const int g = gh * 2 + k2;
      const bf16x8 pf = pack8f(sc[g][0], sc[g][1]);
#pragma unroll
      for (int dvt = 0; dvt < 4; ++dvt) O[dvt] = mfma16(vf[k2][dvt], pf, O[dvt]);
    }
  }
  const float inv = 1.f / ls;
  u16* dst = p.YS + qrow * 2048 + YS_C + h * 64;
#pragma unroll
  for (int u = 0; u < 2; ++u) {
    f32x4 a = O[2 * u] * inv, b = O[2 * u + 1] * inv;
    *(u32x4*)(dst + u * 32 + quad * 8) = pack8(a, b);
  }
}

DEV void poolB_unit(const Params& p, int l, int bl, int tt, int g, bool isc, u16* lds) {
  const int t = tid(), lane = t & 63, w = t >> 6, l15 = lane & 15, quad = lane >> 4, wx = w & 1, wy = w >> 1;
  u16* Xs = lds;
  u16* Ys = lds + 128 * 136;
  const int L = isc ? 256 : 2048;
  const size_t rowbase = isc ? (size_t)LR + bl * 256 : (size_t)bl * 2048;
  const int wh = 1 << g;
  __syncthreads();
  {
    const int ch = t & 15, seg = t >> 4;
    const u16* pb = p.PX + rowbase * PXW + PX_B + g * 128 + ch * 8;
    switch (g) {
      case 0: pool_rows<1>(pb, Ys, tt, seg, ch, L); break;
      case 1: pool_rows<2>(pb, Ys, tt, seg, ch, L); break;
      case 2: pool_rows<4>(pb, Ys, tt, seg, ch, L); break;
      default: pool_rows<8>(pb, Ys, tt, seg, ch, L); break;
    }
    const u16* wp = p.WPOOL + (size_t)(l * 4 + g) * 16384;
#pragma unroll
    for (int i = 0; i < 8; ++i) {
      const int id = t + 256 * i, d = id >> 4, c8 = id & 15;
      *(u32x4*)(Xs + perm32(d) * 136 + c8 * 8) = *(const u32x4*)(wp + d * 128 + c8 * 8);
    }
  }
  __syncthreads();
  f32x4 acc[4][4];
  zero_acc(acc);
  wave_mma<4, 136>(Xs, Ys, acc, wx, wy, l15, quad);
  const float* sp = p.b_pool_s + l * 512 + g * 128;
#pragma unroll
  for (int yt = 0; yt < 4; ++yt) {
    const size_t row = rowbase + tt * 128 + yidx(wy, yt, l15);
#pragma unroll
    for (int u = 0; u < 2; ++u) {
      const int x0 = xidx(wx, u, quad);
      const float4 s0 = *(const float4*)(sp + x0), s1 = *(const float4*)(sp + x0 + 4);
      f32x4 a = acc[2 * u][yt], b = acc[2 * u + 1][yt];
      a[0] *= s0.x; a[1] *= s0.y; a[2] *= s0.z; a[3] *= s0.w;
      b[0] *= s1.x; b[1] *= s1.y; b[2] *= s1.z; b[3] *= s1.w;
      *(u32x4*)(p.YS + row * 2048 + YS_B + g * 128 + x0) = pack8(a, b);
    }
  }
}

DEV void gateD_unit(const Params& p, int l, int bl, int n, int g, bool isc, u16* lds) {
  const int t = tid(), lane = t & 63, w = t >> 6, l15 = lane & 15, quad = lane >> 4, wx = w & 1, wy = w >> 1;
  u16* Xs = lds;
  u16* Ys = lds + 128 * 136;
  float* rr = (float*)(lds + 2 * 128 * 136);
  const size_t rowbase = (isc ? (size_t)LR + bl * 256 : (size_t)bl * 2048) + n * 128;
  __syncthreads();
  {
    const int q = t >> 1, hl = t & 1;
    const u16* vp = p.PX + (rowbase + q) * PXW + PX_DV + hl * 256;
    float ss = 0.f;
#pragma unroll 8
    for (int i = 0; i < 32; ++i) {
      const u32x4 v = *(const u32x4*)(vp + i * 8);
      const float a0 = bflo(v.x), a1 = bfhi(v.x), a2 = bflo(v.y), a3 = bfhi(v.y), a4 = bflo(v.z), a5 = bfhi(v.z), a6 = bflo(v.w), a7 = bfhi(v.w);
      ss += a0 * a0 + a1 * a1 + a2 * a2 + a3 * a3 + a4 * a4 + a5 * a5 + a6 * a6 + a7 * a7;
    }
    ss += __shfl_xor(ss, 1);
    if (hl == 0) rr[q] = rsqrtf(ss * (1.f / 512.f) + EPS_);
  }
  {
    __syncthreads();
    const u16* wp = p.WSB + (size_t)(l * 4 + g) * 16384;
#pragma unroll
    for (int i = 0; i < 8; ++i) {
      const int id = t + 256 * i, pr = id >> 4, c8 = id & 15;
      *(u32x4*)(Ys + perm32(pr) * 136 + c8 * 8) = *(const u32x4*)(wp + pr * 128 + c8 * 8);
    }
    const float* gv = p.d_vn_g + l * 512 + g * 128;
#pragma unroll 4
    for (int i = 0; i < 8; ++i) {
      const int id = t + 256 * i, q = id >> 4, c8 = id & 15;
      const u32x4 v = *(const u32x4*)(p.PX + (rowbase + q) * PXW + PX_DV + g * 128 + c8 * 8);
      const float rq = rr[q];
      const float4 g0 = *(const float4*)(gv + c8 * 8), g1 = *(const float4*)(gv + c8 * 8 + 4);
      const unsigned o0 = cvt_pk(bflo(v.x) * rq * g0.x, bfhi(v.x) * rq * g0.y);
      const unsigned o1 = cvt_pk(bflo(v.y) * rq * g0.z, bfhi(v.y) * rq * g0.w);
      const unsigned o2 = cvt_pk(bflo(v.z) * rq * g1.x, bfhi(v.z) * rq * g1.y);
      const unsigned o3 = cvt_pk(bflo(v.w) * rq * g1.z, bfhi(v.w) * rq * g1.w);
      const int c = c8 * 8;
      Xs[perm32(c + 0) * 136 + q] = (u16)(o0 & 0xffff); Xs[perm32(c + 1) * 136 + q] = (u16)(o0 >> 16);
      Xs[perm32(c + 2) * 136 + q] = (u16)(o1 & 0xffff); Xs[perm32(c + 3) * 136 + q] = (u16)(o1 >> 16);
      Xs[perm32(c + 4) * 136 + q] = (u16)(o2 & 0xffff); Xs[perm32(c + 5) * 136 + q] = (u16)(o2 >> 16);
      Xs[perm32(c + 6) * 136 + q] = (u16)(o3 & 0xffff); Xs[perm32(c + 7) * 136 + q] = (u16)(o3 >> 16);
    }
    __syncthreads();
    f32x4 acc[4][4];
    zero_acc(acc);
    wave_mma<4, 136>(Xs, Ys, acc, wx, wy, l15, quad);
    const float* bs = p.d_bs + (size_t)(l * 4 + g) * 128;
#pragma unroll
    for (int yt = 0; yt < 4; ++yt) {
      const int pr = yidx(wy, yt, l15);
      const float bb = bs[pr];
      const size_t row = rowbase + pr;
#pragma unroll
      for (int u = 0; u < 2; ++u) {
        const int x0 = xidx(wx, u, quad);
        const u32x4 uu = *(const u32x4*)(p.PX + row * PXW + PX_DU + g * 128 + x0);
        f32x4 a = acc[2 * u][yt], b = acc[2 * u + 1][yt];
        a[0] = (a[0] + bb) * bflo(uu.x); a[1] = (a[1] + bb) * bfhi(uu.x); a[2] = (a[2] + bb) * bflo(uu.y); a[3] = (a[3] + bb) * bfhi(uu.y);
        b[0] = (b[0] + bb) * bflo(uu.z); b[1] = (b[1] + bb) * bfhi(uu.z); b[2] = (b[2] + bb) * bflo(uu.w); b[3] = (b[3] + bb) * bfhi(uu.w);
        *(u32x4*)(p.YS + row * 2048 + YS_D + g * 128 + x0) = pack8(a, b);
      }
    }
  }
}

DEV void phase_mixers(const Params& p, int l, int hf, u16* lds, u16* lds0) {
  const bool last = (l == NLAYER - 1);
  {
    const int PG = (int)gridDim.x, pb = pbid();
    const bool swz = ((PG & 7) == 0) && (1024 % PG == 0);
    for (int v = pb; v < 1024; v += PG) {
      int a, qb;
      if (swz) { const int i = v / PG, s2 = i * (PG >> 3) + (pb >> 3); a = (s2 >> 4) * 8 + (pb & 7); qb = s2 & 15; }
      else { a = v >> 4; qb = v & 15; }
      attnA_unit<false>(p, l, a >> 2, a & 3, qb, lds0);
    }
    if (!last) for (int v = pb; v < 128; v += PG) attnA_unit<true>(p, l, v >> 3, (v >> 1) & 3, v & 1, lds0);
    __syncthreads();
    for (int v = pb; v < 2048; v += PG) attnC2_unit(p, l, v >> 7, (v >> 4) & 7, v & 15, lds0);
    if (!last) for (int v = pb; v < 256; v += PG) attnC2_ctx_unit(p, l, v >> 4, (v >> 1) & 7, v & 1, lds0);
  }
  __syncthreads();
  const int G = vgrid();
  const int nC = 0, nB = 1024, nD = 1024;
  const int nCc = 0, nBc = last ? 0 : 128, nDc = last ? 0 : 128;
  const int e1 = nC, e2 = e1 + nB, e3 = e2 + nD, e5 = e3 + nCc, e6 = e5 + nBc, e7 = e6 + nDc;
  for (int v = bid(); v < e7; v += G) {
    if (v < e1) {
      const int u = v;
      attnC_lds_unit(p, l, u >> 8, (u >> 5) & 7, u & 31, lds);
    } else if (v < e2) {
      const int u = v - e1;
      poolB_unit(p, l, u >> 6, (u >> 2) & 15, u & 3, false, lds);
    } else if (v < e3) {
      const int u = v - e2;
      gateD_unit(p, l, u >> 6, (u >> 2) & 15, u & 3, false, lds);
    } else if (v < e5) {
      const int u = v - e3;
      attnC_unit<true>(p, l, u >> 5, (u >> 2) & 7, u & 3, (float*)lds);
    } else if (v < e6) {
      const int u = v - e5;
      poolB_unit(p, l, u >> 3, (u >> 2) & 1, u & 3, true, lds);
    } else {
      const int u = v - e6;
      gateD_unit(p, l, u >> 3, (u >> 2) & 1, u & 3, true, lds);
    }
  }
}

DEV void phase_merge(const Params& p, int l, int hf, u16* lds) {
  const bool last = (l == NLAYER - 1);
  const int RT = last ? 256 : 288;
  const int t = tid(), lane = t & 63, w = t >> 6, l15 = lane & 15, quad = lane >> 4, wx = w & 1, wy = w >> 1;
  int rt, ct;
  for (int it = 0; next_tile(it, RT, 8, 8, 8, rt, ct); ++it) {
    f32x4 tot[4][4];
    zero_acc(tot);
#pragma unroll 1
    for (int i = 0; i < 4; ++i) {
      f32x4 acc[4][4];
      zero_acc(acc);
      gemm_kloop(p.WBR + ((size_t)l * 1024 + ct * 128) * 2048 + i * 512, 2048, p.YS + (size_t)rt * 128 * 2048 + i * 512, 2048, 8, acc, lds);
#pragma unroll
      for (int yt = 0; yt < 4; ++yt) {
        const size_t row = (size_t)rt * 128 + yidx(wy, yt, l15);
#pragma unroll
        for (int u = 0; u < 2; ++u) {
          const u32x4 gq = *(const u32x4*)(p.PX + row * PXW + PX_G + i * 1024 + ct * 128 + xidx(wx, u, quad));
          tot[2 * u][yt][0] += sigmoidf_(bflo(gq.x)) * acc[2 * u][yt][0];
          tot[2 * u][yt][1] += sigmoidf_(bfhi(gq.x)) * acc[2 * u][yt][1];
          tot[2 * u][yt][2] += sigmoidf_(bflo(gq.y)) * acc[2 * u][yt][2];
          tot[2 * u][yt][3] += sigmoidf_(bfhi(gq.y)) * acc[2 * u][yt][3];
          tot[2 * u + 1][yt][0] += sigmoidf_(bflo(gq.z)) * acc[2 * u + 1][yt][0];
          tot[2 * u + 1][yt][1] += sigmoidf_(bfhi(gq.z)) * acc[2 * u + 1][yt][1];
          tot[2 * u + 1][yt][2] += sigmoidf_(bflo(gq.w)) * acc[2 * u + 1][yt][2];
          tot[2 * u + 1][yt][3] += sigmoidf_(bfhi(gq.w)) * acc[2 * u + 1][yt][3];
        }
      }
    }
#pragma unroll
    for (int yt = 0; yt < 4; ++yt) {
      const size_t row = (size_t)rt * 128 + yidx(wy, yt, l15);
#pragma unroll
      for (int u = 0; u < 2; ++u)
        *(u32x4*)(p.HX + row * 1024 + ct * 128 + xidx(wx, u, quad)) = pack8(tot[2 * u][yt], tot[2 * u + 1][yt]);
    }
  }
}

DEV void phase_resgemm(const Params& p, int l, int hf, int which, u16* lds) {
  const bool last = (l == NLAYER - 1);
  const int RT = last ? 256 : 288;
  const int t = tid(), lane = t & 63, w = t >> 6, l15 = lane & 15, quad = lane >> 4, wx = w & 1, wy = w >> 1;
  const bool first = (which == 0 && l == 0);
  const float* xs = first ? p.x : p.out;
  const float* cs = first ? p.ctx : p.CTXC;
  int rt, ct;
  for (int it = 0; next_tile(it, RT, 8, 8, 8, rt, ct); ++it) {
    f32x4 acc[4][4];
    zero_acc(acc);
    if (which == 0) gemm_kloop(p.WOUT + ((size_t)l * 1024 + ct * 128) * 1024, 1024, p.HX + (size_t)rt * 128 * 1024, 1024, 16, acc, lds);
    else gemm_kloop(p.WDN + ((size_t)l * 1024 + ct * 128) * FH, FH, p.PX + (size_t)rt * 128 * FH, FH, FH / 64, acc, lds);
    int b, idx0; bool isc;
    rowmap(hf, rt * 128, b, idx0, isc);
    const float* gate = p.MOD + ((size_t)l * 33 + (isc ? 32 : b)) * 6144 + (which ? 5 : 2) * 1024 + ct * 128;
    const size_t rb = isc ? ((size_t)b * 256 + idx0) * 1024 : ((size_t)b * 2048 + idx0) * 1024;
    const float* src = (isc ? cs : xs) + rb + ct * 128;
    float* dst = (isc ? p.CTXC : p.out) + rb + ct * 128;
#pragma unroll
    for (int u = 0; u < 2; ++u) {
      const int x0 = xidx(wx, u, quad);
      const float4 g0 = *(const float4*)(gate + x0), g1 = *(const float4*)(gate + x0 + 4);
#pragma unroll
      for (int yt = 0; yt < 4; ++yt) {
        const size_t ro = (size_t)yidx(wy, yt, l15) * 1024 + x0;
        const float4 r0 = *(const float4*)(src + ro), r1 = *(const float4*)(src + ro + 4);
        float4 o0, o1;
        o0.x = r0.x + g0.x * acc[2 * u][yt][0]; o0.y = r0.y + g0.y * acc[2 * u][yt][1];
        o0.z = r0.z + g0.z * acc[2 * u][yt][2]; o0.w = r0.w + g0.w * acc[2 * u][yt][3];
        o1.x = r1.x + g1.x * acc[2 * u + 1][yt][0]; o1.y = r1.y + g1.y * acc[2 * u + 1][yt][1];
        o1.z = r1.z + g1.z * acc[2 * u + 1][yt][2]; o1.w = r1.w + g1.w * acc[2 * u + 1][yt][3];
        *(float4*)(dst + ro) = o0;
        *(float4*)(dst + ro + 4) = o1;
      }
    }
  }
}

DEV void phase_ffnup(const Params& p, int l, u16* lds) {
  const bool last = (l == NLAYER - 1);
  const int t = ptid(), lane = t & 63, w = t >> 6, l15 = lane & 15, quad = lane >> 4, wx = w & 1, wy = w >> 1;
  int rt, ct;
  for (int it = 0; next_tile_p(it, 288, 22, 16, 2, rt, ct); ++it) {
    if (last && (rt % 144) >= 128) continue;
    f32x4 acc[8][4];
    zero_acc8(acc);
    gemm_kloop256(p.WGU + ((size_t)l * 2 * FH + ct * 256) * 1024, 1024, p.YS + (size_t)rt * 256 * 1024, 1024, 16, acc, lds);
#pragma unroll
    for (int yt = 0; yt < 4; ++yt) {
      const size_t row = (size_t)rt * 256 + yidx(wy, yt, l15);
#pragma unroll
      for (int u = 0; u < 4; ++u) {
        const f32x4 a = acc[2 * u][yt], b = acc[2 * u + 1][yt];
        u32x2 o;
        o.x = cvt_pk(a[0] * sigmoidf_(a[0]) * b[0], a[1] * sigmoidf_(a[1]) * b[1]);
        o.y = cvt_pk(a[2] * sigmoidf_(a[2]) * b[2], a[3] * sigmoidf_(a[3]) * b[3]);
        *(u32x2*)(p.PX + row * FH + ct * 128 + (xidx8(wx, u, quad) >> 1)) = o;
      }
    }
  }
}

DEV void phase_down(const Params& p, int l, u16* lds) {
  const bool last = (l == NLAYER - 1);
  const int t = ptid(), lane = t & 63, w = t >> 6, l15 = lane & 15, quad = lane >> 4, wx = w & 1, wy = w >> 1;
  int rt, ct;
  for (int it = 0; next_tile_p(it, 288, 4, 8, 4, rt, ct); ++it) {
    const int hf = rt >= 144 ? 1 : 0;
    const int rl = rt - hf * 144;
    if (last && rl >= 128) continue;
    f32x4 acc[8][4];
    zero_acc8(acc);
    gemm_kloop256(p.WDN + ((size_t)l * 1024 + ct * 256) * FH, FH, p.PX + (size_t)rt * 256 * FH, FH, FH / 64, acc, lds);
    int b, idx0; bool isc;
    rowmap(hf, rl * 256, b, idx0, isc);
    const float* gate = p.MOD + ((size_t)l * 33 + (isc ? 32 : b)) * 6144 + 5 * 1024 + ct * 256;
    const size_t rb = isc ? ((size_t)b * 256 + idx0) * 1024 : ((size_t)b * 2048 + idx0) * 1024;
    float* dst = (isc ? p.CTXC : p.out) + rb + ct * 256;
#pragma unroll
    for (int u = 0; u < 4; ++u) {
      const int x0 = xidx8(wx, u, quad);
      const float4 g0 = *(const float4*)(gate + x0), g1 = *(const float4*)(gate + x0 + 4);
#pragma unroll
      for (int yt = 0; yt < 4; ++yt) {
        const size_t ro = (size_t)yidx(wy, yt, l15) * 1024 + x0;
        const float4 r0 = *(const float4*)(dst + ro), r1 = *(const float4*)(dst + ro + 4);
        float4 o0, o1;
        o0.x = r0.x + g0.x * acc[2 * u][yt][0]; o0.y = r0.y + g0.y * acc[2 * u][yt][1];
        o0.z = r0.z + g0.z * acc[2 * u][yt][2]; o0.w = r0.w + g0.w * acc[2 * u][yt][3];
        o1.x = r1.x + g1.x * acc[2 * u + 1][yt][0]; o1.y = r1.y + g1.y * acc[2 * u + 1][yt][1];
        o1.z = r1.z + g1.z * acc[2 * u + 1][yt][2]; o1.w = r1.w + g1.w * acc[2 * u + 1][yt][3];
        *(float4*)(dst + ro) = o0;
        *(float4*)(dst + ro + 4) = o1;
      }
    }
  }
}

namespace pg8 {
#define PG8_LAS __attribute__((address_space(3)))
typedef unsigned short bf16_t;
typedef short bf16x8 __attribute__((ext_vector_type(8)));
typedef float f32x4 __attribute__((ext_vector_type(4)));
constexpr int BM = 256, BK = 64, HALF = 128, HTB = HALF * BK * 2, STAGE_BYTES = 8 * HTB;
__host__ __device__ __forceinline__ int lds_byte(int r, int c) { const int st = (r >> 4) * 2 + (c >> 5), rr = r & 15, cc = c & 31, ob = rr * 64 + cc * 2; return st * 1024 + (ob ^ (((ob >> 9) & 1) << 5)); }
__host__ __device__ __forceinline__ void stage_rc(int b, int& R, int& C) { const int st = b / 1024, sb = b % 1024, swz = sb ^ (((sb >> 9) & 1) << 5); R = (st >> 1) * 16 + swz / 64; C = (st & 1) * 32 + (swz % 64) / 2; }
__host__ __device__ __forceinline__ int perm32(int rho) { const int n = rho >> 4, i = rho & 15; return 8 * (i >> 2) + 4 * n + (i & 3); }
struct Unit { const char* a; const char* b; int pm, pn, kind; };
template <class Epi, class Sched, bool ALIGN_EPI = false, bool SP2 = false>
__device__ __forceinline__ void gemm_phase(PG8_LAS unsigned char* lds, const int K_, const int lda, const int ldb, const Sched& S, const Epi& E) {
    const int tid = ptid(), wid = __builtin_amdgcn_readfirstlane(tid >> 6), lane = tid & 63, wr = wid >> 2, wc = wid & 3, fr = lane & 15, fq = lane >> 4;
    const int K = K_, nt = K / BK;
    unsigned voffA[2], voffB[2];
#pragma unroll
    for (int i = 0; i < 2; ++i) { int R, C; stage_rc(tid * 16 + i * 8192, R, C); const int Rb = 64 * ((R >> 5) & 3) + perm32(R & 31);
        voffA[i] = (unsigned)(R * lda + C) * 2u; voffB[i] = (unsigned)(Rb * ldb + C) * 2u; }
    const size_t kstep = (size_t)(BK * 2);
    const size_t hstep = (size_t)HALF * lda * 2;
    const size_t hstepB = (size_t)32 * ldb * 2;
    const unsigned ldsw = (unsigned)wid * 1024u;
    const int aoff = lds_byte(wr * 64 + fr, fq * 8), boff = lds_byte(wc * 32 + fr, fq * 8);
#define PG8_SA(b, h) (((b) * 2 + (h)) * HTB)
#define PG8_SB(b, h) ((4 + (b) * 2 + (h)) * HTB)
#define PG8_STAGE(bufoff, gbase, voff) do { _Pragma("unroll") for (int _i = 0; _i < 2; ++_i) \
        __builtin_amdgcn_global_load_lds((const unsigned*)((const char*)(gbase) + (voff)[_i]), (PG8_LAS unsigned*)(lds + (bufoff) + ldsw + _i * 8192), 16, 0, 0); } while (0)
#define PG8_LDA(dst, b, h) do { _Pragma("unroll") for (int m = 0; m < 4; ++m) _Pragma("unroll") for (int k = 0; k < 2; ++k) dst[m][k] = *(const PG8_LAS bf16x8*)(lds + PG8_SA(b, h) + aoff + m * 2048 + k * 1024); } while (0)
#define PG8_LDB(dst, b, h) do { _Pragma("unroll") for (int n = 0; n < 2; ++n) _Pragma("unroll") for (int k = 0; k < 2; ++k) dst[n][k] = *(const PG8_LAS bf16x8*)(lds + PG8_SB(b, h) + boff + n * 2048 + k * 1024); } while (0)
#define PG8_MMA(ai, bj, At, Bt) do { __builtin_amdgcn_s_setprio(1); _Pragma("unroll") for (int m = 0; m < 4; ++m) _Pragma("unroll") for (int n = 0; n < 2; ++n) _Pragma("unroll") for (int k = 0; k < 2; ++k) \
        acc[ai][bj][m][n] = __builtin_amdgcn_mfma_f32_16x16x32_bf16(Bt[n][k], At[m][k], acc[ai][bj][m][n], 0, 0, 0); __builtin_amdgcn_s_setprio(0); } while (0)
#define PG8_WAIT_V(n) asm volatile("s_waitcnt vmcnt(" #n ")" ::: "memory")
#define PG8_WAIT_L(n) asm volatile("s_waitcnt lgkmcnt(" #n ")" ::: "memory")
#define PG8_BAR __builtin_amdgcn_s_barrier()
#define PG8_SCHED __builtin_amdgcn_sched_barrier(0)
    Unit cur, nxt; int ui = 0;
    if (!S.next(0, cur)) return;
    f32x4 acc[2][2][4][2];
#pragma unroll
    for (int a = 0; a < 2; ++a)
#pragma unroll
        for (int b = 0; b < 2; ++b)
#pragma unroll
            for (int m = 0; m < 4; ++m)
#pragma unroll
                for (int n = 0; n < 2; ++n) acc[a][b][m][n] = (f32x4){0.f, 0.f, 0.f, 0.f};
    bf16x8 At[4][2], B0[2][2], B1[2][2];
    const char* cA = cur.a; const char* cB = cur.b;
    S.a_ready(cur);
    if constexpr (SP2) {
        PG8_STAGE(PG8_SB(0, 0), cB, voffB); PG8_STAGE(PG8_SB(0, 1), cB + hstepB, voffB); PG8_STAGE(PG8_SA(0, 0), cA, voffA); PG8_STAGE(PG8_SA(0, 1), cA + hstep, voffA);
        if (wr == 1) PG8_BAR;
        PG8_WAIT_V(2); PG8_BAR;
        PG8_STAGE(PG8_SB(1, 0), cB + kstep, voffB); PG8_STAGE(PG8_SA(1, 0), cA + kstep, voffA); PG8_STAGE(PG8_SB(1, 1), cB + hstepB + kstep, voffB);
        PG8_WAIT_V(6); PG8_BAR;
    } else {
        PG8_STAGE(PG8_SB(0, 0), cB, voffB); PG8_STAGE(PG8_SA(0, 0), cA, voffA); PG8_STAGE(PG8_SB(0, 1), cB + hstepB, voffB); PG8_STAGE(PG8_SA(0, 1), cA + hstep, voffA);
        if (wr == 1) PG8_BAR;
        PG8_WAIT_V(4); PG8_BAR;
        PG8_STAGE(PG8_SB(1, 0), cB + kstep, voffB); PG8_STAGE(PG8_SA(1, 0), cA + kstep, voffA); PG8_STAGE(PG8_SB(1, 1), cB + hstepB + kstep, voffB);
        PG8_WAIT_V(6); PG8_BAR;
    }
    for (;;) {
        const bool has_next = S.next(ui + 1, nxt);
        const char* nA = has_next ? nxt.a : cA; const char* nB = has_next ? nxt.b : cB;
        for (int t = 0; t < nt; t += 2) {
            const bool last = (t == nt - 2);
            const char* a1 = cA + (size_t)(t + 1) * kstep;
            const char* a2 = last ? nA : cA + (size_t)(t + 2) * kstep; const char* b2 = last ? nB : cB + (size_t)(t + 2) * kstep;
            const char* a3 = a2 + kstep; const char* b3 = b2 + kstep;
            if (last && has_next) S.a_ready(nxt);
            if constexpr (SP2) {
            PG8_LDB(B0, 0, 0); PG8_LDB(B1, 0, 1); PG8_SCHED; PG8_LDA(At, 0, 0); PG8_STAGE(PG8_SA(1, 1), a1 + hstep, voffA);
            PG8_WAIT_V(8); PG8_WAIT_L(0); PG8_BAR; PG8_MMA(0, 0, At, B0); PG8_MMA(0, 1, At, B1); PG8_BAR; PG8_SCHED;
            PG8_LDA(At, 0, 1); PG8_STAGE(PG8_SB(0, 0), b2, voffB); PG8_STAGE(PG8_SB(0, 1), b2 + hstepB, voffB); PG8_STAGE(PG8_SA(0, 0), a2, voffA);
            PG8_WAIT_V(8); PG8_WAIT_L(0); PG8_BAR; PG8_MMA(1, 0, At, B0); PG8_MMA(1, 1, At, B1); PG8_BAR; PG8_SCHED;
            PG8_LDB(B0, 1, 0); PG8_LDB(B1, 1, 1); PG8_SCHED; PG8_LDA(At, 1, 0); PG8_STAGE(PG8_SA(0, 1), a2 + hstep, voffA);
            PG8_WAIT_V(8); PG8_WAIT_L(0); PG8_BAR; PG8_MMA(0, 0, At, B0); PG8_MMA(0, 1, At, B1); PG8_BAR; PG8_SCHED;
            PG8_LDA(At, 1, 1); PG8_STAGE(PG8_SB(1, 0), b3, voffB); PG8_STAGE(PG8_SB(1, 1), b3 + hstepB, voffB); PG8_STAGE(PG8_SA(1, 0), a3, voffA);
            PG8_WAIT_V(8); PG8_WAIT_L(0); PG8_BAR; PG8_MMA(1, 0, At, B0); PG8_MMA(1, 1, At, B1); PG8_BAR; PG8_SCHED;
            } else {
            PG8_LDB(B0, 0, 0); PG8_SCHED; PG8_LDA(At, 0, 0); PG8_STAGE(PG8_SA(1, 1), a1 + hstep, voffA);
            PG8_WAIT_L(8); PG8_BAR; PG8_WAIT_L(0); PG8_MMA(0, 0, At, B0); PG8_BAR; PG8_SCHED;
            PG8_LDB(B1, 0, 1); PG8_STAGE(PG8_SB(0, 0), b2, voffB);
            PG8_BAR; PG8_WAIT_L(0); PG8_MMA(0, 1, At, B1); PG8_BAR;
            PG8_LDA(At, 0, 1); PG8_STAGE(PG8_SA(0, 0), a2, voffA);
            PG8_BAR; PG8_WAIT_L(0); PG8_MMA(1, 0, At, B0); PG8_BAR; PG8_SCHED;
            PG8_STAGE(PG8_SB(0, 1), b2 + hstepB, voffB);
            PG8_WAIT_V(6); PG8_BAR; PG8_MMA(1, 1, At, B1); PG8_BAR;
            PG8_LDB(B0, 1, 0); PG8_SCHED; PG8_LDA(At, 1, 0); PG8_STAGE(PG8_SA(0, 1), a2 + hstep, voffA);
            PG8_WAIT_L(8); PG8_BAR; PG8_WAIT_L(0); PG8_MMA(0, 0, At, B0); PG8_BAR; PG8_SCHED;
            PG8_LDB(B1, 1, 1); PG8_STAGE(PG8_SB(1, 0), b3, voffB);
            PG8_BAR; PG8_WAIT_L(0); PG8_MMA(0, 1, At, B1); PG8_BAR;
            PG8_LDA(At, 1, 1); PG8_STAGE(PG8_SA(1, 0), a3, voffA);
            PG8_BAR; PG8_WAIT_L(0); PG8_MMA(1, 0, At, B0); PG8_BAR; PG8_SCHED;
            PG8_STAGE(PG8_SB(1, 1), b3 + hstepB, voffB);
            PG8_WAIT_V(6); PG8_BAR; PG8_MMA(1, 1, At, B1); PG8_BAR;
            }
        }
        if constexpr (ALIGN_EPI) { if (wr == 0) PG8_BAR; }
        if constexpr (!Epi::AFTER_DRAIN) { E(acc, cur, wr, wc, fr, fq); S.done(cur); }
        if (!has_next) break;
#pragma unroll
        for (int a = 0; a < 2; ++a)
#pragma unroll
            for (int b = 0; b < 2; ++b)
#pragma unroll
                for (int m = 0; m < 4; ++m)
#pragma unroll
                    for (int n = 0; n < 2; ++n) acc[a][b][m][n] = (f32x4){0.f, 0.f, 0.f, 0.f};
        cur = nxt; cA = nA; cB = nB; ++ui;
        if constexpr (ALIGN_EPI) { if (wr == 1) PG8_BAR; }
    }
    PG8_WAIT_V(0);
    if constexpr (!ALIGN_EPI) { if (wr == 0) PG8_BAR; }
    PG8_BAR;
    if constexpr (Epi::AFTER_DRAIN) { E.fused(acc, cur, wr, wc, fr, fq, lds, wid, lane); S.done(cur); }
#undef PG8_SA
#undef PG8_SB
#undef PG8_STAGE
#undef PG8_LDA
#undef PG8_LDB
#undef PG8_MMA
#undef PG8_WAIT_V
#undef PG8_WAIT_L
#undef PG8_BAR
#undef PG8_SCHED
}
}

DEV bool tile_p(int it, int RT, int CT, int PR, int PC, int& rt, int& ct) {
  const int b = pbid();
  const int G = (int)gridDim.x;
  if (G != 8 * PR * PC) {
    const int v = it * G + b;
    if (v >= RT * CT) return false;
    rt = v / CT; ct = v - rt * CT;
    return true;
  }
  const int x = b & 7, lb = b >> 3;
  const int gp = it * 8 + x;
  const int npc = CT / PC, npr = RT / PR;
  if (gp >= npc * npr) return false;
  const int prow = gp / npc, pcol = gp - prow * npc;
  rt = prow * PR + lb / PC;
  ct = pcol * PC + lb % PC;
  return true;
}
struct SchedInproj {
  const char* hx; const char* win; bool last;
  DEV bool next(int i, pg8::Unit& u) const {
    int cnt = -1;
    for (int it = 0;; ++it) {
      int rt, ct;
      if (!tile_p(it, 144, 34, 16, 2, rt, ct)) return false;
      const bool ctxrow = rt >= 128;
      const bool valid = !(last && ctxrow && !((ct >= 2 && ct < 6) || (ct >= 10 && ct < 14)));
      if (valid && ++cnt == i) {
        const bool isv = (ct == 4 || ct == 5 || ct == 12 || ct == 13);
        const char* at = hx + (size_t)rt * (256 * 1024 * 2);
        const char* wt = win + (size_t)ct * (256 * 1024 * 2);
        u.a = isv ? wt : at; u.b = isv ? at : wt; u.pm = rt; u.pn = ct; u.kind = isv ? 1 : 0;
        return true;
      }
    }
  }
  DEV void a_ready(const pg8::Unit&) const {}
  DEV void done(const pg8::Unit&) const {}
};
struct SchedFull {
  const char* A; const char* W; size_t tstep; int CT, PR, PC; bool last;
  DEV bool next(int i, pg8::Unit& u) const {
    int cnt = -1;
    for (int it = 0;; ++it) {
      int rt, ct;
      if (!tile_p(it, 288, CT, PR, PC, rt, ct)) return false;
      const bool valid = !(last && (rt % 144) >= 128);
      if (valid && ++cnt == i) { u.a = A + (size_t)rt * tstep; u.b = W + (size_t)ct * tstep; u.pm = rt; u.pn = ct; u.kind = 0; return true; }
    }
  }
  DEV void a_ready(const pg8::Unit&) const {}
  DEV void done(const pg8::Unit&) const {}
};

struct EpiInproj {
  static constexpr bool PERM = true, AFTER_DRAIN = false;
  const Params& p; int l;
  DEV void operator()(f32x4 (&acc)[2][2][4][2], const pg8::Unit& u, int wr, int wc, int fr, int fq) const {
    const int rt = u.pm, ct = u.pn;
    const bool ctxrow = rt >= 128;
    if (u.kind == 0) {
      if (ct < 4 || (ct >= 8 && ct < 12)) {
        const int seg = ct < 4 ? (ct >> 1) : 2 + ((ct - 8) >> 1);
        const float* gq = (seg < 2 ? p.a_qk_g : p.c_qk_g) + l * 128 + (seg & 1) * 64;
        const float qs = (seg == 0 || seg == 2) ? 0.125f * LOG2E : 1.f;
        const bool dorope = (seg < 2) && !ctxrow;
        float gl[2][2][4], inv[8];
        int q2 = fq;
        asm volatile("" : "+v"(q2) : "v"(acc[0][0][0][0][0]));
#pragma unroll
        for (int bj = 0; bj < 2; ++bj)
#pragma unroll
          for (int n = 0; n < 2; ++n)
#pragma unroll
            for (int j = 0; j < 4; ++j) gl[bj][n][j] = gq[bj * 32 + q2 * 8 + n * 4 + j] * qs;
#pragma unroll
        for (int k = 0; k < 8; ++k) inv[k] = fexp2(-(float)((q2 & 1) * 8 + k) * (13.287712379549449f / 16.f));
#pragma unroll
        for (int ai = 0; ai < 2; ++ai)
#pragma unroll
          for (int m = 0; m < 4; ++m) {
            float ss = 0.f;
#pragma unroll
            for (int bj = 0; bj < 2; ++bj)
#pragma unroll
              for (int n = 0; n < 2; ++n)
#pragma unroll
                for (int j = 0; j < 4; ++j) ss += acc[ai][bj][m][n][j] * acc[ai][bj][m][n][j];
            ss += __shfl_xor(ss, 16);
            ss += __shfl_xor(ss, 32);
            const float r = rsqrtf(ss * (1.f / 64.f) + EPS_);
#pragma unroll
            for (int bj = 0; bj < 2; ++bj)
#pragma unroll
              for (int n = 0; n < 2; ++n)
#pragma unroll
                for (int j = 0; j < 4; ++j) acc[ai][bj][m][n][j] *= r * gl[bj][n][j];
            if (dorope) {
              int sq = (rt * 256 + ai * 128 + wr * 64 + m * 16 + fr) & 2047;
              asm volatile("" : "+v"(sq) : "v"(acc[ai][0][m][0][0]));
              const float frow = (float)(sq >> 6), fcol = (float)(sq & 63);
#pragma unroll
              for (int bj = 0; bj < 2; ++bj)
#pragma unroll
                for (int n = 0; n < 2; ++n)
#pragma unroll
                  for (int j = 0; j < 4; ++j) {
                    const float ang = (bj ? fcol : frow) * inv[n * 4 + j];
                    const float cs = __cosf(ang), sn = __sinf(ang);
                    const float v = acc[ai][bj][m][n][j];
                    const float pv = __shfl_xor(v, 32);
                    acc[ai][bj][m][n][j] = (q2 < 2) ? v * cs - pv * sn : v * cs + pv * sn;
                  }
            }
          }
      }
      const int c0 = ct * 256;
      const int pxc = c0 < 1024 ? c0 : (c0 < 3072 ? c0 - 512 : c0 - 1024);
#pragma unroll
      for (int ai = 0; ai < 2; ++ai)
#pragma unroll
        for (int m = 0; m < 4; ++m) {
          const size_t row = (size_t)rt * 256 + ai * 128 + wr * 64 + m * 16 + fr;
#pragma unroll
          for (int bj = 0; bj < 2; ++bj)
            *(u32x4*)(p.PX + row * PXW + pxc + wc * 64 + bj * 32 + fq * 8) = pack8(acc[ai][bj][m][0], acc[ai][bj][m][1]);
        }
    } else {
      int bl, key0;
      if (!ctxrow) { bl = rt >> 3; key0 = (rt & 7) * 256; } else { bl = rt - 128; key0 = 2048; }
      const bool isva = ct < 8;
#pragma unroll
      for (int ai = 0; ai < 2; ++ai)
#pragma unroll
        for (int m = 0; m < 4; ++m) {
          const int n = ai * 128 + wr * 64 + m * 16 + fr;
          u16* dst;
          if (isva) dst = p.VTA + ((size_t)((bl * 4 + (ct - 4) * 2 + (n >> 7)) * 128 + (n & 127))) * KV + key0;
          else dst = p.VTC + ((size_t)((bl * 8 + (ct - 12) * 4 + (n >> 6)) * 64 + (n & 63))) * KV + key0;
#pragma unroll
          for (int bj = 0; bj < 2; ++bj) *(u32x4*)(dst + wc * 64 + bj * 32 + fq * 8) = pack8(acc[ai][bj][m][0], acc[ai][bj][m][1]);
        }
    }
  }
};
struct EpiFfnUp {
  static constexpr bool PERM = true, AFTER_DRAIN = false;
  u16* hid;
  DEV void operator()(f32x4 (&acc)[2][2][4][2], const pg8::Unit& u, int wr, int wc, int fr, int fq) const {
#pragma unroll
    for (int ai = 0; ai < 2; ++ai)
#pragma unroll
      for (int m = 0; m < 4; ++m) {
        const size_t row = (size_t)u.pm * 256 + ai * 128 + wr * 64 + m * 16 + fr;
#pragma unroll
        for (int bj = 0; bj < 2; ++bj) {
          const f32x4 a = acc[ai][bj][m][0], b = acc[ai][bj][m][1];
          u32x2 o;
          o.x = cvt_pk(a[0] * sigmoidf_(a[0]) * b[0], a[1] * sigmoidf_(a[1]) * b[1]);
          o.y = cvt_pk(a[2] * sigmoidf_(a[2]) * b[2], a[3] * sigmoidf_(a[3]) * b[3]);
          *(u32x2*)(hid + row * FH + u.pn * 128 + wc * 32 + bj * 16 + fq * 4) = o;
        }
      }
  }
};
struct EpiDown {
  static constexpr bool PERM = true, AFTER_DRAIN = false;
  const Params& p; int l;
  DEV void operator()(f32x4 (&acc)[2][2][4][2], const pg8::Unit& u, int wr, int wc, int fr, int fq) const {
    const int rt = u.pm, ct = u.pn;
    const int hf = rt >= 144 ? 1 : 0;
    const int rl = rt - hf * 144;
    int b, idx0; bool isc;
    rowmap(hf, rl * 256, b, idx0, isc);
    const float* gate = p.MOD + ((size_t)l * 33 + (isc ? 32 : b)) * 6144 + 5 * 1024 + ct * 256;
    const size_t rb = isc ? ((size_t)b * 256 + idx0) * 1024 : ((size_t)b * 2048 + idx0) * 1024;
    float* dst = (isc ? p.CTXC : p.out) + rb + ct * 256;
#pragma unroll
    for (int bj = 0; bj < 2; ++bj) {
      const int x0 = wc * 64 + bj * 32 + fq * 8;
      const float4 g0 = *(const float4*)(gate + x0), g1 = *(const float4*)(gate + x0 + 4);
#pragma unroll
      for (int ai = 0; ai < 2; ++ai) {
      f32x4 r0[2][4], r1[2][4];
#pragma unroll
        for (int m = 0; m < 4; ++m) {
          const size_t ro = (size_t)(ai * 128 + wr * 64 + m * 16 + fr) * 1024 + x0;
          r0[ai][m] = *(const f32x4*)(dst + ro); r1[ai][m] = *(const f32x4*)(dst + ro + 4);
        }
#pragma unroll
        for (int m = 0; m < 4; ++m) {
          const size_t ro = (size_t)(ai * 128 + wr * 64 + m * 16 + fr) * 1024 + x0;
          const f32x4 a0 = acc[ai][bj][m][0], a1 = acc[ai][bj][m][1];
          f32x4 o0 = r0[ai][m], o1 = r1[ai][m];
          o0[0] += g0.x * a0[0]; o0[1] += g0.y * a0[1]; o0[2] += g0.z * a0[2]; o0[3] += g0.w * a0[3];
          o1[0] += g1.x * a1[0]; o1[1] += g1.y * a1[1]; o1[2] += g1.z * a1[2]; o1[3] += g1.w * a1[3];
          *(f32x4*)(dst + ro) = o0;
          *(f32x4*)(dst + ro + 4) = o1;
        }
      }
    }
  }
};

DEV void phase_inproj8(const Params& p, int l, int hf, char* lds) {
  SchedInproj S{(const char*)p.HX, (const char*)(p.WIN + (size_t)l * INC * 1024), l == NLAYER - 1};
  EpiInproj E{p, l};
  pg8::gemm_phase<EpiInproj, SchedInproj, true, true>((PG8_LAS unsigned char*)lds, 1024, 1024, 1024, S, E);
}
DEV void phase_ffnup8(const Params& p, int l, char* lds) {
  SchedFull S{(const char*)p.YS, (const char*)(p.WGU + (size_t)l * 2 * FH * 1024), (size_t)256 * 1024 * 2, 22, 16, 2, l == NLAYER - 1};
  EpiFfnUp E{p.PX};
  pg8::gemm_phase<EpiFfnUp, SchedFull, true, true>((PG8_LAS unsigned char*)lds, 1024, 1024, 1024, S, E);
}
DEV void phase_down8(const Params& p, int l, char* lds) {
  SchedFull S{(const char*)p.PX, (const char*)(p.WDN + (size_t)l * 1024 * FH), (size_t)256 * FH * 2, 4, 8, 4, l == NLAYER - 1};
  EpiDown E{p, l};
  pg8::gemm_phase<EpiDown, SchedFull, true, true>((PG8_LAS unsigned char*)lds, FH, FH, FH, S, E);
}


struct SchedMerge {
  const char* ys; const char* wbr; int RT;
  DEV bool next(int i, pg8::Unit& u) const {
    int rt, ct;
    if (!tile_p(i >> 2, RT, 4, 8, 4, rt, ct)) return false;
    const int br = i & 3;
    u.a = ys + ((size_t)rt * 256 * 2048 + br * 512) * 2;
    u.b = wbr + ((size_t)ct * 256 * 2048 + br * 512) * 2;
    u.pm = rt; u.pn = ct; u.kind = br;
    return true;
  }
  DEV void a_ready(const pg8::Unit&) const {}
  DEV void done(const pg8::Unit&) const {}
};
struct EpiMerge {
  static constexpr bool PERM = true, AFTER_DRAIN = false;
  const u16* px; u16* dstb;
  DEV void operator()(f32x4 (&acc)[2][2][4][2], const pg8::Unit& u, int wr, int wc, int fr, int fq) const {
    const int br = u.kind;
#pragma unroll
    for (int aim = 0; aim < 4; ++aim) {
      const int ai = aim >> 1, m0 = (aim & 1) * 2;
      u32x4 gq[4][2], pv[4][2];
#pragma unroll
      for (int m = m0; m < m0 + 2; ++m) {
        const size_t row = (size_t)u.pm * 256 + ai * 128 + wr * 64 + m * 16 + fr;
#pragma unroll
        for (int bj = 0; bj < 2; ++bj) {
          const int col = u.pn * 256 + wc * 64 + bj * 32 + fq * 8;
          gq[m][bj] = *(const u32x4*)(px + row * PXW + PX_G + br * 1024 + col);
          pv[m][bj] = (u32x4){0u, 0u, 0u, 0u};
          if (br) pv[m][bj] = *(const u32x4*)(dstb + row * 1024 + col);
        }
      }
#pragma unroll
      for (int m = m0; m < m0 + 2; ++m) {
        const size_t row = (size_t)u.pm * 256 + ai * 128 + wr * 64 + m * 16 + fr;
#pragma unroll
        for (int bj = 0; bj < 2; ++bj) {
          const int col = u.pn * 256 + wc * 64 + bj * 32 + fq * 8;
          const u32x4 g = gq[m][bj], q = pv[m][bj];
          f32x4 a = acc[ai][bj][m][0], b = acc[ai][bj][m][1];
          a[0] = bflo(q.x) + sigmoidf_(bflo(g.x)) * a[0]; a[1] = bfhi(q.x) + sigmoidf_(bfhi(g.x)) * a[1];
          a[2] = bflo(q.y) + sigmoidf_(bflo(g.y)) * a[2]; a[3] = bfhi(q.y) + sigmoidf_(bfhi(g.y)) * a[3];
          b[0] = bflo(q.z) + sigmoidf_(bflo(g.z)) * b[0]; b[1] = bfhi(q.z) + sigmoidf_(bfhi(g.z)) * b[1];
          b[2] = bflo(q.w) + sigmoidf_(bflo(g.w)) * b[2]; b[3] = bfhi(q.w) + sigmoidf_(bfhi(g.w)) * b[3];
          *(u32x4*)(dstb + row * 1024 + col) = pack8(a, b);
        }
      }
    }
  }
};
struct EpiOut {
  static constexpr bool PERM = true, AFTER_DRAIN = false;
  const Params& p; int l;
  DEV void operator()(f32x4 (&acc)[2][2][4][2], const pg8::Unit& u, int wr, int wc, int fr, int fq) const {
    const int rt = u.pm, ct = u.pn;
    const int hf = rt >= 144 ? 1 : 0;
    const int rl = rt - hf * 144;
    int b, idx0; bool isc;
    rowmap(hf, rl * 256, b, idx0, isc);
    const float* gate = p.MOD + ((size_t)l * 33 + (isc ? 32 : b)) * 6144 + 2 * 1024 + ct * 256;
    const size_t rb = isc ? ((size_t)b * 256 + idx0) * 1024 : ((size_t)b * 2048 + idx0) * 1024;
    const float* src = (l == 0 ? (isc ? p.ctx : p.x) : (isc ? (const float*)p.CTXC : (const float*)p.out)) + rb + ct * 256;
    float* dst = (isc ? p.CTXC : p.out) + rb + ct * 256;
#pragma unroll
    for (int bj = 0; bj < 2; ++bj) {
      const int x0 = wc * 64 + bj * 32 + fq * 8;
      const float4 g0 = *(const float4*)(gate + x0), g1 = *(const float4*)(gate + x0 + 4);
#pragma unroll
      for (int ai = 0; ai < 2; ++ai) {
      f32x4 r0[2][4], r1[2][4];
#pragma unroll
        for (int m = 0; m < 4; ++m) {
          const size_t ro = (size_t)(ai * 128 + wr * 64 + m * 16 + fr) * 1024 + x0;
          r0[ai][m] = *(const f32x4*)(src + ro); r1[ai][m] = *(const f32x4*)(src + ro + 4);
        }
#pragma unroll
        for (int m = 0; m < 4; ++m) {
          const size_t ro = (size_t)(ai * 128 + wr * 64 + m * 16 + fr) * 1024 + x0;
          const f32x4 a0 = acc[ai][bj][m][0], a1 = acc[ai][bj][m][1];
          f32x4 o0 = r0[ai][m], o1 = r1[ai][m];
          o0[0] += g0.x * a0[0]; o0[1] += g0.y * a0[1]; o0[2] += g0.z * a0[2]; o0[3] += g0.w * a0[3];
          o1[0] += g1.x * a1[0]; o1[1] += g1.y * a1[1]; o1[2] += g1.z * a1[2]; o1[3] += g1.w * a1[3];
          *(f32x4*)(dst + ro) = o0;
          *(f32x4*)(dst + ro + 4) = o1;
        }
      }
    }
  }
};
DEV void phase_merge8(const Params& p, int l, int hf, char* lds) {
  SchedMerge S{(const char*)p.YS, (const char*)(p.WBR + (size_t)l * 1024 * 2048), (l == NLAYER - 1) ? 128 : 144};
  EpiMerge E{p.PX, hf ? p.HX : p.ACC0};
  pg8::gemm_phase<EpiMerge, SchedMerge, true, true>((PG8_LAS unsigned char*)lds, 512, 2048, 2048, S, E);
}
DEV void phase_out8(const Params& p, int l, char* lds) {
  SchedFull S{(const char*)p.ACC0, (const char*)(p.WOUT + (size_t)l * 1024 * 1024), (size_t)256 * 1024 * 2, 4, 8, 4, l == NLAYER - 1};
  EpiOut E{p, l};
  pg8::gemm_phase<EpiOut, SchedFull, true, true>((PG8_LAS unsigned char*)lds, 1024, 1024, 1024, S, E);
}

DEV void run_phase(const Params& p, int ph, char* lds0) {
  char* lds = lds0 + vhalf() * 73728;
  if (ph == 0) { phase_prep(p, lds); return; }
  const int q = ph - 1;
  const int l = q / 11, k = q % 11;
  switch (k) {
    case 0: phase_norm(p, l, 0, 0); break;
    case 1: phase_inproj8(p, l, 0, lds0); break;
    case 2: phase_mixers(p, l, 0, (u16*)lds, (u16*)lds0); break;
    case 3: phase_merge8(p, l, 0, lds0); phase_norm(p, l, 1, 0); break;
    case 4: phase_inproj8(p, l, 1, lds0); break;
    case 5: phase_mixers(p, l, 1, (u16*)lds, (u16*)lds0); break;
    case 6: phase_merge8(p, l, 1, lds0); break;
    case 7: phase_out8(p, l, lds0); break;
    case 8: phase_norm(p, l, 0, 1); break;
    case 9: phase_ffnup8(p, l, lds0); break;
    default: phase_down8(p, l, lds0); break;
  }
}

#define XB_TMO      128
#define XB_XCNT(j)  (256  + 64 * (j))
#define XB_XSUB(j)  (1280 + 64 * (j))
#define XB_XGEN(j)  (2304 + 64 * (j))
#define XB_TOP      3328
#define XB_TOPGEN   3392
#define XCD_BAR_WORDS 3456
#define XB_SPIN_CAP (1u << 24)
#define LAS __attribute__((address_space(3)))
DEV unsigned xb_ld(unsigned* p) { return __hip_atomic_load(p, __ATOMIC_RELAXED, __HIP_MEMORY_SCOPE_AGENT); }
DEV unsigned xb_add(unsigned* p, unsigned v) { return __hip_atomic_fetch_add(p, v, __ATOMIC_RELAXED, __HIP_MEMORY_SCOPE_AGENT); }
DEV unsigned xb_xcc_id() { return (unsigned)__builtin_amdgcn_s_getreg((3 << 11) | 20) & 0xFu; }
#define XB_SPIN(cond, bar) do { unsigned _sp = 0; while (cond) { __builtin_amdgcn_s_sleep(1); \
    if ((++_sp & 255u) == 0u) { if (xb_ld(&(bar)[XB_TMO])) break; if (_sp > XB_SPIN_CAP) { atomicAdd(&(bar)[XB_TMO], 1u); break; } } } } while (0)
struct XcdBarrier { unsigned* bar; unsigned x; volatile LAS unsigned* st; };
DEV XcdBarrier xcd_barrier_post(unsigned* bar, volatile LAS unsigned* st) {
  XcdBarrier b; b.bar = bar; b.x = xb_xcc_id(); b.st = st;
  if (threadIdx.x == 0) (void)xb_add(&bar[XB_XCNT(b.x)], 1u);
  return b;
}
DEV void xcd_barrier_complete(unsigned* bar, unsigned x, unsigned& nloc, unsigned& nx) {
  const unsigned G = gridDim.x * gridDim.y * gridDim.z;
  unsigned sum, cnt, mine, sp = 0u;
  for (;;) {
    sum = 0u; cnt = 0u; mine = 0u;
#pragma unroll
    for (unsigned j = 0; j < 16; ++j) { const unsigned c = xb_ld(&bar[XB_XCNT(j)]); sum += c; cnt += (c > 0u) ? 1u : 0u; mine = (j == x) ? c : mine; }
    if (sum == G) break;
    __builtin_amdgcn_s_sleep(1);
    if ((++sp & 255u) == 0u) { if (xb_ld(&bar[XB_TMO])) break; if (sp > XB_SPIN_CAP) { atomicAdd(&bar[XB_TMO], 1u); break; } }
  }
  nloc = mine > 0u ? mine : 1u; nx = cnt > 0u ? cnt : 1u;
}
DEV void xcd_barrier(const XcdBarrier& b) {
  asm volatile("s_waitcnt vmcnt(0)" ::: "memory");
  __syncthreads();
  if (threadIdx.x == 0) {
    unsigned* bar = b.bar;
    __builtin_amdgcn_s_waitcnt(0);
    unsigned nloc = b.st[0], nx = b.st[1];
    if (nloc == 0u) { xcd_barrier_complete(bar, b.x, nloc, nx); b.st[0] = nloc; b.st[1] = nx; }
    const unsigned old = xb_add(&bar[XB_XSUB(b.x)], 1u);
    const unsigned gen = old / nloc;
    if (old + 1u == (gen + 1u) * nloc) {
      __builtin_amdgcn_fence(__ATOMIC_RELEASE, "agent");
      asm volatile("s_waitcnt vmcnt(0)" ::: "memory");
      const unsigned og = xb_add(&bar[XB_TOP], 1u);
      const unsigned tg = og / nx;
      if (og + 1u == (tg + 1u) * nx) xb_add(&bar[XB_TOPGEN], 1u);
      else XB_SPIN(xb_ld(&bar[XB_TOPGEN]) == tg, bar);
      __builtin_amdgcn_fence(__ATOMIC_ACQUIRE, "agent");
      xb_add(&bar[XB_XGEN(b.x)], 1u);
      asm volatile("s_waitcnt vmcnt(0)" ::: "memory");
    } else {
      XB_SPIN(xb_ld(&bar[XB_XGEN(b.x)]) == gen, bar);
      __builtin_amdgcn_fence(__ATOMIC_ACQUIRE, "agent");
      asm volatile("s_waitcnt vmcnt(0)" ::: "memory");
    }
  }
  __syncthreads();
}

__global__ void __launch_bounds__(512, 2) fwd_kernel(Params p) {
  extern __shared__ __attribute__((aligned(16))) char smem[];
  cg::grid_group grid = cg::this_grid();
  volatile LAS unsigned* st = (volatile LAS unsigned*)(smem + 2 * 73728);
  if (threadIdx.x == 0) { st[0] = 0u; st[1] = 0u; st[2] = 0u; st[3] = 0u; }
  __syncthreads();
  XcdBarrier xb = xcd_barrier_post(p.BAR, st);
  for (int ph = p.ph0; ph < p.ph1; ++ph) {
    run_phase(p, ph, smem);
    if (ph + 1 < p.ph1) { if (ph == 0) grid.sync(); else xcd_barrier(xb); }
  }
}

extern "C" void kernel_launch(void* const* d_in, const int* in_sizes, int n_in, void* d_out, int out_size, void* d_ws, size_t ws_size,
                              hipStream_t stream) {
  static int grid_blocks = 0;
  if (!grid_blocks) {
    int dev = 0, cus = 0, per_cu = 0;
    hipGetDevice(&dev);
    hipDeviceGetAttribute(&cus, hipDeviceAttributeMultiprocessorCount, dev);
    hipFuncSetAttribute((const void*)fwd_kernel, hipFuncAttributeMaxDynamicSharedMemorySize, LDS_BYTES);
    hipOccupancyMaxActiveBlocksPerMultiprocessor(&per_cu, fwd_kernel, 512, LDS_BYTES);
    if (per_cu > 1) per_cu = 1;
    if (per_cu < 1) per_cu = 1;
    grid_blocks = cus * per_cu;
    grid_blocks &= ~7;
    if (grid_blocks < 8) grid_blocks = 8;
  }
  Params p{};
  const float* const* in = (const float* const*)d_in;
  p.x = in[0]; p.c = in[1]; p.ctx = in[2]; p.c_ctx = in[3]; p.w_mod = in[4]; p.b_mod = in[5]; p.norm1_g = in[6]; p.w_in = in[7];
  p.a_qk_g = in[8]; p.a_lambda = in[9]; p.a_subln_g = in[10]; p.b_pool_w = in[11]; p.b_pool_s = in[12]; p.c_qk_g = in[13];
  p.c_rpb = in[14]; p.d_vn_g = in[15]; p.d_ws = in[16]; p.d_bs = in[17]; p.w_branch = in[18]; p.w_out = in[19]; p.norm2_g = in[20];
  p.w_gu = in[21]; p.w_down = in[22];
  p.out = (float*)d_out;
  char* ws = (char*)d_ws;
  size_t off = 0;
  auto carve = [&](size_t bytes) { char* r = ws + off; off += (bytes + 255) & ~(size_t)255; return r; };
  p.BAR = (unsigned*)carve((size_t)4096 * 4);
  p.WIN = (u16*)carve((size_t)NLAYER * INC * 1024 * 2);
  p.WBR = (u16*)carve((size_t)NLAYER * 1024 * 2048 * 2);
  p.WOUT = (u16*)carve((size_t)NLAYER * 1024 * 1024 * 2);
  p.WGU = (u16*)carve((size_t)NLAYER * 2 * FH * 1024 * 2);
  p.WDN = (u16*)carve((size_t)NLAYER * 1024 * FH * 2);
  p.WPOOL = (u16*)carve((size_t)NLAYER * 4 * 16384 * 2);
  p.WSB = (u16*)carve((size_t)NLAYER * 4 * 16384 * 2);
  p.MOD = (float*)carve((size_t)NLAYER * 33 * 6144 * 4);
  p.CTXC = (float*)carve((size_t)32 * 256 * 1024 * 4);
  p.ACC0 = (u16*)carve((size_t)HR * 1024 * 2);
  p.HX = (u16*)carve((size_t)HR * 1024 * 2);
  p.PX = (u16*)carve((size_t)HR * PXW * 2);
  p.VTA = (u16*)carve((size_t)HB * 4 * 128 * KV * 2);
  p.VTC = (u16*)carve((size_t)HB * 8 * 64 * KV * 2);
  p.YS = (u16*)carve((size_t)HR * 2048 * 2);
  if (off > ws_size) { fprintf(stderr, "workspace too small: need %zu have %zu\n", off, ws_size); return; }
#if MULTI_LAUNCH
  for (int ph = 0; ph < NPHASE; ++ph) {
    p.ph0 = ph; p.ph1 = ph + 1;
    hipLaunchKernelGGL(fwd_kernel, dim3(grid_blocks), dim3(512), LDS_BYTES, stream, p);
  }
#else
  p.ph0 = 0; p.ph1 = NPHASE;
  (void)hipMemsetAsync(p.BAR, 0, (size_t)4096 * 4, stream);
  void* args[] = {&p};
  hipError_t e = hipLaunchCooperativeKernel((const void*)fwd_kernel, dim3(grid_blocks), dim3(512), args, LDS_BYTES, stream);
  if (e != hipSuccess) fprintf(stderr, "cooperative launch failed: %s (grid %d)\n", hipGetErrorString(e), grid_blocks);
#endif
}
```

```cpp
#include <hip/hip_runtime.h>
#include <hip/hip_cooperative_groups.h>
#include <cstdio>
#include <cstdint>
namespace cg = cooperative_groups;

#ifndef P13
#define P13 255
#endif
#ifndef MXMASK
#define MXMASK 63
#endif
#ifndef MULTI_LAUNCH
#define MULTI_LAUNCH 0
#endif

typedef unsigned short u16;
typedef short bf16x8 __attribute__((ext_vector_type(8)));
typedef float f32x4 __attribute__((ext_vector_type(4)));
typedef __bf16 bf2_t __attribute__((ext_vector_type(2)));
typedef float f2_t __attribute__((ext_vector_type(2)));
typedef unsigned u32x4 __attribute__((ext_vector_type(4)));
typedef unsigned u32x2 __attribute__((ext_vector_type(2)));

#define DEV __device__ __forceinline__

constexpr int NLAYER = 2;
constexpr int INC = 8704, PXW = 7680, FH = 2816;
constexpr int HB = 16;
constexpr int LR = HB * 2048;
constexpr int HR = LR + HB * 256;
constexpr int KV = 2304;
constexpr int PX_AQ = 0, PX_AK = 512, PX_B = 1024, PX_CQ = 1536, PX_CK = 2048, PX_DU = 2560, PX_DV = 3072, PX_G = 3584;
constexpr int YS_A = 0, YS_B = 512, YS_C = 1024, YS_D = 1536;
constexpr int LDS_BYTES = 2 * 73728 + 16;
constexpr float EPS_ = 1e-6f;
constexpr float LOG2E = 1.4426950408889634f;
constexpr int NPHASE = 1 + NLAYER * 11;

struct Params {
  const float *x, *c, *ctx, *c_ctx, *w_mod, *b_mod, *norm1_g, *w_in, *a_qk_g, *a_lambda, *a_subln_g, *b_pool_w, *b_pool_s,
      *c_qk_g, *c_rpb, *d_vn_g, *d_ws, *d_bs, *w_branch, *w_out, *norm2_g, *w_gu, *w_down;
  float* out;
  u16 *WIN, *WBR, *WOUT, *WGU, *WDN, *WPOOL, *WSB;
  float *MOD, *CTXC;
  u16 *HX, *PX, *VTA, *VTC, *YS, *ACC0;
  unsigned* BAR;
  int ph0, ph1;
};

DEV int tid() { int t = threadIdx.x & 255; asm volatile("" : "+v"(t)); return t; }
DEV int vhalf() { return __builtin_amdgcn_readfirstlane((int)(threadIdx.x >> 8)); }
DEV int bid() { int b = (((int)blockIdx.x >> 3) * 2 + vhalf()) * 8 + ((int)blockIdx.x & 7); asm volatile("" : "+s"(b)); return b; }
DEV int vgrid() { return (int)gridDim.x * 2; }
DEV unsigned cvt_pk(float lo, float hi) {
  f2_t v = {lo, hi};
  bf2_t b = __builtin_convertvector(v, bf2_t);
  return __builtin_bit_cast(unsigned, b);
}
DEV float bflo(unsigned u) { return __uint_as_float(u << 16); }
DEV float bfhi(unsigned u) { return __uint_as_float(u & 0xffff0000u); }
DEV int perm32(int r) { return (r & ~31) | (((r >> 2) & 1) << 4) | (((r >> 3) & 3) << 2) | (r & 3); }
DEV f32x4 mfma16(bf16x8 a, bf16x8 b, f32x4 c) { return __builtin_amdgcn_mfma_f32_16x16x32_bf16(a, b, c, 0, 0, 0); }
DEV u32x4 pack8(const f32x4& a, const f32x4& b) {
  u32x4 o;
  o.x = cvt_pk(a[0], a[1]); o.y = cvt_pk(a[2], a[3]); o.z = cvt_pk(b[0], b[1]); o.w = cvt_pk(b[2], b[3]);
  return o;
}
DEV bf16x8 pack8f(const f32x4& a, const f32x4& b) { return __builtin_bit_cast(bf16x8, pack8(a, b)); }
DEV float fexp2(float x) { return __builtin_amdgcn_exp2f(x); }
DEV float frcp(float x) { return __builtin_amdgcn_rcpf(x); }
DEV float sigmoidf_(float x) { return frcp(1.f + fexp2(-x * LOG2E)); }

DEV int xidx(int wx, int u, int quad) { return wx * 64 + u * 32 + quad * 8; }
DEV int yidx(int wy, int yt, int l15) { return wy * 64 + (yt >> 1) * 32 + (l15 >> 2) * 8 + (yt & 1) * 4 + (l15 & 3); }

DEV void zero_acc(f32x4 (&acc)[4][4]) {
#pragma unroll
  for (int i = 0; i < 4; ++i)
#pragma unroll
    for (int j = 0; j < 4; ++j) acc[i][j] = (f32x4){0.f, 0.f, 0.f, 0.f};
}

template <int KS, int STRIDE>
DEV void wave_mma(const u16* Xs, const u16* Ys, f32x4 (&acc)[4][4], int wx, int wy, int l15, int quad) {
#pragma unroll
  for (int ks = 0; ks < KS; ++ks) {
    bf16x8 xf[4], yf[4];
#pragma unroll
    for (int i = 0; i < 4; ++i) xf[i] = *(const bf16x8*)(Xs + (wx * 64 + i * 16 + l15) * STRIDE + ks * 32 + quad * 8);
#pragma unroll
    for (int i = 0; i < 4; ++i) yf[i] = *(const bf16x8*)(Ys + (wy * 64 + i * 16 + l15) * STRIDE + ks * 32 + quad * 8);
#pragma unroll
    for (int a = 0; a < 4; ++a)
#pragma unroll
      for (int b = 0; b < 4; ++b) acc[a][b] = mfma16(xf[a], yf[b], acc[a][b]);
  }
}

DEV void gemm_kloop(const u16* __restrict__ Xg, int ldx, const u16* __restrict__ Yg, int ldy, int nkt, f32x4 (&acc)[4][4], u16* lds) {
  const int t = tid(), lane = t & 63, w = t >> 6, l15 = lane & 15, quad = lane >> 4;
  const int wx = w & 1, wy = w >> 1;
  const int lr = t >> 3, kc = t & 7;
  const unsigned xo = (unsigned)(lr * ldx + kc * 8), yo = (unsigned)(lr * ldy + kc * 8);
  const int pr = perm32(lr);
  const int sofs = pr * 64 + ((kc ^ ((pr >> 1) & 7)) << 3);
  const int m7 = (l15 >> 1) & 7;
  const int xrow = (wx * 64 + l15) * 64, yrow = 8192 + (wy * 64 + l15) * 64;
  const int ko0 = ((0 + quad) ^ m7) << 3, ko1 = ((4 + quad) ^ m7) << 3;
  u32x4 rx[4], ry[4];
#define GK_LOAD(KT)                                                                \
  _Pragma("unroll") for (int i = 0; i < 4; ++i) {                                  \
    rx[i] = *(const u32x4*)((Xg + (size_t)(32 * i) * ldx + (size_t)(KT) * 64) + xo); \
    ry[i] = *(const u32x4*)((Yg + (size_t)(32 * i) * ldy + (size_t)(KT) * 64) + yo); \
  }
#define GK_STORE(B)                                                                \
  _Pragma("unroll") for (int i = 0; i < 4; ++i) {                                  \
    *(u32x4*)(lds + (B) * 16384 + sofs + i * 32 * 64) = rx[i];                     \
    *(u32x4*)(lds + (B) * 16384 + 8192 + sofs + i * 32 * 64) = ry[i];              \
  }
  GK_LOAD(0)
  __syncthreads();
  GK_STORE(0)
  if (nkt > 1) { GK_LOAD(1) }
  __syncthreads();
  for (int kt = 0; kt < nkt; ++kt) {
    const int cur = kt & 1;
    if (kt + 1 < nkt) {
      GK_STORE(cur ^ 1)
      if (kt + 2 < nkt) { GK_LOAD(kt + 2) }
    }
    const u16* B = lds + cur * 16384;
#pragma unroll
    for (int ks = 0; ks < 2; ++ks) {
      const int ko = ks ? ko1 : ko0;
      bf16x8 xf[4], yf[4];
#pragma unroll
      for (int i = 0; i < 4; ++i) xf[i] = *(const bf16x8*)(B + xrow + i * 16 * 64 + ko);
#pragma unroll
      for (int i = 0; i < 4; ++i) yf[i] = *(const bf16x8*)(B + yrow + i * 16 * 64 + ko);
#pragma unroll
      for (int a = 0; a < 4; ++a)
#pragma unroll
        for (int b = 0; b < 4; ++b) acc[a][b] = mfma16(xf[a], yf[b], acc[a][b]);
    }
    __syncthreads();
  }
#undef GK_LOAD
#undef GK_STORE
}

DEV int ptid() { int t = threadIdx.x; asm volatile("" : "+v"(t)); return t; }
DEV int pbid() { int b = blockIdx.x; asm volatile("" : "+s"(b)); return b; }
DEV void zero_acc8(f32x4 (&acc)[8][4]) {
#pragma unroll
  for (int i = 0; i < 8; ++i)
#pragma unroll
    for (int j = 0; j < 4; ++j) acc[i][j] = (f32x4){0.f, 0.f, 0.f, 0.f};
}
DEV int xidx8(int wx, int u, int quad) { return wx * 128 + u * 32 + quad * 8; }
DEV void gemm_kloop256(const u16* __restrict__ Xg, int ldx, const u16* __restrict__ Yg, int ldy, int nkt, f32x4 (&acc)[8][4], u16* lds) {
  const int t = ptid(), lane = t & 63, w = t >> 6, l15 = lane & 15, quad = lane >> 4;
  const int wx = w & 1, wy = w >> 1;
  const int lr = t >> 3, kc = t & 7;
  const unsigned xo = (unsigned)(lr * ldx + kc * 8), yo = (unsigned)(lr * ldy + kc * 8);
  const int pr = perm32(lr);
  const int sofs = pr * 64 + ((kc ^ ((pr >> 1) & 7)) << 3);
  const int m7 = (l15 >> 1) & 7;
  const int xrow = (wx * 128 + l15) * 64, yrow = 16384 + (wy * 64 + l15) * 64;
  const int ko0 = ((0 + quad) ^ m7) << 3, ko1 = ((4 + quad) ^ m7) << 3;
  u32x4 rx[4], ry[4];
#define GK_LOAD(KT)                                                                \
  _Pragma("unroll") for (int i = 0; i < 4; ++i) {                                  \
    rx[i] = *(const u32x4*)((Xg + (size_t)(64 * i) * ldx + (size_t)(KT) * 64) + xo); \
    ry[i] = *(const u32x4*)((Yg + (size_t)(64 * i) * ldy + (size_t)(KT) * 64) + yo); \
  }
#define GK_STORE(B)                                                                \
  _Pragma("unroll") for (int i = 0; i < 4; ++i) {                                  \
    *(u32x4*)(lds + (B) * 32768 + sofs + i * 64 * 64) = rx[i];                     \
    *(u32x4*)(lds + (B) * 32768 + 16384 + sofs + i * 64 * 64) = ry[i];             \
  }
  GK_LOAD(0)
  __syncthreads();
  GK_STORE(0)
  if (nkt > 1) { GK_LOAD(1) }
  __syncthreads();
  for (int kt = 0; kt < nkt; ++kt) {
    const int cur = kt & 1;
    if (kt + 1 < nkt) {
      GK_STORE(cur ^ 1)
      if (kt + 2 < nkt) { GK_LOAD(kt + 2) }
    }
    const u16* B = lds + cur * 32768;
#pragma unroll
    for (int ks = 0; ks < 2; ++ks) {
      const int ko = ks ? ko1 : ko0;
      bf16x8 yf[4];
#pragma unroll
      for (int i = 0; i < 4; ++i) yf[i] = *(const bf16x8*)(B + yrow + i * 16 * 64 + ko);
#pragma unroll
      for (int a = 0; a < 8; ++a) {
        const bf16x8 xf = *(const bf16x8*)(B + xrow + a * 16 * 64 + ko);
#pragma unroll
        for (int b = 0; b < 4; ++b) acc[a][b] = mfma16(xf, yf[b], acc[a][b]);
      }
    }
    __syncthreads();
  }
#undef GK_LOAD
#undef GK_STORE
}
DEV bool next_tile_p(int it, int RT, int CT, int PR, int PC, int& rt, int& ct) {
  const int G = (int)gridDim.x;
  const int b = pbid();
  if ((G & 7) == 0 && (G >> 3) == PR * PC) {
    const int x = b & 7, lb = b >> 3;
    const int gp = it * 8 + x;
    const int npc = CT / PC, npr = RT / PR;
    if (gp >= npc * npr) return false;
    const int prow = gp / npc, pcol = gp - prow * npc;
    rt = prow * PR + lb / PC;
    ct = pcol * PC + lb % PC;
    return true;
  } else {
    const int v = it * G + b;
    if (v >= RT * CT) return false;
    rt = v / CT; ct = v - rt * CT;
    return true;
  }
}

DEV bool next_tile(int it, int RT, int CT, int PR, int PC, int& rt, int& ct) {
  const int G = vgrid();
  if ((G & 7) == 0) {
    const int x = bid() & 7, nbx = G >> 3, lb = bid() >> 3;
    const int s = it * nbx + lb;
    const int ps = s >> 6, j = s & 63;
    const int gp = ps * 8 + x;
    const int npc = CT / PC, npr = RT / PR;
    if (gp >= npc * npr) return false;
    const int prow = gp / npc, pcol = gp - prow * npc;
    rt = prow * PR + j / PC;
    ct = pcol * PC + j % PC;
    return true;
  } else {
    const int v = it * G + bid();
    if (v >= RT * CT) return false;
    rt = v / CT; ct = v - rt * CT;
    return true;
  }
}

DEV void rowmap(int hf, int R, int& b, int& idx, bool& isc) {
  if (R < LR) { b = hf * HB + (R >> 11); idx = R & 2047; isc = false; }
  else { const int q = R - LR; b = hf * HB + (q >> 8); idx = q & 255; isc = true; }
}

DEV void tconv(const float* __restrict__ src, int K, int N, u16* __restrict__ dst, int mode, float* lds) {
  const int t = tid();
  const int ntn = N >> 6, ntk = K >> 6, ntiles = ntn * ntk;
  for (int base = 0; base < ntiles; base += vgrid()) {
    const int tile = base + bid();
    const bool active = tile < ntiles;
    const int kt = active ? tile / ntn : 0, nt = active ? tile - kt * ntn : 0;
    const int k0 = kt * 64, n0 = nt * 64;
    __syncthreads();
    if (active) {
      const int c = t & 63, r0 = t >> 6;
#pragma unroll
      for (int i = 0; i < 16; ++i) {
        const int k = r0 + 4 * i;
        lds[k * 65 + c] = src[(size_t)(k0 + k) * N + n0 + c];
      }
    }
    __syncthreads();
    if (active) {
      const int kk = t & 63, r0 = t >> 6;
#pragma unroll
      for (int i = 0; i < 16; ++i) {
        const int n = n0 + r0 + 4 * i;
        int dr = n;
        if (mode == 1) { if (n < FH) dr = ((n >> 5) << 6) + (n & 31); else { const int hh = n - FH; dr = ((hh >> 5) << 6) + 32 + (hh & 31); } }
        const float v = lds[kk * 65 + (r0 + 4 * i)];
        dst[(size_t)dr * K + k0 + kk] = (u16)(cvt_pk(v, 0.f) & 0xffffu);
      }
    }
  }
}

DEV void phase_prep(const Params& p, char* ldsc) {
  float* lds = (float*)ldsc;
  const int t = tid();
  for (int l = 0; l < NLAYER; ++l) {
    tconv(p.w_in + (size_t)l * 1024 * INC, 1024, INC, p.WIN + (size_t)l * INC * 1024, 0, lds);
    tconv(p.w_branch + (size_t)l * 2048 * 1024, 2048, 1024, p.WBR + (size_t)l * 1024 * 2048, 0, lds);
    tconv(p.w_out + (size_t)l * 1024 * 1024, 1024, 1024, p.WOUT + (size_t)l * 1024 * 1024, 0, lds);
    tconv(p.w_gu + (size_t)l * 1024 * 2 * FH, 1024, 2 * FH, p.WGU + (size_t)l * 2 * FH * 1024, 1, lds);
    tconv(p.w_down + (size_t)l * FH * 1024, FH, 1024, p.WDN + (size_t)l * 1024 * FH, 0, lds);
    for (int g = 0; g < 4; ++g)
      tconv(p.b_pool_w + (size_t)(l * 4 + g) * 16384, 128, 128, p.WPOOL + (size_t)(l * 4 + g) * 16384, 0, lds);
  }
  for (int i = bid() * 256 + t; i < NLAYER * 4 * 16384; i += vgrid() * 256) p.WSB[i] = (u16)(cvt_pk(p.d_ws[i], 0.f) & 0xffffu);
  for (int base = 0; base < NLAYER * 96; base += vgrid()) {
    const int item0 = base + vgrid() - 1 - bid();
    const bool active = item0 < NLAYER * 96;
    const int item = active ? item0 : 0;
    const int l = item / 96, n0 = (item % 96) * 64;
    const int c = t & 63, w = t >> 6;
    float acc[9];
#pragma unroll
    for (int i = 0; i < 9; ++i) acc[i] = 0.f;
    const float* wm = p.w_mod + (size_t)l * 1024 * 6144 + n0 + c;
    for (int kc = 0; kc < 4; ++kc) {
      __syncthreads();
      for (int i = 0; i < 36; ++i) {
        const int idx = t + 256 * i, r = idx >> 8, k = idx & 255;
        float v = 0.f;
        if (r < 32) v = p.c[r * 1024 + kc * 256 + k]; else if (r == 32) v = p.c_ctx[kc * 256 + k];
        lds[idx] = v / (1.f + __expf(-v));
      }
      __syncthreads();
      for (int k4 = 0; k4 < 64; ++k4) {
        const size_t kb = (size_t)(kc * 256 + k4 * 4) * 6144;
        const float w0 = wm[kb], w1 = wm[kb + 6144], w2 = wm[kb + 2 * 6144], w3 = wm[kb + 3 * 6144];
#pragma unroll
        for (int i = 0; i < 9; ++i) {
          const float4 s = *(const float4*)(lds + (w + 4 * i) * 256 + k4 * 4);
          acc[i] += s.x * w0 + s.y * w1 + s.z * w2 + s.w * w3;
        }
      }
    }
    const float bm = p.b_mod[l * 6144 + n0 + c];
#pragma unroll
    for (int i = 0; i < 9; ++i) {
      const int r = w + 4 * i;
      if (active && r < 33) p.MOD[((size_t)l * 33 + r) * 6144 + n0 + c] = acc[i] + bm;
    }
  }
}

DEV void phase_norm(const Params& p, int l, int hf0, int which) {
  const bool last = (l == NLAYER - 1);
  const int lane = tid() & 63;
  const int gw = (bid() * 256 + tid()) >> 6, nw = vgrid() * 4;
  const float* g = (which ? p.norm2_g : p.norm1_g) + l * 1024;
  const bool first = (which == 0 && l == 0);
  const float* xs = first ? p.x : p.out;
  const float* cs = first ? p.ctx : p.CTXC;
  const int nrows = which ? 2 * HR : HR;
  u16* dstb = which ? p.YS : p.HX;
  for (int GR = gw; GR < nrows; GR += nw) {
    const int hf = which ? (GR >= HR ? 1 : 0) : hf0;
    const int R = which ? GR - hf * HR : GR;
    if (which && last && R >= LR) continue;
    int b, idx; bool isc;
    rowmap(hf, R, b, idx, isc);
    const float* src = isc ? cs + ((size_t)b * 256 + idx) * 1024 : xs + ((size_t)b * 2048 + idx) * 1024;
    const float* md = p.MOD + ((size_t)l * 33 + (isc ? 32 : b)) * 6144 + (which ? 3 : 0) * 1024;
    float4 v[4];
    float ss = 0.f;
#pragma unroll
    for (int i = 0; i < 4; ++i) {
      { const f32x4 q_ = __builtin_nontemporal_load((const f32x4*)(src + i * 256 + lane * 4)); v[i] = make_float4(q_[0], q_[1], q_[2], q_[3]); }
      ss += v[i].x * v[i].x + v[i].y * v[i].y + v[i].z * v[i].z + v[i].w * v[i].w;
    }
#pragma unroll
    for (int o = 32; o >= 1; o >>= 1) ss += __shfl_xor(ss, o);
    const float r = rsqrtf(ss * (1.f / 1024.f) + EPS_);
#pragma unroll
    for (int i = 0; i < 4; ++i) {
      const int col = i * 256 + lane * 4;
      const float4 g4 = *(const float4*)(g + col), sh = *(const float4*)(md + col), sc = *(const float4*)(md + 1024 + col);
      const float o0 = v[i].x * r * g4.x * (1.f + sc.x) + sh.x;
      const float o1 = v[i].y * r * g4.y * (1.f + sc.y) + sh.y;
      const float o2 = v[i].z * r * g4.z * (1.f + sc.z) + sh.z;
      const float o3 = v[i].w * r * g4.w * (1.f + sc.w) + sh.w;
      u32x2 o; o.x = cvt_pk(o0, o1); o.y = cvt_pk(o2, o3);
      *(u32x2*)(dstb + (size_t)GR * 1024 + col) = o;
    }
  }
}

DEV void phase_inproj(const Params& p, int l, int hf, u16* lds) {
  const bool last = (l == NLAYER - 1);
  const int t = ptid(), lane = t & 63, w = t >> 6, l15 = lane & 15, quad = lane >> 4, wx = w & 1, wy = w >> 1;
  int rt, ct;
  for (int it = 0; next_tile_p(it, 144, 34, 16, 2, rt, ct); ++it) {
    const bool ctxrow = rt >= 128;
    if (last && ctxrow && !((ct >= 2 && ct < 6) || (ct >= 10 && ct < 14))) continue;
    const u16* W = p.WIN + ((size_t)l * INC + ct * 256) * 1024;
    const u16* A = p.HX + (size_t)rt * 256 * 1024;
    f32x4 acc[8][4];
    zero_acc8(acc);
    const bool isva = (ct == 4 || ct == 5), isvc = (ct == 12 || ct == 13);
    if (!(isva || isvc)) {
      gemm_kloop256(W, 1024, A, 1024, 16, acc, lds);
      if (ct < 4 || (ct >= 8 && ct < 12)) {
        const int seg = ct < 4 ? (ct >> 1) : 2 + ((ct - 8) >> 1);
        const float* gq = (seg < 2 ? p.a_qk_g : p.c_qk_g) + l * 128 + (seg & 1) * 64;
        const float qs = (seg == 0 || seg == 2) ? 0.125f * LOG2E : 1.f;
        const bool dorope = (seg < 2) && !ctxrow;
        float gl[4][4], inv[8];
        int q2 = quad;
        asm volatile("" : "+v"(q2) : "v"(acc[0][0][0]));
#pragma unroll
        for (int xt = 0; xt < 4; ++xt)
#pragma unroll
          for (int j = 0; j < 4; ++j) gl[xt][j] = gq[(xt >> 1) * 32 + q2 * 8 + (xt & 1) * 4 + j] * qs;
#pragma unroll
        for (int k = 0; k < 8; ++k) inv[k] = fexp2(-(float)((q2 & 1) * 8 + k) * (13.287712379549449f / 16.f));
#pragma unroll
        for (int gi = 0; gi < 2; ++gi)
#pragma unroll
          for (int yt = 0; yt < 4; ++yt) {
            __builtin_amdgcn_sched_barrier(0);
            float ss = 0.f;
#pragma unroll
            for (int xt = 0; xt < 4; ++xt)
#pragma unroll
              for (int j = 0; j < 4; ++j) ss += acc[gi * 4 + xt][yt][j] * acc[gi * 4 + xt][yt][j];
            ss += __shfl_xor(ss, 16);
            ss += __shfl_xor(ss, 32);
            const float r = rsqrtf(ss * (1.f / 64.f) + EPS_);
#pragma unroll
            for (int xt = 0; xt < 4; ++xt)
#pragma unroll
              for (int j = 0; j < 4; ++j) acc[gi * 4 + xt][yt][j] *= r * gl[xt][j];
            if (dorope) {
              int sq = (rt * 256 + yidx(wy, yt, l15)) & 2047;
              asm volatile("" : "+v"(sq) : "v"(acc[gi * 4][yt][0]));
              const float frow = (float)(sq >> 6), fcol = (float)(sq & 63);
#pragma unroll
              for (int xt = 0; xt < 4; ++xt)
#pragma unroll
                for (int j = 0; j < 4; ++j) {
                  const float ang = ((xt >> 1) ? fcol : frow) * inv[(xt & 1) * 4 + j];
                  const float cs = __cosf(ang), sn = __sinf(ang);
                  const float v = acc[gi * 4 + xt][yt][j];
                  const float pv = __shfl_xor(v, 32);
                  acc[gi * 4 + xt][yt][j] = (quad < 2) ? v * cs - pv * sn : v * cs + pv * sn;
                }
            }
          }
      }
      const int c0 = ct * 256;
      const int pxc = c0 < 1024 ? c0 : (c0 < 3072 ? c0 - 512 : c0 - 1024);
#pragma unroll
      for (int yt = 0; yt < 4; ++yt) {
        const size_t row = (size_t)rt * 256 + yidx(wy, yt, l15);
#pragma unroll
        for (int u = 0; u < 4; ++u)
          *(u32x4*)(p.PX + row * PXW + pxc + xidx8(wx, u, quad)) = pack8(acc[2 * u][yt], acc[2 * u + 1][yt]);
      }
    } else {
      gemm_kloop256(A, 1024, W, 1024, 16, acc, lds);
      int bl, key0;
      if (!ctxrow) { bl = rt >> 3; key0 = (rt & 7) * 256; } else { bl = rt - 128; key0 = 2048; }
#pragma unroll
      for (int yt = 0; yt < 4; ++yt) {
        const int n = yidx(wy, yt, l15);
        u16* dst;
        if (isva) dst = p.VTA + ((size_t)((bl * 4 + (ct - 4) * 2 + (n >> 7)) * 128 + (n & 127))) * KV + key0;
        else dst = p.VTC + ((size_t)((bl * 8 + (ct - 12) * 4 + (n >> 6)) * 64 + (n & 63))) * KV + key0;
#pragma unroll
        for (int u = 0; u < 4; ++u) *(u32x4*)(dst + xidx8(wx, u, quad)) = pack8(acc[2 * u][yt], acc[2 * u + 1][yt]);
      }
    }
  }
}

DEV void phase_qk(const Params& p, int l, int hf) {
  const bool last = (l == NLAYER - 1);
  const int total = HR * 32;
  for (int id = bid() * 256 + tid(); id < total; id += vgrid() * 256) {
    const int R = id >> 5, gi = id & 31, seg = gi >> 3, grp = gi & 7;
    const bool isc = R >= LR;
    if (last && isc && !(seg == 1 || seg == 3)) continue;
    const int colbase = seg == 0 ? PX_AQ : (seg == 1 ? PX_AK : (seg == 2 ? PX_CQ : PX_CK));
    u16* ptr = p.PX + (size_t)R * PXW + colbase + grp * 64;
    const float* g = (seg < 2 ? p.a_qk_g : p.c_qk_g) + l * 128 + (seg & 1) * 64;
    float v[64];
    float ss = 0.f;
#pragma unroll
    for (int i = 0; i < 8; ++i) {
      const u32x4 q = *(const u32x4*)(ptr + i * 8);
      v[i * 8 + 0] = bflo(q.x); v[i * 8 + 1] = bfhi(q.x); v[i * 8 + 2] = bflo(q.y); v[i * 8 + 3] = bfhi(q.y);
      v[i * 8 + 4] = bflo(q.z); v[i * 8 + 5] = bfhi(q.z); v[i * 8 + 6] = bflo(q.w); v[i * 8 + 7] = bfhi(q.w);
    }
#pragma unroll
    for (int i = 0; i < 64; ++i) ss += v[i] * v[i];
    float r = rsqrtf(ss * (1.f / 64.f) + EPS_);
#pragma unroll
    for (int i = 0; i < 64; ++i) v[i] = v[i] * r * g[i];
    if (seg < 2 && !isc) {
      const int s = R & 2047;
      const float frow = (float)(s >> 6), fcol = (float)(s & 63);
#pragma unroll
      for (int d = 0; d < 16; ++d) {
        const float inv = exp2f(-(float)d * (13.287712379549449f / 16.f));
        const float ar = frow * inv, ac = fcol * inv;
        const float cr = __cosf(ar), sr = __sinf(ar), cc = __cosf(ac), sc = __sinf(ac);
        const float a = v[d], b = v[16 + d], c2 = v[32 + d], d2 = v[48 + d];
        v[d] = a * cr - b * sr; v[16 + d] = b * cr + a * sr;
        v[32 + d] = c2 * cc - d2 * sc; v[48 + d] = d2 * cc + c2 * sc;
      }
    }
    const float qs = (seg == 0 || seg == 2) ? 0.125f * LOG2E : 1.f;
#pragma unroll
    for (int i = 0; i < 8; ++i) {
      u32x4 q;
      q.x = cvt_pk(v[i * 8 + 0] * qs, v[i * 8 + 1] * qs); q.y = cvt_pk(v[i * 8 + 2] * qs, v[i * 8 + 3] * qs);
      q.z = cvt_pk(v[i * 8 + 4] * qs, v[i * 8 + 5] * qs); q.w = cvt_pk(v[i * 8 + 6] * qs, v[i * 8 + 7] * qs);
      *(u32x4*)(ptr + i * 8) = q;
    }
  }
}

#define LASP __attribute__((address_space(3)))
DEV int invperm32(int s_) { return (s_ & ~31) | (((s_ >> 4) & 1) << 2) | (((s_ >> 2) & 3) << 3) | (s_ & 3); }
template <bool CTXQ>
DEV void attnA_unit(const Params& p, int l, int bl, int h, int qb, u16* ldsg) {
  const int t = ptid(), lane = t & 63, w = __builtin_amdgcn_readfirstlane(t >> 6), l15 = lane & 15, quad = lane >> 4;
  const int comp = w & 1, qp = w >> 1;
  LASP unsigned char* lds = (LASP unsigned char*)ldsg;
  float lam, lam_init, gmax;
  {
    const float* al = p.a_lambda + l * 256;
    float p1 = al[lane] * al[64 + lane], p2 = al[128 + lane] * al[192 + lane];
    float gm = fabsf(p.a_qk_g[l * 128 + 64 + lane]);
#pragma unroll
    for (int o = 32; o >= 1; o >>= 1) { p1 += __shfl_xor(p1, o); p2 += __shfl_xor(p2, o); gm = fmaxf(gm, __shfl_xor(gm, o)); }
    lam_init = 0.8f - 0.6f * __expf(-0.3f * (float)l);
    lam = __expf(p1) - __expf(p2) + lam_init;
    gmax = gm;
  }
  const size_t qrow0 = CTXQ ? (size_t)LR + bl * 256 + qb * 128 + qp * 32 : (size_t)bl * 2048 + qb * 128 + qp * 32;
  bf16x8 qf[2][2];
#pragma unroll
  for (int qt = 0; qt < 2; ++qt)
#pragma unroll
    for (int ks = 0; ks < 2; ++ks)
      qf[qt][ks] = *(const bf16x8*)(p.PX + (qrow0 + qt * 16 + l15) * PXW + PX_AQ + h * 128 + comp * 64 + ks * 32 + quad * 8);
  float mq[2];
#pragma unroll
  for (int qt = 0; qt < 2; ++qt) {
    float ss = 0.f;
#pragma unroll
    for (int ks = 0; ks < 2; ++ks)
#pragma unroll
      for (int e = 0; e < 8; ++e) { const float v = bflo((unsigned)(unsigned short)qf[qt][ks][e]); ss += v * v; }
    ss += __shfl_xor(ss, 16);
    ss += __shfl_xor(ss, 32);
    mq[qt] = sqrtf(ss) * (8.f * 1.01f) * gmax;
  }
  unsigned koff[2], voff[2];
#pragma unroll
  for (int i = 0; i < 2; ++i) {
    const int rho = (w * 2 + i) * 8 + (lane >> 3), c = (lane & 7) ^ ((rho >> 1) & 7);
    koff[i] = (unsigned)(invperm32(rho & 63) * PXW + (rho >> 6) * 64 + c * 8);
    voff[i] = (unsigned)(invperm32(rho) * KV + c * 8);
  }
  const int nkt = CTXQ ? 4 : 36, kt0 = CTXQ ? 32 : 0;
  const u16* vbase = p.VTA + ((size_t)((bl * 4 + h) * 128)) * KV;
#define A_DMA(KT, SLOT) do {                                                                                                          \
    const int kt_ = (KT);                                                                                                              \
    const size_t rowbase_ = kt_ < 32 ? (size_t)bl * 2048 + kt_ * 64 : (size_t)LR + bl * 256 + (kt_ - 32) * 64;                          \
    const u16* kb_ = p.PX + rowbase_ * PXW + PX_AK + h * 128;                                                                          \
    const u16* vb_ = vbase + kt_ * 64;                                                                                                 \
    _Pragma("unroll") for (int i_ = 0; i_ < 2; ++i_) {                                                                                 \
      __builtin_amdgcn_global_load_lds((const unsigned*)(kb_ + koff[i_]), (LASP unsigned*)(lds + (SLOT) * 16384 + (w * 2 + i_) * 1024), 16, 0, 0);          \
      __builtin_amdgcn_global_load_lds((const unsigned*)(vb_ + voff[i_]), (LASP unsigned*)(lds + 49152 + (SLOT) * 16384 + (w * 2 + i_) * 1024), 16, 0, 0);  \
    } } while (0)
  __syncthreads();
  LASP unsigned char* Qs = lds + 98304 + w * 4096;
#pragma unroll
  for (int qt = 0; qt < 2; ++qt)
#pragma unroll
    for (int ks = 0; ks < 2; ++ks) *(LASP bf16x8*)(Qs + ((qt * 2 + ks) * 64 + lane) * 16) = qf[qt][ks];
  A_DMA(kt0, 0);
  if (nkt > 1) A_DMA(kt0 + 1, 1);
  f32x4 O[8][2];
#pragma unroll
  for (int i = 0; i < 8; ++i) { O[i][0] = (f32x4){0.f, 0.f, 0.f, 0.f}; O[i][1] = (f32x4){0.f, 0.f, 0.f, 0.f}; }
  float lsum[2] = {0.f, 0.f};
  const int m7 = (l15 >> 1) & 7;
  const int ko0 = (((0 + quad) ^ m7) << 4), ko1 = (((4 + quad) ^ m7) << 4);
  int slot = 0;
  if (w >= 4) __builtin_amdgcn_s_setprio(1);
  for (int it = 0; it < nkt; ++it) {
    if (it + 1 < nkt) asm volatile("s_waitcnt vmcnt(4)" ::: "memory"); else asm volatile("s_waitcnt vmcnt(0)" ::: "memory");
    __builtin_amdgcn_s_barrier();
    if (it + 2 < nkt) { const int s2 = slot == 0 ? 2 : slot - 1; A_DMA(kt0 + it + 2, s2); }
    const LASP unsigned char* Kb = lds + slot * 16384;
    const LASP unsigned char* Vb = lds + 49152 + slot * 16384;
    f32x4 s[4][2];
#pragma unroll
    for (int mt = 0; mt < 4; ++mt) {
      s[mt][0] = (f32x4){-mq[0], -mq[0], -mq[0], -mq[0]};
      s[mt][1] = (f32x4){-mq[1], -mq[1], -mq[1], -mq[1]};
    }
    {
      bf16x8 kf[2][4];
#pragma unroll
      for (int ks = 0; ks < 2; ++ks)
#pragma unroll
        for (int mt = 0; mt < 4; ++mt) kf[ks][mt] = *(const LASP bf16x8*)(Kb + (comp * 64 + mt * 16 + l15) * 128 + (ks ? ko1 : ko0));
      __builtin_amdgcn_sched_barrier(0);
#pragma unroll
      for (int ks = 0; ks < 2; ++ks)
#pragma unroll
        for (int mt = 0; mt < 4; ++mt) {
          s[mt][0] = mfma16(kf[ks][mt], qf[0][ks], s[mt][0]);
          s[mt][1] = mfma16(kf[ks][mt], qf[1][ks], s[mt][1]);
        }
    }
    bf16x8 vf[8][2];
#pragma unroll
    for (int dvt = 0; dvt < 8; ++dvt)
#pragma unroll
      for (int g = 0; g < 2; ++g) vf[dvt][g] = *(const LASP bf16x8*)(Vb + (dvt * 16 + l15) * 128 + (g ? ko1 : ko0));
    __builtin_amdgcn_sched_barrier(0);
    bf16x8 pf[2][2];
#pragma unroll
    for (int qt = 0; qt < 2; ++qt) {
      float ps0 = 0.f, ps1 = 0.f, ps2 = 0.f, ps3 = 0.f;
#pragma unroll
      for (int j = 0; j < 4; ++j) {
        const float e0 = fexp2(s[0][qt][j]), e1 = fexp2(s[1][qt][j]), e2 = fexp2(s[2][qt][j]), e3 = fexp2(s[3][qt][j]);
        s[0][qt][j] = e0; s[1][qt][j] = e1; s[2][qt][j] = e2; s[3][qt][j] = e3;
        ps0 += e0; ps1 += e1; ps2 += e2; ps3 += e3;
      }
      lsum[qt] += (ps0 + ps1) + (ps2 + ps3);
      pf[0][qt] = pack8f(s[0][qt], s[1][qt]);
      pf[1][qt] = pack8f(s[2][qt], s[3][qt]);
    }
#pragma unroll
    for (int dvt = 0; dvt < 8; ++dvt)
#pragma unroll
      for (int g = 0; g < 2; ++g) {
        O[dvt][0] = mfma16(vf[dvt][g], pf[g][0], O[dvt][0]);
        O[dvt][1] = mfma16(vf[dvt][g], pf[g][1], O[dvt][1]);
      }
    slot = slot == 2 ? 0 : slot + 1;
  }
#undef A_DMA
  __builtin_amdgcn_s_setprio(0);
  float inv[2];
#pragma unroll
  for (int qt = 0; qt < 2; ++qt) {
    float lt = lsum[qt];
    lt += __shfl_xor(lt, 16);
    lt += __shfl_xor(lt, 32);
    inv[qt] = 1.f / lt;
  }
  __syncthreads();
  float* ex = (float*)ldsg;
  if (comp == 1) {
#pragma unroll
    for (int dvt = 0; dvt < 8; ++dvt)
#pragma unroll
      for (int qt = 0; qt < 2; ++qt)
#pragma unroll
        for (int j = 0; j < 4; ++j) ex[(qp * 64 + (dvt * 2 + qt) * 4 + j) * 64 + lane] = O[dvt][qt][j] * inv[qt] * lam;
  }
  __syncthreads();
  if (comp == 0) {
    const float* sg = p.a_subln_g + l * 128;
#pragma unroll
    for (int qt = 0; qt < 2; ++qt) {
      float ss = 0.f;
#pragma unroll
      for (int dvt = 0; dvt < 8; ++dvt)
#pragma unroll
        for (int j = 0; j < 4; ++j) {
          const float o = O[dvt][qt][j] * inv[qt] - ex[(qp * 64 + (dvt * 2 + qt) * 4 + j) * 64 + lane];
          O[dvt][qt][j] = o;
          ss += o * o;
        }
      ss += __shfl_xor(ss, 16);
      ss += __shfl_xor(ss, 32);
      const float r = rsqrtf(ss * (1.f / 128.f) + EPS_) * (1.f - lam_init);
      u16* dst = p.YS + (qrow0 + qt * 16 + l15) * 2048 + YS_A + h * 128;
#pragma unroll
      for (int u = 0; u < 4; ++u) {
        const int dv0 = u * 32 + quad * 8;
        const float4 g0 = *(const float4*)(sg + dv0), g1 = *(const float4*)(sg + dv0 + 4);
        f32x4 a = O[2 * u][qt], b = O[2 * u + 1][qt];
        a[0] *= r * g0.x; a[1] *= r * g0.y; a[2] *= r * g0.z; a[3] *= r * g0.w;
        b[0] *= r * g1.x; b[1] *= r * g1.y; b[2] *= r * g1.z; b[3] *= r * g1.w;
        *(u32x4*)(dst + dv0) = pack8(a, b);
      }
    }
  }
}

template <bool CTXQ>
DEV void attnC_unit(const Params& p, int l, int bl, int h, int r, float* rpbs) {
  const int t = tid(), lane = t & 63, jw = t >> 6, l15 = lane & 15, quad = lane >> 4;
  constexpr int NG = CTXQ ? 8 : 16;
  constexpr int NL = CTXQ ? 0 : 8;
  if (!CTXQ) {
    __syncthreads();
    for (int i = t; i < 465; i += 256) rpbs[i] = p.c_rpb[(size_t)(l * 8 + h) * 465 + i] * LOG2E;
    __syncthreads();
  }
  const size_t qrow = CTXQ ? (size_t)LR + bl * 256 + r * 64 + jw * 16 + l15 : (size_t)bl * 2048 + r * 64 + jw * 16 + l15;
  bf16x8 qf[2];
#pragma unroll
  for (int ks = 0; ks < 2; ++ks) qf[ks] = *(const bf16x8*)(p.PX + qrow * PXW + PX_CQ + h * 64 + ks * 32 + quad * 8);
  const int rs = min(max(r - 4, 0), 24), band0 = min(max(jw * 16 - 8, 0), 32);
  const int kk = (l15 >> 2) * 8 + (l15 & 3);
  f32x4 s[NG][2];
#pragma unroll
  for (int g = 0; g < NG; ++g) {
    size_t krow;
    if (g < NL) krow = (size_t)bl * 2048 + (rs + g) * 64 + band0 + kk;
    else krow = (size_t)LR + bl * 256 + (g - NL) * 32 + kk;
#pragma unroll
    for (int hf = 0; hf < 2; ++hf) {
      const u16* kp = p.PX + (krow + hf * 4) * PXW + PX_CK + h * 64 + quad * 8;
      const bf16x8 k0 = *(const bf16x8*)kp, k1 = *(const bf16x8*)(kp + 32);
      f32x4 a = (f32x4){0.f, 0.f, 0.f, 0.f};
      a = mfma16(k0, qf[0], a);
      a = mfma16(k1, qf[1], a);
      s[g][hf] = a;
    }
  }
  if (!CTXQ) {
    const int qc = jw * 16 + l15;
    const int win0 = min(max(qc - 8, 0), 48);
#pragma unroll
    for (int g = 0; g < NL; ++g) {
      const int ri = (rs + g - r + 7) * 31;
#pragma unroll
      for (int hf = 0; hf < 2; ++hf)
#pragma unroll
        for (int j = 0; j < 4; ++j) {
          const int kc = band0 + quad * 8 + hf * 4 + j;
          const bool valid = (kc >= win0) && (kc < win0 + 16);
          const int dc = min(max(kc - qc + 15, 0), 30);
          const float bias = rpbs[ri + dc];
          s[g][hf][j] = valid ? s[g][hf][j] + bias : -INFINITY;
        }
    }
  }
  float mx = -INFINITY;
#pragma unroll
  for (int g = 0; g < NG; ++g)
#pragma unroll
    for (int hf = 0; hf < 2; ++hf)
#pragma unroll
      for (int j = 0; j < 4; ++j) mx = fmaxf(mx, s[g][hf][j]);
  mx = fmaxf(mx, __shfl_xor(mx, 16));
  mx = fmaxf(mx, __shfl_xor(mx, 32));
  float ls = 0.f;
#pragma unroll
  for (int g = 0; g < NG; ++g)
#pragma unroll
    for (int hf = 0; hf < 2; ++hf)
#pragma unroll
      for (int j = 0; j < 4; ++j) { const float e = fexp2(s[g][hf][j] - mx); s[g][hf][j] = e; ls += e; }
  ls += __shfl_xor(ls, 16);
  ls += __shfl_xor(ls, 32);
  f32x4 O[4];
#pragma unroll
  for (int i = 0; i < 4; ++i) O[i] = (f32x4){0.f, 0.f, 0.f, 0.f};
#pragma unroll
  for (int g = 0; g < NG; ++g) {
    const int keybase = (g < NL) ? (rs + g) * 64 + band0 : 2048 + (g - NL) * 32;
    const bf16x8 pf = pack8f(s[g][0], s[g][1]);
#pragma unroll
    for (int dvt = 0; dvt < 4; ++dvt) {
      const int dv = (dvt >> 1) * 32 + (l15 >> 2) * 8 + (dvt & 1) * 4 + (l15 & 3);
      const bf16x8 vf = *(const bf16x8*)(p.VTC + ((size_t)((bl * 8 + h) * 64 + dv)) * KV + keybase + quad * 8);
      O[dvt] = mfma16(vf, pf, O[dvt]);
    }
  }
  const float inv = 1.f / ls;
  u16* dst = p.YS + qrow * 2048 + YS_C + h * 64;
#pragma unroll
  for (int u = 0; u < 2; ++u) {
    f32x4 a = O[2 * u] * inv, b = O[2 * u + 1] * inv;
    *(u32x4*)(dst + u * 32 + quad * 8) = pack8(a, b);
  }
}

template <int WH>
DEV void pool_rows(const u16* __restrict__ pb, u16* Ys, int tt, int seg, int ch, int L) {
  constexpr int NR = 8 + 2 * WH - 1;
  const int ts0 = tt * 128 + seg * 8;
  u32x4 rows[NR];
#pragma unroll
  for (int j = 0; j < NR; ++j) {
    const int tk = ts0 - WH + j;
    const int tkc = min(max(tk, 0), L - 1);
    rows[j] = *(const u32x4*)(pb + (size_t)tkc * PXW);
    if (tk < 0 || tk >= L) rows[j] = (u32x4){0u, 0u, 0u, 0u};
  }
  float a[8];
#pragma unroll
  for (int e = 0; e < 8; ++e) a[e] = 0.f;
#pragma unroll
  for (int j = 0; j < 2 * WH; ++j) {
    const u32x4 q = rows[j];
    a[0] += bflo(q.x); a[1] += bfhi(q.x); a[2] += bflo(q.y); a[3] += bfhi(q.y);
    a[4] += bflo(q.z); a[5] += bfhi(q.z); a[6] += bflo(q.w); a[7] += bfhi(q.w);
  }
#pragma unroll
  for (int i = 0; i < 8; ++i) {
    const int tl = seg * 8 + i, ts = ts0 + i;
    const int lo = max(ts - WH, 0), hi = min(ts + WH, L);
    const float ic = 1.f / (float)(hi - lo);
    const u32x4 own = rows[i + WH];
    u32x4 o;
    o.x = cvt_pk(a[0] * ic - bflo(own.x), a[1] * ic - bfhi(own.x));
    o.y = cvt_pk(a[2] * ic - bflo(own.y), a[3] * ic - bfhi(own.y));
    o.z = cvt_pk(a[4] * ic - bflo(own.z), a[5] * ic - bfhi(own.z));
    o.w = cvt_pk(a[6] * ic - bflo(own.w), a[7] * ic - bfhi(own.w));
    *(u32x4*)(Ys + perm32(tl) * 136 + ch * 8) = o;
    if (i < 7) {
      const u32x4 q0 = rows[i], q1 = rows[i + 2 * WH];
      a[0] += bflo(q1.x) - bflo(q0.x); a[1] += bfhi(q1.x) - bfhi(q0.x); a[2] += bflo(q1.y) - bflo(q0.y); a[3] += bfhi(q1.y) - bfhi(q0.y);
      a[4] += bflo(q1.z) - bflo(q0.z); a[5] += bfhi(q1.z) - bfhi(q0.z); a[6] += bflo(q1.w) - bflo(q0.w); a[7] += bfhi(q1.w) - bfhi(q0.w);
    }
  }
}

template <int ST>
DEV void attnC_stage_load(const Params& p, int bl, int h, int rs, u32x4 (&rg)[8]) {
  const int t = tid();
  if (ST < 3) {
    const size_t rowbase = ST == 2 ? (size_t)LR + bl * 256 : (size_t)bl * 2048 + rs * 64 + ST * 256;
    const u16* b = p.PX + rowbase * PXW + PX_CK + h * 64;
    const unsigned o = (unsigned)((t >> 3) * PXW + (t & 7) * 8);
#pragma unroll
    for (int i = 0; i < 8; ++i) rg[i] = *(const u32x4*)((b + (size_t)(32 * i) * PXW) + o);
  } else {
    const int keybase = ST == 5 ? 2048 : rs * 64 + (ST - 3) * 256;
    const u16* b = p.VTC + ((size_t)((bl * 8 + h) * 64)) * KV + keybase;
    const unsigned o = (unsigned)((t >> 5) * KV + (t & 31) * 8);
#pragma unroll
    for (int i = 0; i < 8; ++i) rg[i] = *(const u32x4*)((b + (size_t)(8 * i) * KV) + o);
  }
}
template <int ST>
DEV void attnC_stage_store(u16* buf, const u32x4 (&rg)[8]) {
  const int t = tid();
  if (ST < 3) {
#pragma unroll
    for (int i = 0; i < 8; ++i) {
      const int row = (t >> 3) + 32 * i, c = t & 7, key = ((row >> 3) & 3) * 2 + ((row >> 1) & 1);
      *(u32x4*)(buf + row * 64 + ((c ^ key) << 3)) = rg[i];
    }
  } else {
#pragma unroll
    for (int i = 0; i < 8; ++i) {
      const int dv = (t >> 5) + 8 * i, c = t & 31, key = ((dv >> 3) & 3) * 4 + (dv & 3);
      *(u32x4*)(buf + dv * 256 + ((c ^ key) << 3)) = rg[i];
    }
  }
}
DEV bf16x8 attnC_kfrag(const u16* buf, int row, int chunk) {
  const int key = ((row >> 3) & 3) * 2 + ((row >> 1) & 1);
  return *(const bf16x8*)(buf + row * 64 + ((chunk ^ key) << 3));
}
DEV bf16x8 attnC_vfrag(const u16* buf, int dv, int chunk) {
  const int key = ((dv >> 3) & 3) * 4 + (dv & 3);
  return *(const bf16x8*)(buf + dv * 256 + ((chunk ^ key) << 3));
}

DEV void attnC_lds_unit(const Params& p, int l, int bl, int h, int r, u16* lds) {
  const int t = tid(), lane = t & 63, jw = t >> 6, l15 = lane & 15, quad = lane >> 4;
  u16* buf0 = lds;
  u16* buf1 = lds + 16384;
  float* rpbs = (float*)(lds + 32768);
  const int rs = min(max(r - 4, 0), 24), band0 = min(max(jw * 16 - 8, 0), 32);
  const int kk = (l15 >> 2) * 8 + (l15 & 3);
  u32x4 rg[8];
  attnC_stage_load<0>(p, bl, h, rs, rg);
  __syncthreads();
  for (int i = t; i < 465; i += 256) rpbs[i] = p.c_rpb[(size_t)(l * 8 + h) * 465 + i] * LOG2E;
  attnC_stage_store<0>(buf0, rg);
  attnC_stage_load<1>(p, bl, h, rs, rg);
  const size_t qrow = (size_t)bl * 2048 + r * 64 + jw * 16 + l15;
  bf16x8 qf[2];
#pragma unroll
  for (int ks = 0; ks < 2; ++ks) qf[ks] = *(const bf16x8*)(p.PX + qrow * PXW + PX_CQ + h * 64 + ks * 32 + quad * 8);
  __syncthreads();
  f32x4 s[16][2];
  f32x4 O[4];
#pragma unroll
  for (int i = 0; i < 4; ++i) O[i] = (f32x4){0.f, 0.f, 0.f, 0.f};
  float ls = 0.f;
#pragma unroll
  for (int st = 0; st < 2; ++st) {
    const u16* buf = st ? buf1 : buf0;
#pragma unroll
    for (int hf = 0; hf < 2; ++hf) {
      bf16x8 kf[4][2];
#pragma unroll
      for (int kr = 0; kr < 4; ++kr) {
        const int row = kr * 64 + band0 + kk + hf * 4;
        kf[kr][0] = attnC_kfrag(buf, row, quad);
        kf[kr][1] = attnC_kfrag(buf, row, 4 + quad);
      }
#pragma unroll
      for (int kr = 0; kr < 4; ++kr) {
        f32x4 a = (f32x4){0.f, 0.f, 0.f, 0.f};
        a = mfma16(kf[kr][0], qf[0], a);
        a = mfma16(kf[kr][1], qf[1], a);
        s[st * 4 + kr][hf] = a;
      }
    }
    if (st == 0) { attnC_stage_store<1>(buf1, rg); attnC_stage_load<2>(p, bl, h, rs, rg); }
    else { attnC_stage_store<2>(buf0, rg); attnC_stage_load<3>(p, bl, h, rs, rg); }
    __syncthreads();
  }
  {
#pragma unroll
    for (int gh = 0; gh < 4; ++gh) {
      bf16x8 kf[4][2];
#pragma unroll
      for (int i = 0; i < 4; ++i) {
        const int g = gh * 2 + (i >> 1), hf = i & 1;
        const int row = g * 32 + kk + hf * 4;
        kf[i][0] = attnC_kfrag(buf0, row, quad);
        kf[i][1] = attnC_kfrag(buf0, row, 4 + quad);
      }
#pragma unroll
      for (int i = 0; i < 4; ++i) {
        f32x4 a = (f32x4){0.f, 0.f, 0.f, 0.f};
        a = mfma16(kf[i][0], qf[0], a);
        a = mfma16(kf[i][1], qf[1], a);
        s[8 + gh * 2 + (i >> 1)][i & 1] = a;
      }
    }
    attnC_stage_store<3>(buf1, rg);
    attnC_stage_load<4>(p, bl, h, rs, rg);
    const int qc = jw * 16 + l15;
    const int win0 = min(max(qc - 8, 0), 48);
#pragma unroll
    for (int g = 0; g < 8; ++g) {
      const int ri = (rs + g - r + 7) * 31;
#pragma unroll
      for (int hf = 0; hf < 2; ++hf)
#pragma unroll
        for (int j = 0; j < 4; ++j) {
          const int kc = band0 + quad * 8 + hf * 4 + j;
          const bool valid = (kc >= win0) && (kc < win0 + 16);
          const int dc = min(max(kc - qc + 15, 0), 30);
          const float bias = rpbs[ri + dc];
          s[g][hf][j] = valid ? s[g][hf][j] + bias : -INFINITY;
        }
    }
    float mx = -INFINITY;
#pragma unroll
    for (int g = 0; g < 16; ++g)
#pragma unroll
      for (int hf = 0; hf < 2; ++hf)
#pragma unroll
        for (int j = 0; j < 4; ++j) mx = fmaxf(mx, s[g][hf][j]);
    mx = fmaxf(mx, __shfl_xor(mx, 16));
    mx = fmaxf(mx, __shfl_xor(mx, 32));
#pragma unroll
    for (int g = 0; g < 16; ++g)
#pragma unroll
      for (int hf = 0; hf < 2; ++hf)
#pragma unroll
        for (int j = 0; j < 4; ++j) { const float e = fexp2(s[g][hf][j] - mx); s[g][hf][j] = e; ls += e; }
    ls += __shfl_xor(ls, 16);
    ls += __shfl_xor(ls, 32);
    __syncthreads();
  }
#pragma unroll
  for (int st = 0; st < 2; ++st) {
    const u16* buf = st ? buf0 : buf1;
#pragma unroll
    for (int kh = 0; kh < 2; ++kh) {
      bf16x8 vf[2][4];
#pragma unroll
      for (int k2 = 0; k2 < 2; ++k2) {
        const int c = (kh * 2 + k2) * 8 + (band0 >> 3) + quad;
#pragma unroll
        for (int dvt = 0; dvt < 4; ++dvt) {
          const int dv = (dvt >> 1) * 32 + (l15 >> 2) * 8 + (dvt & 1) * 4 + (l15 & 3);
          vf[k2][dvt] = attnC_vfrag(buf, dv, c);
        }
      }
#pragma unroll
      for (int k2 = 0; k2 < 2; ++k2) {
        const int kr = kh * 2 + k2;
        const bf16x8 pf = pack8f(s[st * 4 + kr][0], s[st * 4 + kr][1]);
#pragma unroll
        for (int dvt = 0; dvt < 4; ++dvt) O[dvt] = mfma16(vf[k2][dvt], pf, O[dvt]);
      }
    }
    if (st == 0) { attnC_stage_store<4>(buf0, rg); attnC_stage_load<5>(p, bl, h, rs, rg); }
    else { attnC_stage_store<5>(buf1, rg); }
    __syncthreads();
  }
#pragma unroll
  for (int gh = 0; gh < 4; ++gh) {
    bf16x8 vf[2][4];
#pragma unroll
    for (int k2 = 0; k2 < 2; ++k2) {
      const int c = (gh * 2 + k2) * 4 + quad;
#pragma unroll
      for (int dvt = 0; dvt < 4; ++dvt) {
        const int dv = (dvt >> 1) * 32 + (l15 >> 2) * 8 + (dvt & 1) * 4 + (l15 & 3);
        vf[k2][dvt] = attnC_vfrag(buf1, dv, c);
      }
    }
#pragma unroll
    for (int k2 = 0; k2 < 2; ++k2) {
      const int g = gh * 2 + k2;
      const bf16x8 pf = pack8f(s[8 + g][0], s[8 + g][1]);
#pragma unroll
      for (int dvt = 0; dvt < 4; ++dvt) O[dvt] = mfma16(vf[k2][dvt], pf, O[dvt]);
    }
  }
  const float inv = 1.f / ls;
  u16* dst = p.YS + qrow * 2048 + YS_C + h * 64;
#pragma unroll
  for (int u = 0; u < 2; ++u) {
    f32x4 a = O[2 * u] * inv, b = O[2 * u + 1] * inv;
    *(u32x4*)(dst + u * 32 + quad * 8) = pack8(a, b);
  }
}

template <int ST>
DEV void c2_load(const Params& p, int bl, int h, int base, u32x4 (&rg)[4]) {
  const int t = ptid();
  if (ST < 3) {
    const u16* b = p.PX + (size_t)bl * 2048 * PXW + PX_CK + h * 64;
#pragma unroll
    for (int i = 0; i < 3; ++i) {
      const int id = t + 512 * i, key = id >> 3, c = id & 7;
      const int row = min(base + ST * 3 + (key >> 6), 31);
      rg[i] = *(const u32x4*)(b + (size_t)(row * 64 + (key & 63)) * PXW + c * 8);
    }
  } else if (ST == 3) {
    const u16* b = p.PX + ((size_t)LR + bl * 256) * PXW + PX_CK + h * 64;
    const unsigned o = (unsigned)((t >> 3) * PXW + (t & 7) * 8);
#pragma unroll
    for (int i = 0; i < 4; ++i) rg[i] = *(const u32x4*)((b + (size_t)(64 * i) * PXW) + o);
  } else if (ST < 7) {
    const u16* b = p.VTC + ((size_t)((bl * 8 + h) * 64)) * KV + (base + (ST - 4) * 3) * 64;
#pragma unroll
    for (int i = 0; i < 3; ++i) {
      const int id = t + 512 * i, dv = id / 24, c = id - dv * 24;
      rg[i] = *(const u32x4*)(b + (size_t)dv * KV + c * 8);
    }
  } else {
    const u16* b = p.VTC + ((size_t)((bl * 8 + h) * 64)) * KV + 2048;
    const unsigned o = (unsigned)((t >> 5) * KV + (t & 31) * 8);
#pragma unroll
    for (int i = 0; i < 4; ++i) rg[i] = *(const u32x4*)((b + (size_t)(16 * i) * KV) + o);
  }
}
template <int ST>
DEV void c2_store(u16* buf, const u32x4 (&rg)[4]) {
  const int t = ptid();
  if (ST <= 3) {
    constexpr int N = (ST == 3) ? 4 : 3;
#pragma unroll
    for (int i = 0; i < N; ++i) {
      const int id = t + 512 * i, row = id >> 3, c = id & 7, key = ((row >> 3) & 3) * 2 + ((row >> 1) & 1);
      *(u32x4*)(buf + row * 64 + ((c ^ key) << 3)) = rg[i];
    }
  } else if (ST < 7) {
#pragma unroll
    for (int i = 0; i < 3; ++i) {
      const int id = t + 512 * i, dv = id / 24, c = id - dv * 24, key = ((dv >> 3) & 3) * 4 + (dv & 3);
      *(u32x4*)(buf + dv * 256 + ((c ^ key) << 3)) = rg[i];
    }
  } else {
#pragma unroll
    for (int i = 0; i < 4; ++i) {
      const int id = t + 512 * i, dv = id >> 5, c = id & 31, key = ((dv >> 3) & 3) * 4 + (dv & 3);
      *(u32x4*)(buf + dv * 256 + ((c ^ key) << 3)) = rg[i];
    }
  }
}
DEV bf16x8 c2k(const LASP unsigned char* buf, int row, int chunk) {
  const int key = ((row >> 3) & 3) * 2 + ((row >> 1) & 1);
  return *(const LASP bf16x8*)(buf + row * 128 + ((chunk ^ key) << 4));
}
DEV bf16x8 c2v(const LASP unsigned char* buf, int dv, int chunk) {
  const int key = ((dv >> 3) & 3) * 4 + (dv & 3);
  return *(const LASP bf16x8*)(buf + dv * 512 + ((chunk ^ key) << 4));
}
template <int ST>
DEV void c2_dma(const Params& p, int bl, int h, int base, LASP unsigned char* slot, int w, int lane) {
  if (ST <= 3) {
    constexpr int NB = (ST == 3) ? 4 : 3;
#pragma unroll
    for (int i = 0; i < NB; ++i) {
      const int b = w * NB + i;
      const int row = b * 8 + (lane >> 3), c = (lane & 7) ^ (((row >> 3) & 3) * 2 + ((row >> 1) & 1));
      const u16* src;
      if (ST < 3) {
        const int grow = min(base + ST * 3 + (row >> 6), 31);
        src = p.PX + ((size_t)bl * 2048 + grow * 64 + (row & 63)) * PXW + PX_CK + h * 64 + c * 8;
      } else {
        src = p.PX + ((size_t)LR + bl * 256 + row) * PXW + PX_CK + h * 64 + c * 8;
      }
      __builtin_amdgcn_global_load_lds((const unsigned*)src, (LASP unsigned*)(slot + b * 1024), 16, 0, 0);
    }
  } else {
#pragma unroll
    for (int i = 0; i < 4; ++i) {
      const int b = w * 4 + i;
      const int dv = b * 2 + (lane >> 5);
      int c = (lane & 31) ^ (((dv >> 3) & 3) * 4 + (dv & 3));
      const u16* vb = p.VTC + ((size_t)((bl * 8 + h) * 64 + dv)) * KV;
      const u16* src;
      if (ST < 7) { if (c >= 24) c -= 8; src = vb + (base + (ST - 4) * 3) * 64 + c * 8; }
      else src = vb + 2048 + c * 8;
      __builtin_amdgcn_global_load_lds((const unsigned*)src, (LASP unsigned*)(slot + b * 1024), 16, 0, 0);
    }
  }
}
template <int K3>
DEV void c2_kloc(const LASP unsigned char* buf, f32x4 (&sl)[9][2], const bf16x8 (&qf)[2], int band0, int kk, int quad) {
#pragma unroll
  for (int hf = 0; hf < 2; ++hf) {
    bf16x8 kf[3][2];
#pragma unroll
    for (int i = 0; i < 3; ++i) {
      const int row = i * 64 + band0 + kk + hf * 4;
      kf[i][0] = c2k(buf, row, quad);
      kf[i][1] = c2k(buf, row, 4 + quad);
    }
#pragma unroll
    for (int i = 0; i < 3; ++i) {
      f32x4 a = (f32x4){0.f, 0.f, 0.f, 0.f};
      a = mfma16(kf[i][0], qf[0], a);
      a = mfma16(kf[i][1], qf[1], a);
      sl[K3 * 3 + i][hf] = a;
    }
  }
}
template <int K3>
DEV void c2_vloc(const LASP unsigned char* buf, f32x4 (&sl)[9][2], f32x4 (&O)[4], int band0, int l15, int quad) {
  bf16x8 vf[3][4];
#pragma unroll
  for (int i = 0; i < 3; ++i) {
    const int c = i * 8 + (band0 >> 3) + quad;
#pragma unroll
    for (int dvt = 0; dvt < 4; ++dvt) {
      const int dv = (dvt >> 1) * 32 + (l15 >> 2) * 8 + (dvt & 1) * 4 + (l15 & 3);
      vf[i][dvt] = c2v(buf, dv, c);
    }
  }
#pragma unroll
  for (int i = 0; i < 3; ++i) {
    const bf16x8 pf = pack8f(sl[K3 * 3 + i][0], sl[K3 * 3 + i][1]);
#pragma unroll
    for (int dvt = 0; dvt < 4; ++dvt) O[dvt] = mfma16(vf[i][dvt], pf, O[dvt]);
  }
}

DEV void attnC2_unit(const Params& p, int l, int bl, int h, int rp, u16* ldsg) {
  const int t = ptid(), lane = t & 63, w = __builtin_amdgcn_readfirstlane(t >> 6), l15 = lane & 15, quad = lane >> 4;
  const int qr = w >> 2, jw = w & 3;
  LASP unsigned char* L = (LASP unsigned char*)ldsg;
  float* rpbs = (float*)(ldsg + 65536);
  const int r0 = rp * 2;
  const int base = min(max(r0 - 4, 0), 24);
  const int d = qr ? (min(max(r0 - 3, 0), 24) - base) : 0;
  const int r = r0 + qr;
  const int band0 = min(max(jw * 16 - 8, 0), 32);
  const int kk = (l15 >> 2) * 8 + (l15 & 3);
#define C2_WAIT(n) asm volatile("s_waitcnt vmcnt(" #n ")" ::: "memory")
  __syncthreads();
  for (int i = t; i < 465; i += 512) rpbs[i] = p.c_rpb[(size_t)(l * 8 + h) * 465 + i] * LOG2E;
  const size_t qrow = (size_t)bl * 2048 + r * 64 + jw * 16 + l15;
  bf16x8 qf[2];
#pragma unroll
  for (int ks = 0; ks < 2; ++ks) qf[ks] = *(const bf16x8*)(p.PX + qrow * PXW + PX_CQ + h * 64 + ks * 32 + quad * 8);
  c2_dma<0>(p, bl, h, base, L, w, lane);
  c2_dma<1>(p, bl, h, base, L + 32768, w, lane);
  c2_dma<2>(p, bl, h, base, L + 65536, w, lane);
  f32x4 sl[9][2], sc[8][2];
  f32x4 O[4];
#pragma unroll
  for (int i = 0; i < 4; ++i) O[i] = (f32x4){0.f, 0.f, 0.f, 0.f};
  float ls = 0.f;
  asm volatile("s_waitcnt lgkmcnt(0)" ::: "memory");
  C2_WAIT(6); __builtin_amdgcn_s_barrier();
  c2_dma<3>(p, bl, h, base, L + 98304, w, lane);
  c2_kloc<0>(L, sl, qf, band0, kk, quad);
  C2_WAIT(7); __builtin_amdgcn_s_barrier();
  c2_dma<4>(p, bl, h, base, L, w, lane);
  c2_kloc<1>(L + 32768, sl, qf, band0, kk, quad);
  C2_WAIT(8); __builtin_amdgcn_s_barrier();
  c2_dma<5>(p, bl, h, base, L + 32768, w, lane);
  c2_kloc<2>(L + 65536, sl, qf, band0, kk, quad);
  C2_WAIT(8); __builtin_amdgcn_s_barrier();
  c2_dma<6>(p, bl, h, base, L + 65536, w, lane);
  {
#pragma unroll
    for (int gh = 0; gh < 4; ++gh) {
      bf16x8 kf[4][2];
#pragma unroll
      for (int i = 0; i < 4; ++i) {
        const int g = gh * 2 + (i >> 1), hf = i & 1;
        const int row = g * 32 + kk + hf * 4;
        kf[i][0] = c2k(L + 98304, row, quad);
        kf[i][1] = c2k(L + 98304, row, 4 + quad);
      }
#pragma unroll
      for (int i = 0; i < 4; ++i) {
        f32x4 a = (f32x4){0.f, 0.f, 0.f, 0.f};
        a = mfma16(kf[i][0], qf[0], a);
        a = mfma16(kf[i][1], qf[1], a);
        sc[gh * 2 + (i >> 1)][i & 1] = a;
      }
    }
    const int qc = jw * 16 + l15;
    const int win0 = min(max(qc - 8, 0), 48);
#pragma unroll
    for (int a = 0; a < 9; ++a) {
      const bool rowvalid = (a >= d) && (a < d + 8);
      const int ri = min(max(base + a - r + 7, 0), 14) * 31;
#pragma unroll
      for (int hf = 0; hf < 2; ++hf)
#pragma unroll
        for (int j = 0; j < 4; ++j) {
          const int kc = band0 + quad * 8 + hf * 4 + j;
          const bool valid = rowvalid && (kc >= win0) && (kc < win0 + 16);
          const int dc = min(max(kc - qc + 15, 0), 30);
          const float bias = rpbs[ri + dc];
          sl[a][hf][j] = valid ? sl[a][hf][j] + bias : -INFINITY;
        }
    }
    float mx = -INFINITY;
#pragma unroll
    for (int a = 0; a < 9; ++a)
#pragma unroll
      for (int hf = 0; hf < 2; ++hf)
#pragma unroll
        for (int j = 0; j < 4; ++j) mx = fmaxf(mx, sl[a][hf][j]);
#pragma unroll
    for (int g = 0; g < 8; ++g)
#pragma unroll
      for (int hf = 0; hf < 2; ++hf)
#pragma unroll
        for (int j = 0; j < 4; ++j) mx = fmaxf(mx, sc[g][hf][j]);
    mx = fmaxf(mx, __shfl_xor(mx, 16));
    mx = fmaxf(mx, __shfl_xor(mx, 32));
#pragma unroll
    for (int a = 0; a < 9; ++a)
#pragma unroll
      for (int hf = 0; hf < 2; ++hf)
#pragma unroll
        for (int j = 0; j < 4; ++j) { const float e = fexp2(sl[a][hf][j] - mx); sl[a][hf][j] = e; ls += e; }
#pragma unroll
    for (int g = 0; g < 8; ++g)
#pragma unroll
      for (int hf = 0; hf < 2; ++hf)
#pragma unroll
        for (int j = 0; j < 4; ++j) { const float e = fexp2(sc[g][hf][j] - mx); sc[g][hf][j] = e; ls += e; }
    ls += __shfl_xor(ls, 16);
    ls += __shfl_xor(ls, 32);
  }
  C2_WAIT(8); __builtin_amdgcn_s_barrier();
  c2_dma<7>(p, bl, h, base, L + 98304, w, lane);
  c2_vloc<0>(L, sl, O, band0, l15, quad);
  C2_WAIT(8); __builtin_amdgcn_s_barrier();
  c2_vloc<1>(L + 32768, sl, O, band0, l15, quad);
  C2_WAIT(4); __builtin_amdgcn_s_barrier();
  c2_vloc<2>(L + 65536, sl, O, band0, l15, quad);
  C2_WAIT(0); __builtin_amdgcn_s_barrier();
#pragma unroll
  for (int gh = 0; gh < 4; ++gh) {
    bf16x8 vf[2][4];
#pragma unroll
    for (int k2 = 0; k2 < 2; ++k2) {
      const int c = (gh * 2 + k2) * 4 + quad;
#pragma unroll
      for (int dvt = 0; dvt < 4; ++dvt) {
        const int dv = (dvt >> 1) * 32 + (l15 >> 2) * 8 + (dvt & 1) * 4 + (l15 & 3);
        vf[k2][dvt] = c2v(L + 98304, dv, c);
      }
    }
#pragma unroll
    for (int k2 = 0; k2 < 2; ++k2) {
      const int g = gh * 2 + k2;
      const bf16x8 pf = pack8f(sc[g][0], sc[g][1]);
#pragma unroll
      for (int dvt = 0; dvt < 4; ++dvt) O[dvt] = mfma16(vf[k2][dvt], pf, O[dvt]);
    }
  }
#undef C2_WAIT
  const float inv = 1.f / ls;
  u16* dst = p.YS + qrow * 2048 + YS_C + h * 64;
#pragma unroll
  for (int u = 0; u < 2; ++u) {
    f32x4 a = O[2 * u] * inv, b = O[2 * u + 1] * inv;
    *(u32x4*)(dst + u * 32 + quad * 8) = pack8(a, b);
  }
}

DEV void attnC2_ctx_unit(const Params& p, int l, int bl, int h, int hq, u16* lds) {
  const int t = ptid(), lane = t & 63, w = t >> 6, l15 = lane & 15, quad = lane >> 4;
  u16* buf0 = lds;
  u16* buf1 = lds + 16384;
  const int kk = (l15 >> 2) * 8 + (l15 & 3);
  u32x4 rg[4];
  c2_load<3>(p, bl, h, 0, rg);
  __syncthreads();
  c2_store<3>(buf0, rg);
  c2_load<7>(p, bl, h, 0, rg);
  const size_t qrow = (size_t)LR + bl * 256 + hq * 128 + w * 16 + l15;
  bf16x8 qf[2];
#pragma unroll
  for (int ks = 0; ks < 2; ++ks) qf[ks] = *(const bf16x8*)(p.PX + qrow * PXW + PX_CQ + h * 64 + ks * 32 + quad * 8);
  __syncthreads();
  f32x4 sc[8][2];
#pragma unroll
  for (int gh = 0; gh < 4; ++gh) {
    bf16x8 kf[4][2];
#pragma unroll
    for (int i = 0; i < 4; ++i) {
      const int g = gh * 2 + (i >> 1), hf = i & 1;
      const int row = g * 32 + kk + hf * 4;
      kf[i][0] = attnC_kfrag(buf0, row, quad);
      kf[i][1] = attnC_kfrag(buf0, row, 4 + quad);
    }
#pragma unroll
    for (int i = 0; i < 4; ++i) {
      f32x4 a = (f32x4){0.f, 0.f, 0.f, 0.f};
      a = mfma16(kf[i][0], qf[0], a);
      a = mfma16(kf[i][1], qf[1], a);
      sc[gh * 2 + (i >> 1)][i & 1] = a;
    }
  }
  c2_store<7>(buf1, rg);
  float mx = -INFINITY, ls = 0.f;
#pragma unroll
  for (int g = 0; g < 8; ++g)
#pragma unroll
    for (int hf = 0; hf < 2; ++hf)
#pragma unroll
      for (int j = 0; j < 4; ++j) mx = fmaxf(mx, sc[g][hf][j]);
  mx = fmaxf(mx, __shfl_xor(mx, 16));
  mx = fmaxf(mx, __shfl_xor(mx, 32));
#pragma unroll
  for (int g = 0; g < 8; ++g)
#pragma unroll
    for (int hf = 0; hf < 2; ++hf)
#pragma unroll
      for (int j = 0; j < 4; ++j) { const float e = fexp2(sc[g][hf][j] - mx); sc[g][hf][j] = e; ls += e; }
  ls += __shfl_xor(ls, 16);
  ls += __shfl_xor(ls, 32);
  __syncthreads();
  f32x4 O[4];
#pragma unroll
  for (int i = 0; i < 4; ++i) O[i] = (f32x4){0.f, 0.f, 0.f, 0.f};
#pragma unroll
  for (int gh = 0; gh < 4; ++gh) {
    bf16x8 vf[2][4];
#pragma unroll
    for (int k2 = 0; k2 < 2; ++k2) {
      const int c = (gh * 2 + k2) * 4 + quad;
#pragma unroll
      for (int dvt = 0; dvt < 4; ++dvt) {
        const int dv = (dvt >> 1) * 32 + (l15 >> 2) * 8 + (dvt & 1) * 4 + (l15 & 3);
        vf[k2][dvt] = attnC_vfrag(buf1, dv, c);
      }
    }
#pragma unroll
    for (int k2 = 0; k2 < 2; ++k2) {
      const int g = gh * 2 + k2;
      const bf16x8 pf = pack8f(sc[g][0], sc[g][1]);
#pragma unroll
      for (int dvt = 0; dvt < 4; ++dvt) O[dvt] = mfma16(vf[k2][dvt], pf, O[dvt]);
    }
  }
  const float inv = 1.f / ls;
  u16* dst = p.YS + qrow * 2048 + YS_C + h * 64;
#pragma unroll
  for (int u = 0; u < 2; ++u) {
    f32x4 a = O[2 * u] * inv, b = O[2 * u + 1] * inv;
    *(u32x4*)(dst + u * 32 + quad * 8) = pack8(a, b);
  }
}

DEV void poolB_unit(const Params& p, int l, int bl, int tt, int g, bool isc, u16* lds) {
  const int t = tid(), lane = t & 63, w = t >> 6, l15 = lane & 15, quad = lane >> 4, wx = w & 1, wy = w >> 1;
  u16* Xs = lds;
  u16* Ys = lds + 128 * 136;
  const int L = isc ? 256 : 2048;
  const size_t rowbase = isc ? (size_t)LR + bl * 256 : (size_t)bl * 2048;
  const int wh = 1 << g;
  __syncthreads();
  {
    const int ch = t & 15, seg = t >> 4;
    const u16* pb = p.PX + rowbase * PXW + PX_B + g * 128 + ch * 8;
    switch (g) {
      case 0: pool_rows<1>(pb, Ys, tt, seg, ch, L); break;
      case 1: pool_rows<2>(pb, Ys, tt, seg, ch, L); break;
      case 2: pool_rows<4>(pb, Ys, tt, seg, ch, L); break;
      default: pool_rows<8>(pb, Ys, tt, seg, ch, L); break;
    }
    const u16* wp = p.WPOOL + (size_t)(l * 4 + g) * 16384;
#pragma unroll
    for (int i = 0; i < 8; ++i) {
      const int id = t + 256 * i, d = id >> 4, c8 = id & 15;
      *(u32x4*)(Xs + perm32(d) * 136 + c8 * 8) = *(const u32x4*)(wp + d * 128 + c8 * 8);
    }
  }
  __syncthreads();
  f32x4 acc[4][4];
  zero_acc(acc);
  wave_mma<4, 136>(Xs, Ys, acc, wx, wy, l15, quad);
  const float* sp = p.b_pool_s + l * 512 + g * 128;
#pragma unroll
  for (int yt = 0; yt < 4; ++yt) {
    const size_t row = rowbase + tt * 128 + yidx(wy, yt, l15);
#pragma unroll
    for (int u = 0; u < 2; ++u) {
      const int x0 = xidx(wx, u, quad);
      const float4 s0 = *(const float4*)(sp + x0), s1 = *(const float4*)(sp + x0 + 4);
      f32x4 a = acc[2 * u][yt], b = acc[2 * u + 1][yt];
      a[0] *= s0.x; a[1] *= s0.y; a[2] *= s0.z; a[3] *= s0.w;
      b[0] *= s1.x; b[1] *= s1.y; b[2] *= s1.z; b[3] *= s1.w;
      *(u32x4*)(p.YS + row * 2048 + YS_B + g * 128 + x0) = pack8(a, b);
    }
  }
}

DEV void gateD_unit(const Params& p, int l, int bl, int n, int g, bool isc, u16* lds) {
  const int t = tid(), lane = t & 63, w = t >> 6, l15 = lane & 15, quad = lane >> 4, wx = w & 1, wy = w >> 1;
  u16* Xs = lds;
  u16* Ys = lds + 128 * 136;
  float* rr = (float*)(lds + 2 * 128 * 136);
  const size_t rowbase = (isc ? (size_t)LR + bl * 256 : (size_t)bl * 2048) + n * 128;
  __syncthreads();
  {
    const int q = t >> 1, hl = t & 1;
    const u16* vp = p.PX + (rowbase + q) * PXW + PX_DV + hl * 256;
    float ss = 0.f;
#pragma unroll 8
    for (int i = 0; i < 32; ++i) {
      const u32x4 v = *(const u32x4*)(vp + i * 8);
      const float a0 = bflo(v.x), a1 = bfhi(v.x), a2 = bflo(v.y), a3 = bfhi(v.y), a4 = bflo(v.z), a5 = bfhi(v.z), a6 = bflo(v.w), a7 = bfhi(v.w);
      ss += a0 * a0 + a1 * a1 + a2 * a2 + a3 * a3 + a4 * a4 + a5 * a5 + a6 * a6 + a7 * a7;
    }
    ss += __shfl_xor(ss, 1);
    if (hl == 0) rr[q] = rsqrtf(ss * (1.f / 512.f) + EPS_);
  }
  {
    __syncthreads();
    const u16* wp = p.WSB + (size_t)(l * 4 + g) * 16384;
#pragma unroll
    for (int i = 0; i < 8; ++i) {
      const int id = t + 256 * i, pr = id >> 4, c8 = id & 15;
      *(u32x4*)(Ys + perm32(pr) * 136 + c8 * 8) = *(const u32x4*)(wp + pr * 128 + c8 * 8);
    }
    const float* gv = p.d_vn_g + l * 512 + g * 128;
#pragma unroll 4
    for (int i = 0; i < 8; ++i) {
      const int id = t + 256 * i, q = id >> 4, c8 = id & 15;
      const u32x4 v = *(const u32x4*)(p.PX + (rowbase + q) * PXW + PX_DV + g * 128 + c8 * 8);
      const float rq = rr[q];
      const float4 g0 = *(const float4*)(gv + c8 * 8), g1 = *(const float4*)(gv + c8 * 8 + 4);
      const unsigned o0 = cvt_pk(bflo(v.x) * rq * g0.x, bfhi(v.x) * rq * g0.y);
      const unsigned o1 = cvt_pk(bflo(v.y) * rq * g0.z, bfhi(v.y) * rq * g0.w);
      const unsigned o2 = cvt_pk(bflo(v.z) * rq * g1.x, bfhi(v.z) * rq * g1.y);
      const unsigned o3 = cvt_pk(bflo(v.w) * rq * g1.z, bfhi(v.w) * rq * g1.w);
      const int c = c8 * 8;
      Xs[perm32(c + 0) * 136 + q] = (u16)(o0 & 0xffff); Xs[perm32(c + 1) * 136 + q] = (u16)(o0 >> 16);
      Xs[perm32(c + 2) * 136 + q] = (u16)(o1 & 0xffff); Xs[perm32(c + 3) * 136 + q] = (u16)(o1 >> 16);
      Xs[perm32(c + 4) * 136 + q] = (u16)(o2 & 0xffff); Xs[perm32(c + 5) * 136 + q] = (u16)(o2 >> 16);
      Xs[perm32(c + 6) * 136 + q] = (u16)(o3 & 0xffff); Xs[perm32(c + 7) * 136 + q] = (u16)(o3 >> 16);
    }
    __syncthreads();
    f32x4 acc[4][4];
    zero_acc(acc);
    wave_mma<4, 136>(Xs, Ys, acc, wx, wy, l15, quad);
    const float* bs = p.d_bs + (size_t)(l * 4 + g) * 128;
#pragma unroll
    for (int yt = 0; yt < 4; ++yt) {
      const int pr = yidx(wy, yt, l15);
      const float bb = bs[pr];
      const size_t row = rowbase + pr;
#pragma unroll
      for (int u = 0; u < 2; ++u) {
        const int x0 = xidx(wx, u, quad);
        const u32x4 uu = *(const u32x4*)(p.PX + row * PXW + PX_DU + g * 128 + x0);
        f32x4 a = acc[2 * u][yt], b = acc[2 * u + 1][yt];
        a[0] = (a[0] + bb) * bflo(uu.x); a[1] = (a[1] + bb) * bfhi(uu.x); a[2] = (a[2] + bb) * bflo(uu.y); a[3] = (a[3] + bb) * bfhi(uu.y);
        b[0] = (b[0] + bb) * bflo(uu.z); b[1] = (b[1] + bb) * bfhi(uu.z); b[2] = (b[2] + bb) * bflo(uu.w); b[3] = (b[3] + bb) * bfhi(uu.w);
        *(u32x4*)(p.YS + row * 2048 + YS_D + g * 128 + x0) = pack8(a, b);
      }
    }
  }
}

DEV void phase_mixers(const Params& p, int l, int hf, u16* lds, u16* lds0) {
  const bool last = (l == NLAYER - 1);
  {
    const int PG = (int)gridDim.x, pb = pbid();
    const bool swz = ((PG & 7) == 0) && (1024 % PG == 0);
    for (int v = pb; v < 1024; v += PG) {
      int a, qb;
      if (swz) { const int i = v / PG, s2 = i * (PG >> 3) + (pb >> 3); a = (s2 >> 4) * 8 + (pb & 7); qb = s2 & 15; }
      else { a = v >> 4; qb = v & 15; }
      attnA_unit<false>(p, l, a >> 2, a & 3, qb, lds0);
    }
    if (!last) for (int v = pb; v < 128; v += PG) attnA_unit<true>(p, l, v >> 3, (v >> 1) & 3, v & 1, lds0);
    __syncthreads();
    for (int v = pb; v < 2048; v += PG) attnC2_unit(p, l, v >> 7, (v >> 4) & 7, v & 15, lds0);
    if (!last) for (int v = pb; v < 256; v += PG) attnC2_ctx_unit(p, l, v >> 4, (v >> 1) & 7, v & 1, lds0);
  }
  __syncthreads();
  const int G = vgrid();
  const int nC = 0, nB = 1024, nD = 1024;
  const int nCc = 0, nBc = last ? 0 : 128, nDc = last ? 0 : 128;
  const int e1 = nC, e2 = e1 + nB, e3 = e2 + nD, e5 = e3 + nCc, e6 = e5 + nBc, e7 = e6 + nDc;
  for (int v = bid(); v < e7; v += G) {
    if (v < e1) {
      const int u = v;
      attnC_lds_unit(p, l, u >> 8, (u >> 5) & 7, u & 31, lds);
    } else if (v < e2) {
      const int u = v - e1;
      poolB_unit(p, l, u >> 6, (u >> 2) & 15, u & 3, false, lds);
    } else if (v < e3) {
      const int u = v - e2;
      gateD_unit(p, l, u >> 6, (u >> 2) & 15, u & 3, false, lds);
    } else if (v < e5) {
      const int u = v - e3;
      attnC_unit<true>(p, l, u >> 5, (u >> 2) & 7, u & 3, (float*)lds);
    } else if (v < e6) {
      const int u = v - e5;
      poolB_unit(p, l, u >> 3, (u >> 2) & 1, u & 3, true, lds);
    } else {
      const int u = v - e6;
      gateD_unit(p, l, u >> 3, (u >> 2) & 1, u & 3, true, lds);
    }
  }
}

DEV void phase_merge(const Params& p, int l, int hf, u16* lds) {
  const bool last = (l == NLAYER - 1);
  const int RT = last ? 256 : 288;
  const int t = tid(), lane = t & 63, w = t >> 6, l15 = lane & 15, quad = lane >> 4, wx = w & 1, wy = w >> 1;
  int rt, ct;
  for (int it = 0; next_tile(it, RT, 8, 8, 8, rt, ct); ++it) {
    f32x4 tot[4][4];
    zero_acc(tot);
#pragma unroll 1
    for (int i = 0; i < 4; ++i) {
      f32x4 acc[4][4];
      zero_acc(acc);
      gemm_kloop(p.WBR + ((size_t)l * 1024 + ct * 128) * 2048 + i * 512, 2048, p.YS + (size_t)rt * 128 * 2048 + i * 512, 2048, 8, acc, lds);
#pragma unroll
      for (int yt = 0; yt < 4; ++yt) {
        const size_t row = (size_t)rt * 128 + yidx(wy, yt, l15);
#pragma unroll
        for (int u = 0; u < 2; ++u) {
          const u32x4 gq = *(const u32x4*)(p.PX + row * PXW + PX_G + i * 1024 + ct * 128 + xidx(wx, u, quad));
          tot[2 * u][yt][0] += sigmoidf_(bflo(gq.x)) * acc[2 * u][yt][0];
          tot[2 * u][yt][1] += sigmoidf_(bfhi(gq.x)) * acc[2 * u][yt][1];
          tot[2 * u][yt][2] += sigmoidf_(bflo(gq.y)) * acc[2 * u][yt][2];
          tot[2 * u][yt][3] += sigmoidf_(bfhi(gq.y)) * acc[2 * u][yt][3];
          tot[2 * u + 1][yt][0] += sigmoidf_(bflo(gq.z)) * acc[2 * u + 1][yt][0];
          tot[2 * u + 1][yt][1] += sigmoidf_(bfhi(gq.z)) * acc[2 * u + 1][yt][1];
          tot[2 * u + 1][yt][2] += sigmoidf_(bflo(gq.w)) * acc[2 * u + 1][yt][2];
          tot[2 * u + 1][yt][3] += sigmoidf_(bfhi(gq.w)) * acc[2 * u + 1][yt][3];
        }
      }
    }
#pragma unroll
    for (int yt = 0; yt < 4; ++yt) {
      const size_t row = (size_t)rt * 128 + yidx(wy, yt, l15);
#pragma unroll
      for (int u = 0; u < 2; ++u)
        *(u32x4*)(p.HX + row * 1024 + ct * 128 + xidx(wx, u, quad)) = pack8(tot[2 * u][yt], tot[2 * u + 1][yt]);
    }
  }
}

DEV void phase_resgemm(const Params& p, int l, int hf, int which, u16* lds) {
  const bool last = (l == NLAYER - 1);
  const int RT = last ? 256 : 288;
  const int t = tid(), lane = t & 63, w = t >> 6, l15 = lane & 15, quad = lane >> 4, wx = w & 1, wy = w >> 1;
  const bool first = (which == 0 && l == 0);
  const float* xs = first ? p.x : p.out;
  const float* cs = first ? p.ctx : p.CTXC;
  int rt, ct;
  for (int it = 0; next_tile(it, RT, 8, 8, 8, rt, ct); ++it) {
    f32x4 acc[4][4];
    zero_acc(acc);
    if (which == 0) gemm_kloop(p.WOUT + ((size_t)l * 1024 + ct * 128) * 1024, 1024, p.HX + (size_t)rt * 128 * 1024, 1024, 16, acc, lds);
    else gemm_kloop(p.WDN + ((size_t)l * 1024 + ct * 128) * FH, FH, p.PX + (size_t)rt * 128 * FH, FH, FH / 64, acc, lds);
    int b, idx0; bool isc;
    rowmap(hf, rt * 128, b, idx0, isc);
    const float* gate = p.MOD + ((size_t)l * 33 + (isc ? 32 : b)) * 6144 + (which ? 5 : 2) * 1024 + ct * 128;
    const size_t rb = isc ? ((size_t)b * 256 + idx0) * 1024 : ((size_t)b * 2048 + idx0) * 1024;
    const float* src = (isc ? cs : xs) + rb + ct * 128;
    float* dst = (isc ? p.CTXC : p.out) + rb + ct * 128;
#pragma unroll
    for (int u = 0; u < 2; ++u) {
      const int x0 = xidx(wx, u, quad);
      const float4 g0 = *(const float4*)(gate + x0), g1 = *(const float4*)(gate + x0 + 4);
#pragma unroll
      for (int yt = 0; yt < 4; ++yt) {
        const size_t ro = (size_t)yidx(wy, yt, l15) * 1024 + x0;
        const float4 r0 = *(const float4*)(src + ro), r1 = *(const float4*)(src + ro + 4);
        float4 o0, o1;
        o0.x = r0.x + g0.x * acc[2 * u][yt][0]; o0.y = r0.y + g0.y * acc[2 * u][yt][1];
        o0.z = r0.z + g0.z * acc[2 * u][yt][2]; o0.w = r0.w + g0.w * acc[2 * u][yt][3];
        o1.x = r1.x + g1.x * acc[2 * u + 1][yt][0]; o1.y = r1.y + g1.y * acc[2 * u + 1][yt][1];
        o1.z = r1.z + g1.z * acc[2 * u + 1][yt][2]; o1.w = r1.w + g1.w * acc[2 * u + 1][yt][3];
        *(float4*)(dst + ro) = o0;
        *(float4*)(dst + ro + 4) = o1;
      }
    }
  }
}

DEV void phase_ffnup(const Params& p, int l, u16* lds) {
  const bool last = (l == NLAYER - 1);
  const int t = ptid(), lane = t & 63, w = t >> 6, l15 = lane & 15, quad = lane >> 4, wx = w & 1, wy = w >> 1;
  int rt, ct;
  for (int it = 0; next_tile_p(it, 288, 22, 16, 2, rt, ct); ++it) {
    if (last && (rt % 144) >= 128) continue;
    f32x4 acc[8][4];
    zero_acc8(acc);
    gemm_kloop256(p.WGU + ((size_t)l * 2 * FH + ct * 256) * 1024, 1024, p.YS + (size_t)rt * 256 * 1024, 1024, 16, acc, lds);
#pragma unroll
    for (int yt = 0; yt < 4; ++yt) {
      const size_t row = (size_t)rt * 256 + yidx(wy, yt, l15);
#pragma unroll
      for (int u = 0; u < 4; ++u) {
        const f32x4 a = acc[2 * u][yt], b = acc[2 * u + 1][yt];
        u32x2 o;
        o.x = cvt_pk(a[0] * sigmoidf_(a[0]) * b[0], a[1] * sigmoidf_(a[1]) * b[1]);
        o.y = cvt_pk(a[2] * sigmoidf_(a[2]) * b[2], a[3] * sigmoidf_(a[3]) * b[3]);
        *(u32x2*)(p.PX + row * FH + ct * 128 + (xidx8(wx, u, quad) >> 1)) = o;
      }
    }
  }
}

DEV void phase_down(const Params& p, int l, u16* lds) {
  const bool last = (l == NLAYER - 1);
  const int t = ptid(), lane = t & 63, w = t >> 6, l15 = lane & 15, quad = lane >> 4, wx = w & 1, wy = w >> 1;
  int rt, ct;
  for (int it = 0; next_tile_p(it, 288, 4, 8, 4, rt, ct); ++it) {
    const int hf = rt >= 144 ? 1 : 0;
    const int rl = rt - hf * 144;
    if (last && rl >= 128) continue;
    f32x4 acc[8][4];
    zero_acc8(acc);
    gemm_kloop256(p.WDN + ((size_t)l * 1024 + ct * 256) * FH, FH, p.PX + (size_t)rt * 256 * FH, FH, FH / 64, acc, lds);
    int b, idx0; bool isc;
    rowmap(hf, rl * 256, b, idx0, isc);
    const float* gate = p.MOD + ((size_t)l * 33 + (isc ? 32 : b)) * 6144 + 5 * 1024 + ct * 256;
    const size_t rb = isc ? ((size_t)b * 256 + idx0) * 1024 : ((size_t)b * 2048 + idx0) * 1024;
    float* dst = (isc ? p.CTXC : p.out) + rb + ct * 256;
#pragma unroll
    for (int u = 0; u < 4; ++u) {
      const int x0 = xidx8(wx, u, quad);
      const float4 g0 = *(const float4*)(gate + x0), g1 = *(const float4*)(gate + x0 + 4);
#pragma unroll
      for (int yt = 0; yt < 4; ++yt) {
        const size_t ro = (size_t)yidx(wy, yt, l15) * 1024 + x0;
        const float4 r0 = *(const float4*)(dst + ro), r1 = *(const float4*)(dst + ro + 4);
        float4 o0, o1;
        o0.x = r0.x + g0.x * acc[2 * u][yt][0]; o0.y = r0.y + g0.y * acc[2 * u][yt][1];
        o0.z = r0.z + g0.z * acc[2 * u][yt][2]; o0.w = r0.w + g0.w * acc[2 * u][yt][3];
        o1.x = r1.x + g1.x * acc[2 * u + 1][yt][0]; o1.y = r1.y + g1.y * acc[2 * u + 1][yt][1];
        o1.z = r1.z + g1.z * acc[2 * u + 1][yt][2]; o1.w = r1.w + g1.w * acc[2 * u + 1][yt][3];
        *(float4*)(dst + ro) = o0;
        *(float4*)(dst + ro + 4) = o1;
      }
    }
  }
}

namespace pg8 {
#define PG8_LAS __attribute__((address_space(3)))
typedef unsigned short bf16_t;
typedef short bf16x8 __attribute__((ext_vector_type(8)));
typedef float f32x4 __attribute__((ext_vector_type(4)));
constexpr int BM = 256, BK = 64, HALF = 128, HTB = HALF * BK * 2, STAGE_BYTES = 8 * HTB;
__host__ __device__ __forceinline__ int lds_byte(int r, int c) { const int st = (r >> 4) * 2 + (c >> 5), rr = r & 15, cc = c & 31, ob = rr * 64 + cc * 2; return st * 1024 + (ob ^ (((ob >> 9) & 1) << 5)); }
__host__ __device__ __forceinline__ void stage_rc(int b, int& R, int& C) { const int st = b / 1024, sb = b % 1024, swz = sb ^ (((sb >> 9) & 1) << 5); R = (st >> 1) * 16 + swz / 64; C = (st & 1) * 32 + (swz % 64) / 2; }
__host__ __device__ __forceinline__ int perm32(int rho) { const int n = rho >> 4, i = rho & 15; return 8 * (i >> 2) + 4 * n + (i & 3); }
struct Unit { const char* a; const char* b; int pm, pn, kind; };
template <class Epi, class Sched, bool ALIGN_EPI = false, bool SP2 = false>
__device__ __forceinline__ void gemm_phase(PG8_LAS unsigned char* lds, const int K_, const int lda, const int ldb, const Sched& S, const Epi& E) {
    const int tid = ptid(), wid = __builtin_amdgcn_readfirstlane(tid >> 6), lane = tid & 63, wr = wid >> 2, wc = wid & 3, fr = lane & 15, fq = lane >> 4;
    const int K = K_, nt = K / BK;
    unsigned voffA[2], voffB[2];
#pragma unroll
    for (int i = 0; i < 2; ++i) { int R, C; stage_rc(tid * 16 + i * 8192, R, C); const int Rb = 64 * ((R >> 5) & 3) + perm32(R & 31);
        voffA[i] = (unsigned)(R * lda + C) * 2u; voffB[i] = (unsigned)(Rb * ldb + C) * 2u; }
    const size_t kstep = (size_t)(BK * 2);
    const size_t hstep = (size_t)HALF * lda * 2;
    const size_t hstepB = (size_t)32 * ldb * 2;
    const unsigned ldsw = (unsigned)wid * 1024u;
    const int aoff = lds_byte(wr * 64 + fr, fq * 8), boff = lds_byte(wc * 32 + fr, fq * 8);
#define PG8_SA(b, h) (((b) * 2 + (h)) * HTB)
#define PG8_SB(b, h) ((4 + (b) * 2 + (h)) * HTB)
#define PG8_STAGE(bufoff, gbase, voff) do { _Pragma("unroll") for (int _i = 0; _i < 2; ++_i) \
        __builtin_amdgcn_global_load_lds((const unsigned*)((const char*)(gbase) + (voff)[_i]), (PG8_LAS unsigned*)(lds + (bufoff) + ldsw + _i * 8192), 16, 0, 0); } while (0)
#define PG8_LDA(dst, b, h) do { _Pragma("unroll") for (int m = 0; m < 4; ++m) _Pragma("unroll") for (int k = 0; k < 2; ++k) dst[m][k] = *(const PG8_LAS bf16x8*)(lds + PG8_SA(b, h) + aoff + m * 2048 + k * 1024); } while (0)
#define PG8_LDB(dst, b, h) do { _Pragma("unroll") for (int n = 0; n < 2; ++n) _Pragma("unroll") for (int k = 0; k < 2; ++k) dst[n][k] = *(const PG8_LAS bf16x8*)(lds + PG8_SB(b, h) + boff + n * 2048 + k * 1024); } while (0)
#define PG8_MMA(ai, bj, At, Bt) do { __builtin_amdgcn_s_setprio(1); _Pragma("unroll") for (int m = 0; m < 4; ++m) _Pragma("unroll") for (int n = 0; n < 2; ++n) _Pragma("unroll") for (int k = 0; k < 2; ++k) \
        acc[ai][bj][m][n] = __builtin_amdgcn_mfma_f32_16x16x32_bf16(Bt[n][k], At[m][k], acc[ai][bj][m][n], 0, 0, 0); __builtin_amdgcn_s_setprio(0); } while (0)
#define PG8_WAIT_V(n) asm volatile("s_waitcnt vmcnt(" #n ")" ::: "memory")
#define PG8_WAIT_L(n) asm volatile("s_waitcnt lgkmcnt(" #n ")" ::: "memory")
#define PG8_BAR __builtin_amdgcn_s_barrier()
#define PG8_SCHED __builtin_amdgcn_sched_barrier(0)
    Unit cur, nxt; int ui = 0;
    if (!S.next(0, cur)) return;
    f32x4 acc[2][2][4][2];
#pragma unroll
    for (int a = 0; a < 2; ++a)
#pragma unroll
        for (int b = 0; b < 2; ++b)
#pragma unroll
            for (int m = 0; m < 4; ++m)
#pragma unroll
                for (int n = 0; n < 2; ++n) acc[a][b][m][n] = (f32x4){0.f, 0.f, 0.f, 0.f};
    bf16x8 At[4][2], B0[2][2], B1[2][2];
    const char* cA = cur.a; const char* cB = cur.b;
    S.a_ready(cur);
    if constexpr (SP2) {
        PG8_STAGE(PG8_SB(0, 0), cB, voffB); PG8_STAGE(PG8_SB(0, 1), cB + hstepB, voffB); PG8_STAGE(PG8_SA(0, 0), cA, voffA); PG8_STAGE(PG8_SA(0, 1), cA + hstep, voffA);
        if (wr == 1) PG8_BAR;
        PG8_WAIT_V(2); PG8_BAR;
        PG8_STAGE(PG8_SB(1, 0), cB + kstep, voffB); PG8_STAGE(PG8_SA(1, 0), cA + kstep, voffA); PG8_STAGE(PG8_SB(1, 1), cB + hstepB + kstep, voffB);
        PG8_WAIT_V(6); PG8_BAR;
    } else {
        PG8_STAGE(PG8_SB(0, 0), cB, voffB); PG8_STAGE(PG8_SA(0, 0), cA, voffA); PG8_STAGE(PG8_SB(0, 1), cB + hstepB, voffB); PG8_STAGE(PG8_SA(0, 1), cA + hstep, voffA);
        if (wr == 1) PG8_BAR;
        PG8_WAIT_V(4); PG8_BAR;
        PG8_STAGE(PG8_SB(1, 0), cB + kstep, voffB); PG8_STAGE(PG8_SA(1, 0), cA + kstep, voffA); PG8_STAGE(PG8_SB(1, 1), cB + hstepB + kstep, voffB);
        PG8_WAIT_V(6); PG8_BAR;
    }
    for (;;) {
        const bool has_next = S.next(ui + 1, nxt);
        const char* nA = has_next ? nxt.a : cA; const char* nB = has_next ? nxt.b : cB;
        for (int t = 0; t < nt; t += 2) {
            const bool last = (t == nt - 2);
            const char* a1 = cA + (size_t)(t + 1) * kstep;
            const char* a2 = last ? nA : cA + (size_t)(t + 2) * kstep; const char* b2 = last ? nB : cB + (size_t)(t + 2) * kstep;
            const char* a3 = a2 + kstep; const char* b3 = b2 + kstep;
            if (last && has_next) S.a_ready(nxt);
            if constexpr (SP2) {
            PG8_LDB(B0, 0, 0); PG8_LDB(B1, 0, 1); PG8_SCHED; PG8_LDA(At, 0, 0); PG8_STAGE(PG8_SA(1, 1), a1 + hstep, voffA);
            PG8_WAIT_V(8); PG8_WAIT_L(0); PG8_BAR; PG8_MMA(0, 0, At, B0); PG8_MMA(0, 1, At, B1); PG8_BAR; PG8_SCHED;
            PG8_LDA(At, 0, 1); PG8_STAGE(PG8_SB(0, 0), b2, voffB); PG8_STAGE(PG8_SB(0, 1), b2 + hstepB, voffB); PG8_STAGE(PG8_SA(0, 0), a2, voffA);
            PG8_WAIT_V(8); PG8_WAIT_L(0); PG8_BAR; PG8_MMA(1, 0, At, B0); PG8_MMA(1, 1, At, B1); PG8_BAR; PG8_SCHED;
            PG8_LDB(B0, 1, 0); PG8_LDB(B1, 1, 1); PG8_SCHED; PG8_LDA(At, 1, 0); PG8_STAGE(PG8_SA(0, 1), a2 + hstep, voffA);
            PG8_WAIT_V(8); PG8_WAIT_L(0); PG8_BAR; PG8_MMA(0, 0, At, B0); PG8_MMA(0, 1, At, B1); PG8_BAR; PG8_SCHED;
            PG8_LDA(At, 1, 1); PG8_STAGE(PG8_SB(1, 0), b3, voffB); PG8_STAGE(PG8_SB(1, 1), b3 + hstepB, voffB); PG8_STAGE(PG8_SA(1, 0), a3, voffA);
            PG8_WAIT_V(8); PG8_WAIT_L(0); PG8_BAR; PG8_MMA(1, 0, At, B0); PG8_MMA(1, 1, At, B1); PG8_BAR; PG8_SCHED;
            } else {
            PG8_LDB(B0, 0, 0); PG8_SCHED; PG8_LDA(At, 0, 0); PG8_STAGE(PG8_SA(1, 1), a1 + hstep, voffA);
            PG8_WAIT_L(8); PG8_BAR; PG8_WAIT_L(0); PG8_MMA(0, 0, At, B0); PG8_BAR; PG8_SCHED;
            PG8_LDB(B1, 0, 1); PG8_STAGE(PG8_SB(0, 0), b2, voffB);
            PG8_BAR; PG8_WAIT_L(0); PG8_MMA(0, 1, At, B1); PG8_BAR;
            PG8_LDA(At, 0, 1); PG8_STAGE(PG8_SA(0, 0), a2, voffA);
            PG8_BAR; PG8_WAIT_L(0); PG8_MMA(1, 0, At, B0); PG8_BAR; PG8_SCHED;
            PG8_STAGE(PG8_SB(0, 1), b2 + hstepB, voffB);
            PG8_WAIT_V(6); PG8_BAR; PG8_MMA(1, 1, At, B1); PG8_BAR;
            PG8_LDB(B0, 1, 0); PG8_SCHED; PG8_LDA(At, 1, 0); PG8_STAGE(PG8_SA(0, 1), a2 + hstep, voffA);
            PG8_WAIT_L(8); PG8_BAR; PG8_WAIT_L(0); PG8_MMA(0, 0, At, B0); PG8_BAR; PG8_SCHED;
            PG8_LDB(B1, 1, 1); PG8_STAGE(PG8_SB(1, 0), b3, voffB);
            PG8_BAR; PG8_WAIT_L(0); PG8_MMA(0, 1, At, B1); PG8_BAR;
            PG8_LDA(At, 1, 1); PG8_STAGE(PG8_SA(1, 0), a3, voffA);
            PG8_BAR; PG8_WAIT_L(0); PG8_MMA(1, 0, At, B0); PG8_BAR; PG8_SCHED;
            PG8_STAGE(PG8_SB(1, 1), b3 + hstepB, voffB);
            PG8_WAIT_V(6); PG8_BAR; PG8_MMA(1, 1, At, B1); PG8_BAR;
            }
        }
        if constexpr (ALIGN_EPI) { if (wr == 0) PG8_BAR; }
        if constexpr (!Epi::AFTER_DRAIN) { E(acc, cur, wr, wc, fr, fq); S.done(cur); }
        if (!has_next) break;
#pragma unroll
        for (int a = 0; a < 2; ++a)
#pragma unroll
            for (int b = 0; b < 2; ++b)
#pragma unroll
                for (int m = 0; m < 4; ++m)
#pragma unroll
                    for (int n = 0; n < 2; ++n) acc[a][b][m][n] = (f32x4){0.f, 0.f, 0.f, 0.f};
        cur = nxt; cA = nA; cB = nB; ++ui;
        if constexpr (ALIGN_EPI) { if (wr == 1) PG8_BAR; }
    }
    PG8_WAIT_V(0);
    if constexpr (!ALIGN_EPI) { if (wr == 0) PG8_BAR; }
    PG8_BAR;
    if constexpr (Epi::AFTER_DRAIN) { E.fused(acc, cur, wr, wc, fr, fq, lds, wid, lane); S.done(cur); }
#undef PG8_SA
#undef PG8_SB
#undef PG8_STAGE
#undef PG8_LDA
#undef PG8_LDB
#undef PG8_MMA
#undef PG8_WAIT_V
#undef PG8_WAIT_L
#undef PG8_BAR
#undef PG8_SCHED
}
}

DEV bool tile_p(int it, int RT, int CT, int PR, int PC, int& rt, int& ct) {
  const int b = pbid();
  const int G = (int)gridDim.x;
  if (G != 8 * PR * PC) {
    const int v = it * G + b;
    if (v >= RT * CT) return false;
    rt = v / CT; ct = v - rt * CT;
    return true;
  }
  const int x = b & 7, lb = b >> 3;
  const int gp = it * 8 + x;
  const int npc = CT / PC, npr = RT / PR;
  if (gp >= npc * npr) return false;
  const int prow = gp / npc, pcol = gp - prow * npc;
  rt = prow * PR + lb / PC;
  ct = pcol * PC + lb % PC;
  return true;
}
struct SchedInproj {
  const char* hx; const char* win; bool last;
  DEV bool next(int i, pg8::Unit& u) const {
    int cnt = -1;
    for (int it = 0;; ++it) {
      int rt, ct;
      if (!tile_p(it, 144, 34, 16, 2, rt, ct)) return false;
      const bool ctxrow = rt >= 128;
      const bool valid = !(last && ctxrow && !((ct >= 2 && ct < 6) || (ct >= 10 && ct < 14)));
      if (valid && ++cnt == i) {
        const bool isv = (ct == 4 || ct == 5 || ct == 12 || ct == 13);
        const char* at = hx + (size_t)rt * (256 * 1024 * 2);
        const char* wt = win + (size_t)ct * (256 * 1024 * 2);
        u.a = isv ? wt : at; u.b = isv ? at : wt; u.pm = rt; u.pn = ct; u.kind = isv ? 1 : 0;
        return true;
      }
    }
  }
  DEV void a_ready(const pg8::Unit&) const {}
  DEV void done(const pg8::Unit&) const {}
};
struct SchedFull {
  const char* A; const char* W; size_t tstep; int CT, PR, PC; bool last;
  DEV bool next(int i, pg8::Unit& u) const {
    int cnt = -1;
    for (int it = 0;; ++it) {
      int rt, ct;
      if (!tile_p(it, 288, CT, PR, PC, rt, ct)) return false;
      const bool valid = !(last && (rt % 144) >= 128);
      if (valid && ++cnt == i) { u.a = A + (size_t)rt * tstep; u.b = W + (size_t)ct * tstep; u.pm = rt; u.pn = ct; u.kind = 0; return true; }
    }
  }
  DEV void a_ready(const pg8::Unit&) const {}
  DEV void done(const pg8::Unit&) const {}
};

struct EpiInproj {
  static constexpr bool PERM = true, AFTER_DRAIN = false;
  const Params& p; int l;
  DEV void operator()(f32x4 (&acc)[2][2][4][2], const pg8::Unit& u, int wr, int wc, int fr, int fq) const {
    const int rt = u.pm, ct = u.pn;
    const bool ctxrow = rt >= 128;
    if (u.kind == 0) {
      if (ct < 4 || (ct >= 8 && ct < 12)) {
        const int seg = ct < 4 ? (ct >> 1) : 2 + ((ct - 8) >> 1);
        const float* gq = (seg < 2 ? p.a_qk_g : p.c_qk_g) + l * 128 + (seg & 1) * 64;
        const float qs = (seg == 0 || seg == 2) ? 0.125f * LOG2E : 1.f;
        const bool dorope = (seg < 2) && !ctxrow;
        float gl[2][2][4], inv[8];
        int q2 = fq;
        asm volatile("" : "+v"(q2) : "v"(acc[0][0][0][0][0]));
#pragma unroll
        for (int bj = 0; bj < 2; ++bj)
#pragma unroll
          for (int n = 0; n < 2; ++n)
#pragma unroll
            for (int j = 0; j < 4; ++j) gl[bj][n][j] = gq[bj * 32 + q2 * 8 + n * 4 + j] * qs;
#pragma unroll
        for (int k = 0; k < 8; ++k) inv[k] = fexp2(-(float)((q2 & 1) * 8 + k) * (13.287712379549449f / 16.f));
#pragma unroll
        for (int ai = 0; ai < 2; ++ai)
#pragma unroll
          for (int m = 0; m < 4; ++m) {
            __builtin_amdgcn_sched_barrier(0);
            float ss = 0.f;
#pragma unroll
            for (int bj = 0; bj < 2; ++bj)
#pragma unroll
              for (int n = 0; n < 2; ++n)
#pragma unroll
                for (int j = 0; j < 4; ++j) ss += acc[ai][bj][m][n][j] * acc[ai][bj][m][n][j];
            ss += __shfl_xor(ss, 16);
            ss += __shfl_xor(ss, 32);
            const float r = rsqrtf(ss * (1.f / 64.f) + EPS_);
#pragma unroll
            for (int bj = 0; bj < 2; ++bj)
#pragma unroll
              for (int n = 0; n < 2; ++n)
#pragma unroll
                for (int j = 0; j < 4; ++j) acc[ai][bj][m][n][j] *= r * gl[bj][n][j];
            if (dorope) {
              int sq = (rt * 256 + ai * 128 + wr * 64 + m * 16 + fr) & 2047;
              asm volatile("" : "+v"(sq) : "v"(acc[ai][0][m][0][0]));
              const float frow = (float)(sq >> 6), fcol = (float)(sq & 63);
#pragma unroll
              for (int bj = 0; bj < 2; ++bj)
#pragma unroll
                for (int n = 0; n < 2; ++n)
#pragma unroll
                  for (int j = 0; j < 4; ++j) {
                    const float ang = (bj ? fcol : frow) * inv[n * 4 + j];
                    const float cs = __cosf(ang), sn = __sinf(ang);
                    const float v = acc[ai][bj][m][n][j];
                    const float pv = __shfl_xor(v, 32);
                    acc[ai][bj][m][n][j] = (q2 < 2) ? v * cs - pv * sn : v * cs + pv * sn;
                  }
            }
          }
      }
      const int c0 = ct * 256;
      const int pxc = c0 < 1024 ? c0 : (c0 < 3072 ? c0 - 512 : c0 - 1024);
#pragma unroll
      for (int ai = 0; ai < 2; ++ai)
#pragma unroll
        for (int m = 0; m < 4; ++m) {
          const size_t row = (size_t)rt * 256 + ai * 128 + wr * 64 + m * 16 + fr;
#pragma unroll
          for (int bj = 0; bj < 2; ++bj)
            *(u32x4*)(p.PX + row * PXW + pxc + wc * 64 + bj * 32 + fq * 8) = pack8(acc[ai][bj][m][0], acc[ai][bj][m][1]);
        }
    } else {
      int bl, key0;
      if (!ctxrow) { bl = rt >> 3; key0 = (rt & 7) * 256; } else { bl = rt - 128; key0 = 2048; }
      const bool isva = ct < 8;
#pragma unroll
      for (int ai = 0; ai < 2; ++ai)
#pragma unroll
        for (int m = 0; m < 4; ++m) {
          const int n = ai * 128 + wr * 64 + m * 16 + fr;
          u16* dst;
          if (isva) dst = p.VTA + ((size_t)((bl * 4 + (ct - 4) * 2 + (n >> 7)) * 128 + (n & 127))) * KV + key0;
          else dst = p.VTC + ((size_t)((bl * 8 + (ct - 12) * 4 + (n >> 6)) * 64 + (n & 63))) * KV + key0;
#pragma unroll
          for (int bj = 0; bj < 2; ++bj) *(u32x4*)(dst + wc * 64 + bj * 32 + fq * 8) = pack8(acc[ai][bj][m][0], acc[ai][bj][m][1]);
        }
    }
  }
};
struct EpiFfnUp {
  static constexpr bool PERM = true, AFTER_DRAIN = false;
  u16* hid;
  DEV void operator()(f32x4 (&acc)[2][2][4][2], const pg8::Unit& u, int wr, int wc, int fr, int fq) const {
#pragma unroll
    for (int ai = 0; ai < 2; ++ai)
#pragma unroll
      for (int m = 0; m < 4; ++m) {
        const size_t row = (size_t)u.pm * 256 + ai * 128 + wr * 64 + m * 16 + fr;
        f32x4 o0, o1;
#pragma unroll
        for (int j = 0; j < 4; ++j) {
          const float a0 = acc[ai][0][m][0][j], a1 = acc[ai][0][m][1][j];
          o0[j] = a0 * sigmoidf_(a0) * acc[ai][1][m][0][j];
          o1[j] = a1 * sigmoidf_(a1) * acc[ai][1][m][1][j];
        }
        *(u32x4*)(hid + row * FH + u.pn * 128 + wc * 32 + fq * 8) = pack8(o0, o1);
      }
  }
};
struct EpiDown {
  static constexpr bool PERM = true, AFTER_DRAIN = false;
  const Params& p; int l;
  DEV void operator()(f32x4 (&acc)[2][2][4][2], const pg8::Unit& u, int wr, int wc, int fr, int fq) const {
    const int rt = u.pm, ct = u.pn;
    const int hf = rt >= 144 ? 1 : 0;
    const int rl = rt - hf * 144;
    int b, idx0; bool isc;
    rowmap(hf, rl * 256, b, idx0, isc);
    const float* gate = p.MOD + ((size_t)l * 33 + (isc ? 32 : b)) * 6144 + 5 * 1024 + ct * 256;
    const size_t rb = isc ? ((size_t)b * 256 + idx0) * 1024 : ((size_t)b * 2048 + idx0) * 1024;
    float* dst = (isc ? p.CTXC : p.out) + rb + ct * 256;
#pragma unroll
    for (int bj = 0; bj < 2; ++bj) {
      const int x0 = wc * 64 + bj * 32 + fq * 8;
      const float4 g0 = *(const float4*)(gate + x0), g1 = *(const float4*)(gate + x0 + 4);
#pragma unroll
      for (int ai = 0; ai < 2; ++ai) {
      f32x4 r0[2][4], r1[2][4];
#pragma unroll
        for (int m = 0; m < 4; ++m) {
          const size_t ro = (size_t)(ai * 128 + wr * 64 + m * 16 + fr) * 1024 + x0;
          r0[ai][m] = *(const f32x4*)(dst + ro); r1[ai][m] = *(const f32x4*)(dst + ro + 4);
        }
#pragma unroll
        for (int m = 0; m < 4; ++m) {
          const size_t ro = (size_t)(ai * 128 + wr * 64 + m * 16 + fr) * 1024 + x0;
          const f32x4 a0 = acc[ai][bj][m][0], a1 = acc[ai][bj][m][1];
          f32x4 o0 = r0[ai][m], o1 = r1[ai][m];
          o0[0] += g0.x * a0[0]; o0[1] += g0.y * a0[1]; o0[2] += g0.z * a0[2]; o0[3] += g0.w * a0[3];
          o1[0] += g1.x * a1[0]; o1[1] += g1.y * a1[1]; o1[2] += g1.z * a1[2]; o1[3] += g1.w * a1[3];
          *(f32x4*)(dst + ro) = o0;
          *(f32x4*)(dst + ro + 4) = o1;
        }
      }
    }
  }
};

DEV void phase_inproj8(const Params& p, int l, int hf, char* lds) {
  SchedInproj S{(const char*)p.HX, (const char*)(p.WIN + (size_t)l * INC * 1024), l == NLAYER - 1};
  EpiInproj E{p, l};
  pg8::gemm_phase<EpiInproj, SchedInproj, true, true>((PG8_LAS unsigned char*)lds, 1024, 1024, 1024, S, E);
}
DEV void phase_ffnup8(const Params& p, int l, char* lds) {
  SchedFull S{(const char*)p.YS, (const char*)(p.WGU + (size_t)l * 2 * FH * 1024), (size_t)256 * 1024 * 2, 22, 16, 2, l == NLAYER - 1};
  EpiFfnUp E{p.PX};
  pg8::gemm_phase<EpiFfnUp, SchedFull, true, true>((PG8_LAS unsigned char*)lds, 1024, 1024, 1024, S, E);
}
DEV void phase_down8(const Params& p, int l, char* lds) {
  SchedFull S{(const char*)p.PX, (const char*)(p.WDN + (size_t)l * 1024 * FH), (size_t)256 * FH * 2, 4, 8, 4, l == NLAYER - 1};
  EpiDown E{p, l};
  pg8::gemm_phase<EpiDown, SchedFull, true, true>((PG8_LAS unsigned char*)lds, FH, FH, FH, S, E);
}


struct SchedMerge {
  const char* ys; const char* wbr; int RT;
  DEV bool next(int i, pg8::Unit& u) const {
    int rt, ct;
    if (!tile_p(i >> 2, RT, 4, 8, 4, rt, ct)) return false;
    const int br = i & 3;
    u.a = ys + ((size_t)rt * 256 * 2048 + br * 512) * 2;
    u.b = wbr + ((size_t)ct * 256 * 2048 + br * 512) * 2;
    u.pm = rt; u.pn = ct; u.kind = br;
    return true;
  }
  DEV void a_ready(const pg8::Unit&) const {}
  DEV void done(const pg8::Unit&) const {}
};
struct EpiMerge {
  static constexpr bool PERM = true, AFTER_DRAIN = false;
  const u16* px; u16* dstb;
  DEV void operator()(f32x4 (&acc)[2][2][4][2], const pg8::Unit& u, int wr, int wc, int fr, int fq) const {
    const int br = u.kind;
#pragma unroll
    for (int aim = 0; aim < 4; ++aim) {
      const int ai = aim >> 1, m0 = (aim & 1) * 2;
      u32x4 gq[4][2], pv[4][2];
#pragma unroll
      for (int m = m0; m < m0 + 2; ++m) {
        const size_t row = (size_t)u.pm * 256 + ai * 128 + wr * 64 + m * 16 + fr;
#pragma unroll
        for (int bj = 0; bj < 2; ++bj) {
          const int col = u.pn * 256 + wc * 64 + bj * 32 + fq * 8;
          gq[m][bj] = *(const u32x4*)(px + row * PXW + PX_G + br * 1024 + col);
          pv[m][bj] = (u32x4){0u, 0u, 0u, 0u};
          if (br) pv[m][bj] = *(const u32x4*)(dstb + row * 1024 + col);
        }
      }
#pragma unroll
      for (int m = m0; m < m0 + 2; ++m) {
        const size_t row = (size_t)u.pm * 256 + ai * 128 + wr * 64 + m * 16 + fr;
#pragma unroll
        for (int bj = 0; bj < 2; ++bj) {
          const int col = u.pn * 256 + wc * 64 + bj * 32 + fq * 8;
          const u32x4 g = gq[m][bj], q = pv[m][bj];
          f32x4 a = acc[ai][bj][m][0], b = acc[ai][bj][m][1];
          a[0] = bflo(q.x) + sigmoidf_(bflo(g.x)) * a[0]; a[1] = bfhi(q.x) + sigmoidf_(bfhi(g.x)) * a[1];
          a[2] = bflo(q.y) + sigmoidf_(bflo(g.y)) * a[2]; a[3] = bfhi(q.y) + sigmoidf_(bfhi(g.y)) * a[3];
          b[0] = bflo(q.z) + sigmoidf_(bflo(g.z)) * b[0]; b[1] = bfhi(q.z) + sigmoidf_(bfhi(g.z)) * b[1];
          b[2] = bflo(q.w) + sigmoidf_(bflo(g.w)) * b[2]; b[3] = bfhi(q.w) + sigmoidf_(bfhi(g.w)) * b[3];
          *(u32x4*)(dstb + row * 1024 + col) = pack8(a, b);
        }
      }
    }
  }
};
struct EpiOut {
  static constexpr bool PERM = true, AFTER_DRAIN = false;
  const Params& p; int l;
  DEV void operator()(f32x4 (&acc)[2][2][4][2], const pg8::Unit& u, int wr, int wc, int fr, int fq) const {
    const int rt = u.pm, ct = u.pn;
    const int hf = rt >= 144 ? 1 : 0;
    const int rl = rt - hf * 144;
    int b, idx0; bool isc;
    rowmap(hf, rl * 256, b, idx0, isc);
    const float* gate = p.MOD + ((size_t)l * 33 + (isc ? 32 : b)) * 6144 + 2 * 1024 + ct * 256;
    const size_t rb = isc ? ((size_t)b * 256 + idx0) * 1024 : ((size_t)b * 2048 + idx0) * 1024;
    const float* src = (l == 0 ? (isc ? p.ctx : p.x) : (isc ? (const float*)p.CTXC : (const float*)p.out)) + rb + ct * 256;
    float* dst = (isc ? p.CTXC : p.out) + rb + ct * 256;
#pragma unroll
    for (int bj = 0; bj < 2; ++bj) {
      const int x0 = wc * 64 + bj * 32 + fq * 8;
      const float4 g0 = *(const float4*)(gate + x0), g1 = *(const float4*)(gate + x0 + 4);
#pragma unroll
      for (int ai = 0; ai < 2; ++ai) {
      f32x4 r0[2][4], r1[2][4];
#pragma unroll
        for (int m = 0; m < 4; ++m) {
          const size_t ro = (size_t)(ai * 128 + wr * 64 + m * 16 + fr) * 1024 + x0;
          r0[ai][m] = *(const f32x4*)(src + ro); r1[ai][m] = *(const f32x4*)(src + ro + 4);
        }
#pragma unroll
        for (int m = 0; m < 4; ++m) {
          const size_t ro = (size_t)(ai * 128 + wr * 64 + m * 16 + fr) * 1024 + x0;
          const f32x4 a0 = acc[ai][bj][m][0], a1 = acc[ai][bj][m][1];
          f32x4 o0 = r0[ai][m], o1 = r1[ai][m];
          o0[0] += g0.x * a0[0]; o0[1] += g0.y * a0[1]; o0[2] += g0.z * a0[2]; o0[3] += g0.w * a0[3];
          o1[0] += g1.x * a1[0]; o1[1] += g1.y * a1[1]; o1[2] += g1.z * a1[2]; o1[3] += g1.w * a1[3];
          *(f32x4*)(dst + ro) = o0;
          *(f32x4*)(dst + ro + 4) = o1;
        }
      }
    }
  }
};
DEV void phase_merge8(const Params& p, int l, int hf, char* lds) {
  SchedMerge S{(const char*)p.YS, (const char*)(p.WBR + (size_t)l * 1024 * 2048), (l == NLAYER - 1) ? 128 : 144};
  EpiMerge E{p.PX, hf ? p.HX : p.ACC0};
  pg8::gemm_phase<EpiMerge, SchedMerge, true, true>((PG8_LAS unsigned char*)lds, 512, 2048, 2048, S, E);
}
DEV void phase_out8(const Params& p, int l, char* lds) {
  SchedFull S{(const char*)p.ACC0, (const char*)(p.WOUT + (size_t)l * 1024 * 1024), (size_t)256 * 1024 * 2, 4, 8, 4, l == NLAYER - 1};
  EpiOut E{p, l};
  pg8::gemm_phase<EpiOut, SchedFull, true, true>((PG8_LAS unsigned char*)lds, 1024, 1024, 1024, S, E);
}

DEV void run_phase(const Params& p, int ph, char* lds0) {
  char* lds = lds0 + vhalf() * 73728;
  if (ph == 0) { phase_prep(p, lds); return; }
  const int q = ph - 1;
  const int l = q / 11, k = q % 11;
  switch (k) {
    case 0: phase_norm(p, l, 0, 0); break;
    case 1: phase_inproj8(p, l, 0, lds0); break;
    case 2: phase_mixers(p, l, 0, (u16*)lds, (u16*)lds0); break;
    case 3: phase_merge8(p, l, 0, lds0); phase_norm(p, l, 1, 0); break;
    case 4: phase_inproj8(p, l, 1, lds0); break;
    case 5: phase_mixers(p, l, 1, (u16*)lds, (u16*)lds0); break;
    case 6: phase_merge8(p, l, 1, lds0); break;
    case 7: phase_out8(p, l, lds0); break;
    case 8: phase_norm(p, l, 0, 1); break;
    case 9: phase_ffnup8(p, l, lds0); break;
    default: phase_down8(p, l, lds0); break;
  }
}

#define XB_TMO      128
#define XB_XCNT(j)  (256  + 64 * (j))
#define XB_XSUB(j)  (1280 + 64 * (j))
#define XB_XGEN(j)  (2304 + 64 * (j))
#define XB_TOP      3328
#define XB_TOPGEN   3392
#define XCD_BAR_WORDS 3456
#define XB_SPIN_CAP (1u << 24)
#define LAS __attribute__((address_space(3)))
DEV unsigned xb_ld(unsigned* p) { return __hip_atomic_load(p, __ATOMIC_RELAXED, __HIP_MEMORY_SCOPE_AGENT); }
DEV unsigned xb_add(unsigned* p, unsigned v) { return __hip_atomic_fetch_add(p, v, __ATOMIC_RELAXED, __HIP_MEMORY_SCOPE_AGENT); }
DEV unsigned xb_xcc_id() { return (unsigned)__builtin_amdgcn_s_getreg((3 << 11) | 20) & 0xFu; }
#define XB_SPIN(cond, bar) do { unsigned _sp = 0; while (cond) { __builtin_amdgcn_s_sleep(1); \
    if ((++_sp & 255u) == 0u) { if (xb_ld(&(bar)[XB_TMO])) break; if (_sp > XB_SPIN_CAP) { atomicAdd(&(bar)[XB_TMO], 1u); break; } } } } while (0)
struct XcdBarrier { unsigned* bar; unsigned x; volatile LAS unsigned* st; };
DEV XcdBarrier xcd_barrier_post(unsigned* bar, volatile LAS unsigned* st) {
  XcdBarrier b; b.bar = bar; b.x = xb_xcc_id(); b.st = st;
  if (threadIdx.x == 0) (void)xb_add(&bar[XB_XCNT(b.x)], 1u);
  return b;
}
DEV void xcd_barrier_complete(unsigned* bar, unsigned x, unsigned& nloc, unsigned& nx) {
  const unsigned G = gridDim.x * gridDim.y * gridDim.z;
  unsigned sum, cnt, mine, sp = 0u;
  for (;;) {
    sum = 0u; cnt = 0u; mine = 0u;
#pragma unroll
    for (unsigned j = 0; j < 16; ++j) { const unsigned c = xb_ld(&bar[XB_XCNT(j)]); sum += c; cnt += (c > 0u) ? 1u : 0u; mine = (j == x) ? c : mine; }
    if (sum == G) break;
    __builtin_amdgcn_s_sleep(1);
    if ((++sp & 255u) == 0u) { if (xb_ld(&bar[XB_TMO])) break; if (sp > XB_SPIN_CAP) { atomicAdd(&bar[XB_TMO], 1u); break; } }
  }
  nloc = mine > 0u ? mine : 1u; nx = cnt > 0u ? cnt : 1u;
}
DEV void xcd_barrier(const XcdBarrier& b) {
  asm volatile("s_waitcnt vmcnt(0)" ::: "memory");
  __syncthreads();
  if (threadIdx.x == 0) {
    unsigned* bar = b.bar;
    __builtin_amdgcn_s_waitcnt(0);
    unsigned nloc = b.st[0], nx = b.st[1];
    if (nloc == 0u) { xcd_barrier_complete(bar, b.x, nloc, nx); b.st[0] = nloc; b.st[1] = nx; }
    const unsigned old = xb_add(&bar[XB_XSUB(b.x)], 1u);
    const unsigned gen = old / nloc;
    if (old + 1u == (gen + 1u) * nloc) {
      __builtin_amdgcn_fence(__ATOMIC_RELEASE, "agent");
      asm volatile("s_waitcnt vmcnt(0)" ::: "memory");
      const unsigned og = xb_add(&bar[XB_TOP], 1u);
      const unsigned tg = og / nx;
      if (og + 1u == (tg + 1u) * nx) xb_add(&bar[XB_TOPGEN], 1u);
      else XB_SPIN(xb_ld(&bar[XB_TOPGEN]) == tg, bar);
      __builtin_amdgcn_fence(__ATOMIC_ACQUIRE, "agent");
      xb_add(&bar[XB_XGEN(b.x)], 1u);
      asm volatile("s_waitcnt vmcnt(0)" ::: "memory");
    } else {
      XB_SPIN(xb_ld(&bar[XB_XGEN(b.x)]) == gen, bar);
      __builtin_amdgcn_fence(__ATOMIC_ACQUIRE, "agent");
      asm volatile("s_waitcnt vmcnt(0)" ::: "memory");
    }
  }
  __syncthreads();
}

__global__ void __launch_bounds__(512, 2) fwd_kernel(Params p) {
  extern __shared__ __attribute__((aligned(16))) char smem[];
  cg::grid_group grid = cg::this_grid();
  volatile LAS unsigned* st = (volatile LAS unsigned*)(smem + 2 * 73728);
  if (threadIdx.x == 0) { st[0] = 0u; st[1] = 0u; st[2] = 0u; st[3] = 0u; }
  __syncthreads();
  XcdBarrier xb = xcd_barrier_post(p.BAR, st);
  for (int ph = p.ph0; ph < p.ph1; ++ph) {
    run_phase(p, ph, smem);
    if (ph + 1 < p.ph1) { if (ph == 0) grid.sync(); else xcd_barrier(xb); }
  }
}

extern "C" void kernel_launch(void* const* d_in, const int* in_sizes, int n_in, void* d_out, int out_size, void* d_ws, size_t ws_size,
                              hipStream_t stream) {
  static int grid_blocks = 0;
  if (!grid_blocks) {
    int dev = 0, cus = 0, per_cu = 0;
    hipGetDevice(&dev);
    hipDeviceGetAttribute(&cus, hipDeviceAttributeMultiprocessorCount, dev);
    hipFuncSetAttribute((const void*)fwd_kernel, hipFuncAttributeMaxDynamicSharedMemorySize, LDS_BYTES);
    hipOccupancyMaxActiveBlocksPerMultiprocessor(&per_cu, fwd_kernel, 512, LDS_BYTES);
    if (per_cu > 1) per_cu = 1;
    if (per_cu < 1) per_cu = 1;
    grid_blocks = cus * per_cu;
    grid_blocks &= ~7;
    if (grid_blocks < 8) grid_blocks = 8;
  }
  Params p{};
  const float* const* in = (const float* const*)d_in;
  p.x = in[0]; p.c = in[1]; p.ctx = in[2]; p.c_ctx = in[3]; p.w_mod = in[4]; p.b_mod = in[5]; p.norm1_g = in[6]; p.w_in = in[7];
  p.a_qk_g = in[8]; p.a_lambda = in[9]; p.a_subln_g = in[10]; p.b_pool_w = in[11]; p.b_pool_s = in[12]; p.c_qk_g = in[13];
  p.c_rpb = in[14]; p.d_vn_g = in[15]; p.d_ws = in[16]; p.d_bs = in[17]; p.w_branch = in[18]; p.w_out = in[19]; p.norm2_g = in[20];
  p.w_gu = in[21]; p.w_down = in[22];
  p.out = (float*)d_out;
  char* ws = (char*)d_ws;
  size_t off = 0;
  auto carve = [&](size_t bytes) { char* r = ws + off; off += (bytes + 255) & ~(size_t)255; return r; };
  p.BAR = (unsigned*)carve((size_t)4096 * 4);
  p.WIN = (u16*)carve((size_t)NLAYER * INC * 1024 * 2);
  p.WBR = (u16*)carve((size_t)NLAYER * 1024 * 2048 * 2);
  p.WOUT = (u16*)carve((size_t)NLAYER * 1024 * 1024 * 2);
  p.WGU = (u16*)carve((size_t)NLAYER * 2 * FH * 1024 * 2);
  p.WDN = (u16*)carve((size_t)NLAYER * 1024 * FH * 2);
  p.WPOOL = (u16*)carve((size_t)NLAYER * 4 * 16384 * 2);
  p.WSB = (u16*)carve((size_t)NLAYER * 4 * 16384 * 2);
  p.MOD = (float*)carve((size_t)NLAYER * 33 * 6144 * 4);
  p.CTXC = (float*)carve((size_t)32 * 256 * 1024 * 4);
  p.ACC0 = (u16*)carve((size_t)HR * 1024 * 2);
  p.HX = (u16*)carve((size_t)HR * 1024 * 2);
  p.PX = (u16*)carve((size_t)HR * PXW * 2);
  p.VTA = (u16*)carve((size_t)HB * 4 * 128 * KV * 2);
  p.VTC = (u16*)carve((size_t)HB * 8 * 64 * KV * 2);
  p.YS = (u16*)carve((size_t)HR * 2048 * 2);
  if (off > ws_size) { fprintf(stderr, "workspace too small: need %zu have %zu\n", off, ws_size); return; }
#if MULTI_LAUNCH
  for (int ph = 0; ph < NPHASE; ++ph) {
    p.ph0 = ph; p.ph1 = ph + 1;
    hipLaunchKernelGGL(fwd_kernel, dim3(grid_blocks), dim3(512), LDS_BYTES, stream, p);
  }
#else
  p.ph0 = 0; p.ph1 = NPHASE;
  (void)hipMemsetAsync(p.BAR, 0, (size_t)4096 * 4, stream);
  void* args[] = {&p};
  hipError_t e = hipLaunchCooperativeKernel((const void*)fwd_kernel, dim3(grid_blocks), dim3(512), args, LDS_BYTES, stream);
  if (e != hipSuccess) fprintf(stderr, "cooperative launch failed: %s (grid %d)\n", hipGetErrorString(e), grid_blocks);
#endif
}
```
